# Optimizing an MI355X kernel written in HIP

```python
import math
import jax
import jax.numpy as jnp
from jax import lax
import numpy as np

D_MODEL = 1024
BATCH = 2
SEQ = 8192
DEPTH = 2

GRID_W = 64
CTX_LEN = 256
BRANCH_W = D_MODEL // 2
N_BRANCH = 3
GLA_HEADS = 4
GLA_DV = BRANCH_W // GLA_HEADS
GLA_DK = GLA_DV // 2
GLA_RANK = 16
GLA_TAU = 16.0
GLA_CHUNK = 16
MLA_HEADS = 8
MLA_DV = BRANCH_W // MLA_HEADS
MLA_NOPE = MLA_DV
MLA_ROPE = MLA_NOPE // 2
MLA_Q_RANK = 3 * D_MODEL // 8
MLA_KV_RANK = D_MODEL // 4
ROPE_BASE = 10000.0
Q_BLOCK = 128
HY_W = BRANCH_W
HY_ORDER = 2
HY_DIRS = 2
HY_BANDS = 16
HY_EMB = 2 * HY_BANDS + 1
HY_FFN = 64
HY_DECAY_TARGET = 1e-2
HY_FAST_PCT = 0.3
HY_SLOW_PCT = 1.5
N_EXPERTS = 32
TOP_K = 4
D_FF = D_MODEL
SWIGLU_LIMIT = 7.0
SWIGLU_ALPHA = 1.702
MOE_BLOCK = 128
LN_EPS = 1e-5
RMS_EPS = 1e-6
DEEPNORM_ALPHA = (2 * DEPTH) ** 0.25
DEEPNORM_BETA = (8 * DEPTH) ** -0.25
IN_SPLITS = (
    GLA_HEADS * GLA_DK,
    GLA_HEADS * GLA_DV,
    GLA_RANK,
    GLA_RANK,
    MLA_KV_RANK,
    MLA_ROPE,
    GLA_HEADS * GLA_DK,
    GLA_HEADS * GLA_DV,
    MLA_Q_RANK,
    3 * HY_W,
    N_BRANCH * D_MODEL,
)
N_KEY_GROUPS = 6
KEY_COLS = sum(IN_SPLITS[:N_KEY_GROUPS])
IN_OFFSETS = tuple(int(o) for o in np.cumsum(IN_SPLITS)[:-1])
IN_TOTAL = sum(IN_SPLITS)
F32 = jnp.float32

kernel_name = 'hybrid_gla_mla_hyena_moe_diffusion_block'


def layer_norm(x, gain=None, bias=None):
    xf = x.astype(F32)
    xc = xf - xf.mean(-1, keepdims=True)
    y = xc * lax.rsqrt((xc * xc).mean(-1, keepdims=True) + LN_EPS)
    if gain is not None:
        y = y * gain.astype(F32) + bias.astype(F32)
    return y.astype(x.dtype)


def rms_norm(x, gain):
    xf = x.astype(F32)
    y = xf * lax.rsqrt(jnp.mean(xf * xf, -1, keepdims=True) + RMS_EPS) * gain.astype(F32)
    return y.astype(x.dtype)


def modulate(x, shift, scale):
    return layer_norm(x) * (1 + scale) + shift


def to_heads(t, n):
    B, L, _ = t.shape
    return t.reshape(B, L, n, -1).transpose(0, 2, 1, 3)


def from_heads(t):
    B, H, L, d = t.shape
    return t.transpose(0, 2, 1, 3).reshape(B, L, H * d)


def _rev(t):
    return None if t is None else jnp.flip(t, axis=2)


def axial_rope_angles(L):
    rows = L // GRID_W
    row = jnp.repeat(jnp.arange(rows, dtype=F32), GRID_W)
    col = jnp.tile(jnp.arange(GRID_W, dtype=F32), rows)
    n_freq = MLA_ROPE // 4
    inv = ROPE_BASE ** (-jnp.arange(n_freq, dtype=F32) / n_freq)
    ang = jnp.concatenate([row[:, None] * inv, col[:, None] * inv], -1)
    return jnp.cos(ang), jnp.sin(ang)


def apply_rope(x, cos, sin):
    half = x.shape[-1] // 2
    x1, x2 = x[..., :half].astype(F32), x[..., half:].astype(F32)
    return jnp.concatenate([x1 * cos - x2 * sin, x2 * cos + x1 * sin], -1).astype(x.dtype)


def attend_blocks(q, k, v):
    B, H, Lq, dq = q.shape
    nb = Lq // Q_BLOCK
    scale = dq ** -0.5
    qb = q.reshape(B, H, nb, Q_BLOCK, dq).transpose(2, 0, 1, 3, 4)

    def one_block(qi):
        s = jnp.einsum('bhqd,bhkd->bhqk', qi, k).astype(F32) * scale
        p = jax.nn.softmax(s, axis=-1)
        return jnp.einsum('bhqk,bhkd->bhqd', p.astype(v.dtype), v)

    o = lax.map(one_block, qb)
    return o.transpose(1, 2, 0, 3, 4).reshape(B, H, Lq, v.shape[-1])


def _chunk(t):
    B, H, L, d = t.shape
    return t.reshape(B, H, L // GLA_CHUNK, GLA_CHUNK, d)


def gla_states(k, v, b, s0):
    b_last = b[:, :, :, -1:, :]
    delta = jnp.einsum('bhncd,bhnce->bhnde', k * jnp.exp(b_last - b), v)
    dec = jnp.exp(b_last[:, :, :, 0, :])

    def step(s, inp):
        d_n, delta_n = inp
        return d_n[..., None] * s + delta_n, s

    s_final, s_prev = lax.scan(step, s0, (jnp.moveaxis(dec, 2, 0), jnp.moveaxis(delta, 2, 0)))
    return jnp.moveaxis(s_prev, 0, 2), s_final


def gla_outputs(q, k, v, b, s_prev):
    C = q.shape[3]
    lower = jnp.tril(jnp.ones((C, C), bool))
    diff = b[:, :, :, :, None, :] - b[:, :, :, None, :, :]
    decay = jnp.exp(jnp.where(lower[:, :, None], diff, -jnp.inf))
    scores = jnp.einsum('bhnid,bhnjd,bhnijd->bhnij', q, k, decay)
    o = (jnp.einsum('bhnij,bhnje->bhnie', scores, v)
         + jnp.einsum('bhnid,bhnde->bhnie', q * jnp.exp(b), s_prev))
    B, H, N, _, dv = o.shape
    return o.reshape(B, H, N * C, dv)


def gla_direction(q, k, v, g, qc, kc, vc, gc):
    B, H, _, dk = k.shape
    s0 = jnp.zeros((B, H, dk, v.shape[-1]), F32)
    kc_, vc_ = _chunk(kc), _chunk(vc)
    bc = jnp.cumsum(_chunk(gc), axis=3)
    sc_prev, sc_final = gla_states(kc_, vc_, bc, s0)
    oc = None if qc is None else gla_outputs(_chunk(qc), kc_, vc_, bc, sc_prev)
    k_, v_ = _chunk(k), _chunk(v)
    b = jnp.cumsum(_chunk(g), axis=3)
    s_prev, _ = gla_states(k_, v_, b, sc_final)
    return gla_outputs(_chunk(q), k_, v_, b, s_prev), oc


def gla_keys(pk, pv, paf, pab, wa2_f, ba_f, wa2_b, ba_b):
    k = to_heads(pk, GLA_HEADS)
    v = to_heads(pv, GLA_HEADS)
    g_f = to_heads(jax.nn.log_sigmoid((paf @ wa2_f + ba_f).astype(F32)) / GLA_TAU, GLA_HEADS)
    g_b = to_heads(jax.nn.log_sigmoid((pab @ wa2_b + ba_b).astype(F32)) / GLA_TAU, GLA_HEADS)
    return k, v, g_f, g_b


def gla_query(pq):
    return to_heads(pq, GLA_HEADS) * GLA_DK ** -0.5


def gla_finish(o, r, norm_w):
    return from_heads(rms_norm(o, norm_w)).astype(r.dtype) * jax.nn.silu(r)


def mla_keys(pkva, pkr, kv_norm, w_ukv, rope):
    kv = to_heads(rms_norm(pkva, kv_norm) @ w_ukv, MLA_HEADS)
    k_nope, v = kv[..., :MLA_NOPE], kv[..., MLA_NOPE:]
    k_rope = pkr[:, None]
    if rope is not None:
        k_rope = apply_rope(k_rope, *rope)
    k_rope = jnp.broadcast_to(k_rope, k_nope.shape[:-1] + (MLA_ROPE,))
    return jnp.concatenate([k_nope, k_rope], -1), v


def mla_query(pqa, q_norm, w_uq, rope):
    q = to_heads(rms_norm(pqa, q_norm) @ w_uq, MLA_HEADS)
    if rope is not None:
        q = jnp.concatenate([q[..., :MLA_NOPE], apply_rope(q[..., MLA_NOPE:], *rope)], -1)
    return q


def short_conv3(x, w, b):
    xp = jnp.pad(x, ((0, 0), (1, 1), (0, 0)))
    return xp[:, :-2] * w[0] + xp[:, 1:-1] * w[1] + xp[:, 2:] * w[2] + b


def hyena_filters(L, w1, b1, w2, b2, w3, freq):
    t = jnp.linspace(0.0, 1.0, L, dtype=F32)[:, None]
    w = 2 * math.pi * jnp.arange(L, dtype=F32)[:, None] / L
    f = jnp.linspace(1e-4, HY_BANDS - 1, HY_BANDS, dtype=F32)
    z = jnp.concatenate([t, jnp.cos(f * w), -jnp.sin(f * w)], -1)
    fr = freq.astype(F32)
    h = jnp.sin(fr * (z @ w1.astype(F32) + b1.astype(F32)))
    h = jnp.sin(fr * (h @ w2.astype(F32) + b2.astype(F32)))
    h = (h @ w3.astype(F32)).reshape(L, HY_ORDER, HY_DIRS, HY_W)
    deltas = jnp.abs(jnp.linspace(math.log(HY_DECAY_TARGET) / HY_SLOW_PCT,
                                  math.log(HY_DECAY_TARGET) / HY_FAST_PCT, HY_W, dtype=F32))
    h = h * jnp.exp(-t * deltas)[:, None, None, :]
    return h / jnp.sum(jnp.abs(h), axis=(0, 2), keepdims=True)


def two_sided_fftconv(z, h_fwd, h_bwd, bias):
    B, L, C = z.shape
    k = jnp.concatenate([h_fwd, jnp.zeros((1, C), F32), jnp.flip(h_bwd[1:], 0)], 0)
    zf = jnp.fft.rfft(z.astype(F32), n=2 * L, axis=1)
    kf = jnp.fft.rfft(k, n=2 * L, axis=0)
    y = jnp.fft.irfft(zf * kf[None], n=2 * L, axis=1)[:, :L]
    return (y + z.astype(F32) * bias.astype(F32)).astype(z.dtype)


def hyena_branch(p, conv_w, conv_b, w1, b1, w2, b2, w3, freq, hbias):
    v, x1, x2 = jnp.split(short_conv3(p, conv_w, conv_b), 3, axis=-1)
    filt = hyena_filters(p.shape[1], w1, b1, w2, b2, w3, freq)
    z = x1 * two_sided_fftconv(v, filt[:, 0, 0], filt[:, 0, 1], hbias[0])
    return x2 * two_sided_fftconv(z, filt[:, 1, 0], filt[:, 1, 1], hbias[1])


def merge_branches(o_gla, o_mla, o_hy, gates, w_br_gla, w_br_mla, w_br_hy, w_out):
    g1, g2, g3 = jnp.split(jax.nn.sigmoid(gates.astype(F32)).astype(o_gla.dtype), 3, axis=-1)
    y = g1 * (o_gla @ w_br_gla) + g2 * (o_mla @ w_br_mla) + g3 * (o_hy @ w_br_hy)
    return y @ w_out


def token_mixer(h, hc, rope, with_ctx_out, w_in, gla_wa2_f, gla_ba_f, gla_wa2_b, gla_ba_b, gla_norm,
                mla_q_norm, mla_w_uq, mla_kv_norm, mla_w_ukv,
                hy_conv_w, hy_conv_b, hy_w1, hy_b1, hy_w2, hy_b2, hy_w3, hy_freq, hy_bias,
                w_br_gla, w_br_mla, w_br_hy, w_out):
    gk, gv, gaf, gab, mkva, mkr, gq, gr, mqa, hy, gates = jnp.split(h @ w_in, IN_OFFSETS, axis=-1)
    if with_ctx_out:
        ck, cv, caf, cab, ckva, ckr, cq, cr, cqa, chy, cgates = jnp.split(hc @ w_in, IN_OFFSETS, axis=-1)
    else:
        ck, cv, caf, cab, ckva, ckr = jnp.split(hc @ w_in[:, :KEY_COLS], IN_OFFSETS[:N_KEY_GROUPS - 1], axis=-1)
    gate_w = (gla_wa2_f, gla_ba_f, gla_wa2_b, gla_ba_b)
    k, v, g_f, g_b = gla_keys(gk, gv, gaf, gab, *gate_w)
    kc, vc, gc_f, gc_b = gla_keys(ck, cv, caf, cab, *gate_w)
    q = gla_query(gq)
    qc = gla_query(cq) if with_ctx_out else None
    o_f, oc_f = gla_direction(q, k, v, g_f, qc, kc, vc, gc_f)
    o_b, oc_b = gla_direction(_rev(q), _rev(k), _rev(v), _rev(g_b), _rev(qc), _rev(kc), _rev(vc), _rev(gc_b))
    o_gla = gla_finish(o_f + _rev(o_b), gr, gla_norm)
    mk, mv = mla_keys(mkva, mkr, mla_kv_norm, mla_w_ukv, rope)
    mkc, mvc = mla_keys(ckva, ckr, mla_kv_norm, mla_w_ukv, None)
    mq = mla_query(mqa, mla_q_norm, mla_w_uq, rope)
    o_mla = from_heads(attend_blocks(mq, jnp.concatenate([mkc, mk], 2), jnp.concatenate([mvc, mv], 2)))
    hy_w = (hy_conv_w, hy_conv_b, hy_w1, hy_b1, hy_w2, hy_b2, hy_w3, hy_freq, hy_bias)
    o_hy = hyena_branch(hy, *hy_w)
    br_w = (w_br_gla, w_br_mla, w_br_hy, w_out)
    y = merge_branches(o_gla, o_mla, o_hy, gates, *br_w)
    if not with_ctx_out:
        return y, None
    oc_gla = gla_finish(oc_f + _rev(oc_b), cr, gla_norm)
    oc_mla = from_heads(attend_blocks(mla_query(cqa, mla_q_norm, mla_w_uq, None), mkc, mvc))
    oc_hy = hyena_branch(chy, *hy_w)
    yc = merge_branches(oc_gla, oc_mla, oc_hy, cgates, *br_w)
    return y, yc


def moe_ffn(h, router_w, router_b, w1, b1, w2, b2):
    N, D = h.shape
    logits = (h @ router_w + router_b).astype(F32)
    top_val, top_idx = lax.top_k(logits, TOP_K)
    gates = jax.nn.softmax(top_val, axis=-1)
    NK = N * TOP_K
    flat_e = top_idx.reshape(NK)
    order = jnp.argsort(flat_e)
    sorted_e = flat_e[order]
    sorted_tok = (order // TOP_K).astype(jnp.int32)
    counts = jnp.bincount(flat_e, length=N_EXPERTS)
    padded = (counts + MOE_BLOCK - 1) // MOE_BLOCK * MOE_BLOCK
    pad_end = jnp.cumsum(padded)
    pad_start = pad_end - padded
    start = jnp.cumsum(counts) - counts
    dest = pad_start[sorted_e] + (jnp.arange(NK) - start[sorted_e])
    n_blocks = -(-NK // MOE_BLOCK) + N_EXPERTS
    buf_tok = jnp.zeros((n_blocks * MOE_BLOCK,), jnp.int32).at[dest].set(sorted_tok)
    block_e = jnp.minimum(jnp.searchsorted(pad_end, jnp.arange(n_blocks) * MOE_BLOCK, side='right'), N_EXPERTS - 1)
    xb = h[buf_tok].reshape(n_blocks, MOE_BLOCK, D)

    def expert_block(args):
        xi, e = args
        glu, lin = jnp.split(xi @ w1[e] + b1[e], 2, axis=-1)
        glu = jnp.minimum(glu, SWIGLU_LIMIT)
        lin = jnp.clip(lin, -SWIGLU_LIMIT, SWIGLU_LIMIT)
        act = glu * jax.nn.sigmoid(SWIGLU_ALPHA * glu) * (lin + 1)
        return act @ w2[e] + b2[e]

    yb = lax.map(expert_block, (xb, block_e)).reshape(-1, D)
    y_assign = yb[dest] * gates.reshape(NK)[order][:, None].astype(yb.dtype)
    return jax.ops.segment_sum(y_assign, sorted_tok, num_segments=N)


def setup_inputs(seed: int = 0) -> dict:
    key = jax.random.key(seed)
    ks = iter(jax.random.split(key, 48))

    def nrm(shape, scale):
        return jax.random.normal(next(ks), shape, F32) * scale

    def gain(shape):
        return 1.0 + nrm(shape, 0.05)

    L_, D = DEPTH, D_MODEL
    return {
        'x': nrm((BATCH, SEQ, D), 1.0),
        'c': nrm((BATCH, D), 1.0),
        'ctx': nrm((BATCH, CTX_LEN, D), 1.0),
        'c_ctx': nrm((D,), 1.0),
        'ada_w': nrm((L_, D, 6 * D), 0.5 * D ** -0.5),
        'ada_b': nrm((L_, 6 * D), 0.02),
        'w_in': nrm((L_, D, IN_TOTAL), D ** -0.5),
        'gla_wa2_f': nrm((L_, GLA_RANK, GLA_HEADS * GLA_DK), GLA_RANK ** -0.5),
        'gla_ba_f': nrm((L_, GLA_HEADS * GLA_DK), 0.1),
        'gla_wa2_b': nrm((L_, GLA_RANK, GLA_HEADS * GLA_DK), GLA_RANK ** -0.5),
        'gla_ba_b': nrm((L_, GLA_HEADS * GLA_DK), 0.1),
        'gla_norm': gain((L_, GLA_DV)),
        'mla_q_norm': gain((L_, MLA_Q_RANK)),
        'mla_w_uq': nrm((L_, MLA_Q_RANK, MLA_HEADS * (MLA_NOPE + MLA_ROPE)), MLA_Q_RANK ** -0.5),
        'mla_kv_norm': gain((L_, MLA_KV_RANK)),
        'mla_w_ukv': nrm((L_, MLA_KV_RANK, MLA_HEADS * (MLA_NOPE + MLA_DV)), MLA_KV_RANK ** -0.5),
        'hy_conv_w': nrm((L_, 3, 3 * HY_W), 3 ** -0.5),
        'hy_conv_b': nrm((L_, 3 * HY_W), 0.02),
        'hy_w1': nrm((L_, HY_EMB, HY_FFN), HY_EMB ** -0.5),
        'hy_b1': nrm((L_, HY_FFN), 0.1),
        'hy_w2': nrm((L_, HY_FFN, HY_FFN), HY_FFN ** -0.5),
        'hy_b2': nrm((L_, HY_FFN), 0.1),
        'hy_w3': nrm((L_, HY_FFN, HY_ORDER * HY_DIRS * HY_W), HY_FFN ** -0.5),
        'hy_freq': gain((L_, HY_FFN)),
        'hy_bias': nrm((L_, HY_ORDER, HY_W), 1.0),
        'w_br_gla': nrm((L_, BRANCH_W, D), BRANCH_W ** -0.5 * DEEPNORM_BETA),
        'w_br_mla': nrm((L_, BRANCH_W, D), BRANCH_W ** -0.5 * DEEPNORM_BETA),
        'w_br_hy': nrm((L_, BRANCH_W, D), BRANCH_W ** -0.5 * DEEPNORM_BETA),
        'w_out': nrm((L_, D, D), D ** -0.5 * DEEPNORM_BETA),
        'ln1_g': gain((L_, D)),
        'ln1_b': nrm((L_, D), 0.02),
        'ln2_g': gain((L_, D)),
        'ln2_b': nrm((L_, D), 0.02),
        'router_w': nrm((L_, D, N_EXPERTS), D ** -0.5),
        'router_b': nrm((L_, N_EXPERTS), 0.01),
        'moe_w1': nrm((L_, N_EXPERTS, D, 2 * D_FF), D ** -0.5),
        'moe_b1': nrm((L_, N_EXPERTS, 2 * D_FF), 0.02),
        'moe_w2': nrm((L_, N_EXPERTS, D_FF, D), D_FF ** -0.5 * DEEPNORM_BETA),
        'moe_b2': nrm((L_, N_EXPERTS, D), 0.02),
    }


def reference(x, c, ctx, c_ctx, ada_w, ada_b, w_in, gla_wa2_f, gla_ba_f, gla_wa2_b, gla_ba_b, gla_norm,
              mla_q_norm, mla_w_uq, mla_kv_norm, mla_w_ukv, hy_conv_w, hy_conv_b, hy_w1, hy_b1, hy_w2, hy_b2,
              hy_w3, hy_freq, hy_bias, w_br_gla, w_br_mla, w_br_hy, w_out, ln1_g, ln1_b, ln2_g, ln2_b,
              router_w, router_b, moe_w1, moe_b1, moe_w2, moe_b2):
    B, L, D = x.shape
    CL = ctx.shape[1]
    rope = axial_rope_angles(L)
    xc = ctx
    c_act = jax.nn.silu(c)
    cc_act = jax.nn.silu(c_ctx)
    for l in range(DEPTH):
        last = l == DEPTH - 1
        sh1, sc1, g1, sh2, sc2, g2 = jnp.split((c_act @ ada_w[l] + ada_b[l])[:, None, :], 6, axis=-1)
        csh1, csc1, cg1, csh2, csc2, cg2 = jnp.split(cc_act @ ada_w[l] + ada_b[l], 6, axis=-1)
        y, yc = token_mixer(modulate(x, sh1, sc1), modulate(xc, csh1, csc1), rope, not last,
                            w_in[l], gla_wa2_f[l], gla_ba_f[l], gla_wa2_b[l], gla_ba_b[l], gla_norm[l],
                            mla_q_norm[l], mla_w_uq[l], mla_kv_norm[l], mla_w_ukv[l],
                            hy_conv_w[l], hy_conv_b[l], hy_w1[l], hy_b1[l], hy_w2[l], hy_b2[l], hy_w3[l],
                            hy_freq[l], hy_bias[l], w_br_gla[l], w_br_mla[l], w_br_hy[l], w_out[l])
        x = layer_norm(DEEPNORM_ALPHA * x + g1 * y, ln1_g[l], ln1_b[l])
        h = modulate(x, sh2, sc2).reshape(B * L, D)
        moe_w = (router_w[l], router_b[l], moe_w1[l], moe_b1[l], moe_w2[l], moe_b2[l])
        if last:
            f = moe_ffn(h, *moe_w).reshape(B, L, D)
            x = layer_norm(DEEPNORM_ALPHA * x + g2 * f, ln2_g[l], ln2_b[l])
        else:
            xc = layer_norm(DEEPNORM_ALPHA * xc + cg1 * yc, ln1_g[l], ln1_b[l])
            hc = modulate(xc, csh2, csc2).reshape(B * CL, D)
            f = moe_ffn(jnp.concatenate([h, hc], 0), *moe_w)
            x = layer_norm(DEEPNORM_ALPHA * x + g2 * f[:B * L].reshape(B, L, D), ln2_g[l], ln2_b[l])
            xc = layer_norm(DEEPNORM_ALPHA * xc + cg2 * f[B * L:].reshape(B, CL, D), ln2_g[l], ln2_b[l])
    return x
```

```cpp
#include <hip/hip_runtime.h>
#include <cstdio>
#include <cstdint>

#ifndef MK_PER_PHASE
#define MK_PER_PHASE 0
#endif

constexpr int D = 1024, NB = 2, SEQ = 8192, CTXL = 256, NLAT = NB * SEQ, NCTX = NB * CTXL, MALL = NLAT + NCTX;
constexpr int KEYS = CTXL + SEQ;
constexpr int INTOT = 6848, INPAD = 6912;
constexpr int O_GK = 0, O_GV = 256, O_GAF = 768, O_GAB = 784, O_MKVA = 800, O_MKR = 1056, O_GQ = 1088, O_GR = 1344, O_MQA = 1856, O_HY = 2240, O_GATE = 3776;
constexpr int NEXP = 32, TOPK = 4, NSLOT = MALL * TOPK;
constexpr int XG_ROWS = 75776;
constexpr int NPANEL_MAX = XG_ROWS / 256;
constexpr float LN_EPS = 1e-5f, RMS_EPS = 1e-6f, DN_ALPHA = 1.41421356237f;
constexpr int FFTN = 16384;

constexpr size_t al256(size_t x) { return (x + 255) & ~(size_t)255; }
constexpr size_t WS_CTL = 0, CTL_ZERO_BYTES = 1u << 20;
constexpr size_t WS_MODP = CTL_ZERO_BYTES;
constexpr size_t WS_MOD = WS_MODP + al256((size_t)8 * 2 * 3 * 6144 * 4);
constexpr size_t WS_ROPE = WS_MOD + al256((size_t)2 * 3 * 6144 * 4);
constexpr size_t WS_TW = WS_ROPE + al256((size_t)8192 * 16 * 2 * 4);
constexpr size_t WS_HPART = WS_TW + al256((size_t)FFTN * 8);
constexpr size_t WS_HPARTC = WS_HPART + al256((size_t)256 * 1024 * 4);
constexpr size_t WS_TOPE = WS_HPARTC + al256((size_t)8 * 1024 * 4);
constexpr size_t WS_TOPG = WS_TOPE + al256((size_t)NSLOT * 4);
constexpr size_t WS_SPOS = WS_TOPG + al256((size_t)NSLOT * 4);
constexpr size_t WS_RSLOT = WS_SPOS + al256((size_t)NSLOT * 4);
constexpr size_t WS_GDEC = WS_RSLOT + al256((size_t)XG_ROWS * 4);
constexpr size_t WB_IN = 0, WB_UQ = WB_IN + (size_t)INPAD * 1024 * 2, WB_UKV = WB_UQ + (size_t)768 * 384 * 2, WB_BR = WB_UKV + (size_t)1024 * 256 * 2,
                 WB_OUT = WB_BR + (size_t)3 * 1024 * 512 * 2, WB_M1 = WB_OUT + (size_t)1024 * 1024 * 2, WB_M2 = WB_M1 + (size_t)32 * 2048 * 1024 * 2,
                 WB_LAYER = WB_M2 + (size_t)32 * 1024 * 1024 * 2;
constexpr size_t WS_W = WS_GDEC + al256((size_t)16 * 132 * 64 * 4);
constexpr size_t WS_XS = WS_W + 2 * WB_LAYER;
constexpr size_t WS_XPRE = WS_XS + (size_t)MALL * D * 4;
constexpr size_t WS_HBF = WS_XPRE + (size_t)MALL * D * 4;
constexpr size_t WS_P = WS_HBF + (size_t)MALL * D * 2;
constexpr size_t WS_XG = WS_P;
constexpr size_t WS_NQ = WS_P + (size_t)MALL * INPAD * 2;
constexpr size_t WS_NKV = WS_NQ + (size_t)MALL * 384 * 2;
constexpr size_t WS_QB = WS_NKV + (size_t)MALL * 256 * 2;
constexpr size_t WS_KB = WS_QB + (size_t)MALL * 768 * 2;
constexpr size_t WS_VT = WS_KB + (size_t)16 * KEYS * 96 * 2;
constexpr size_t WS_AF = WS_VT + (size_t)16 * 64 * KEYS * 2;
constexpr size_t WS_AB = WS_AF + (size_t)MALL * 256 * 4;
constexpr size_t WS_YM = WS_AB + (size_t)MALL * 256 * 4;
constexpr size_t WS_YMB = WS_YM + (size_t)MALL * D * 4;
constexpr size_t WS_U = WS_YMB + (size_t)MALL * D * 2;
constexpr size_t WS_R1 = WS_U + (size_t)MALL * 3072 * 2;
constexpr size_t WS_OF = WS_R1;
constexpr size_t WS_GST = WS_R1;
constexpr size_t WS_OB = WS_OF + (size_t)MALL * 512 * 4;
constexpr size_t WS_HYT = WS_OB + (size_t)MALL * 512 * 4;
constexpr size_t WS_HYTC = WS_HYT + (size_t)1536 * NLAT * 2;
constexpr size_t WS_OHYT = WS_HYTC + (size_t)1536 * NCTX * 2;
constexpr size_t WS_OBR = WS_OHYT + (size_t)512 * NLAT * 2;
constexpr size_t WS_R1_END = WS_OBR + (size_t)3 * MALL * 512 * 2;
constexpr size_t WS_YSLOT = WS_R1;
static_assert(WS_YSLOT + (size_t)NSLOT * D * 2 <= WS_R1_END, "YSLOT overlay");
static_assert(WS_GST + (size_t)16 * 132 * 8192 * 4 <= WS_HYT, "GST overlay");
constexpr size_t WS_FILT = WS_R1_END;
constexpr size_t WS_FILTC = WS_FILT + (size_t)4 * 512 * 8192 * 4;
constexpr size_t WS_R2 = WS_FILTC + (size_t)4 * 512 * 256 * 4;
constexpr size_t WS_K0S = WS_R2;
constexpr size_t WS_K1S = WS_K0S + (size_t)512 * FFTN * 8;
constexpr size_t WS_R2_END = WS_R2 + (size_t)XG_ROWS * D * 2;
constexpr size_t WS_ACT = WS_R2;
static_assert(WS_ACT + (size_t)XG_ROWS * D * 2 <= WS_R2_END && WS_K1S + (size_t)512 * FFTN * 8 <= WS_R2_END, "ACT overlay");
static_assert((size_t)XG_ROWS * D * 2 <= (size_t)MALL * INPAD * 2, "XG overlay");
constexpr size_t WS_END = WS_R2_END;

constexpr int CW_BAR = 4096;
constexpr int CW_CNT = 8192;
constexpr int CW_QCTR = 8192 + 2 * 32 * 64;
constexpr int CW_DBG = 16384;
static_assert(CW_QCTR + 8 * 64 <= CW_DBG, "ctl map");

constexpr int LDS_STAGE = 147456;
constexpr int LDS_TAB = LDS_STAGE;
constexpr int LDS_MISC = LDS_STAGE + 4096;
constexpr int LDS_BYTES = 155648;

#define GAS __attribute__((address_space(1)))
#define LAS __attribute__((address_space(3)))
typedef unsigned short bf16;
typedef unsigned v4u __attribute__((ext_vector_type(4)));
typedef unsigned v2u __attribute__((ext_vector_type(2)));
typedef float f32x2 __attribute__((ext_vector_type(2)));
typedef float f32x4 __attribute__((ext_vector_type(4)));
typedef float f32x16 __attribute__((ext_vector_type(16)));
typedef short bf16x8 __attribute__((ext_vector_type(8)));
#define LDS_WAIT() asm volatile("s_waitcnt lgkmcnt(0)" ::: "memory")
#define VM_WAIT() asm volatile("s_waitcnt vmcnt(0)" ::: "memory")
__device__ __forceinline__ unsigned f2bf(float f) { unsigned u = __builtin_bit_cast(unsigned, f); return (u + 0x7fffu + ((u >> 16) & 1u)) >> 16; }
__device__ __forceinline__ unsigned pk2(float lo, float hi) { return f2bf(lo) | (f2bf(hi) << 16); }
__device__ __forceinline__ float bf2f(unsigned h) { return __builtin_bit_cast(float, h << 16); }
__device__ __forceinline__ float bflo(unsigned w) { return __builtin_bit_cast(float, w << 16); }
__device__ __forceinline__ float bfhi(unsigned w) { return __builtin_bit_cast(float, w & 0xffff0000u); }
__device__ __forceinline__ float wave_sum(float v) {
#pragma unroll
    for (int o = 1; o < 64; o <<= 1) v += __shfl_xor(v, o);
    return v;
}
__device__ __forceinline__ float wave_max(float v) {
#pragma unroll
    for (int o = 1; o < 64; o <<= 1) v = fmaxf(v, __shfl_xor(v, o));
    return v;
}
__device__ __forceinline__ float sigmoidf_(float x) { return 1.f / (1.f + __expf(-x)); }

namespace pg8 {
#define PG8_LAS __attribute__((address_space(3)))
typedef unsigned short bf16_t;
typedef short bf16x8 __attribute__((ext_vector_type(8)));
typedef float f32x4 __attribute__((ext_vector_type(4)));
typedef unsigned u32x4 __attribute__((ext_vector_type(4)));
constexpr int BM = 256, BK = 64, HALF = 128, HTB = HALF * BK * 2  , STAGE_BYTES = 8 * HTB, NXCD = 8, WGM = 8;

__host__ __device__ __forceinline__ int lds_byte(int r, int c) { const int st = (r >> 4) * 2 + (c >> 5), rr = r & 15, cc = c & 31, ob = rr * 64 + cc * 2; return st * 1024 + (ob ^ (((ob >> 9) & 1) << 5)); }
__host__ __device__ __forceinline__ void stage_rc(int b, int& R, int& C) { const int st = b / 1024, sb = b % 1024, swz = sb ^ (((sb >> 9) & 1) << 5); R = (st >> 1) * 16 + swz / 64; C = (st & 1) * 32 + (swz % 64) / 2; }
__host__ __device__ __forceinline__ int perm32(int rho) { const int n = rho >> 4, i = rho & 15; return 8 * (i >> 2) + 4 * n + (i & 3); }

struct Unit { int pm, pn; };
struct Gemm { const bf16_t* A; const bf16_t* Bt; int M, N, K; };

struct StaticOrder {
    int nM, nN, nwg, G, c;
    __host__ __device__ void init(int M, int N, int G_, int c_) { nM = M / BM; nN = N / BM; nwg = nM * nN; G = G_; c = c_; }
    __host__ __device__ bool next(int i, Unit& u) const {
        const long L = (long)i * G + c; if (L >= nwg) return false;
        int wgid = (int)L; { const int q = nwg / NXCD, r = nwg % NXCD, xcd = wgid % NXCD, off = wgid / NXCD; wgid = (xcd < r ? xcd * (q + 1) : r * (q + 1) + (xcd - r) * q) + off; }
        const int nig = WGM * nN, gid = wgid / nig, fm = gid * WGM, gsz = (nM - fm) < WGM ? (nM - fm) : WGM;
        u.pm = fm + ((wgid % nig) % gsz); u.pn = (wgid % nig) / gsz; return true;
    }
    __device__ __forceinline__ void a_ready(const Unit&) const {}
    __device__ __forceinline__ void done(const Unit&) const {}
};

__device__ __forceinline__ unsigned cvt_pk_bf16(float lo, float hi) { unsigned r; asm volatile("v_cvt_pk_bf16_f32 %0, %1, %2" : "=v"(r) : "v"(lo), "v"(hi)); return r; }
typedef float f32x2 __attribute__((ext_vector_type(2)));

typedef unsigned u32x2e __attribute__((ext_vector_type(2)));
__device__ __forceinline__ unsigned pkbf(float lo, float hi) { return cvt_pk_bf16(lo, hi); }

struct EpiP {
    static constexpr bool PERM = true, AFTER_DRAIN = false;
    __attribute__((address_space(1))) bf16_t* O; int ldc;
    __device__ __forceinline__ void operator()(const f32x4 (&acc)[2][2][4][2], const Unit& u, int wr, int wc, int fr, int fq) const {
        const int row0 = u.pm * BM + wr * 64 + fr, col0 = u.pn * BM + wc * 32 + 8 * fq;
#pragma unroll
        for (int ai = 0; ai < 2; ++ai)
#pragma unroll
            for (int m = 0; m < 4; ++m) { __attribute__((address_space(1))) bf16_t* rowp = O + (size_t)(row0 + ai * HALF + m * 16) * ldc + col0;
#pragma unroll
                for (int bj = 0; bj < 2; ++bj) { const f32x4 v0 = acc[ai][bj][m][0], v1 = acc[ai][bj][m][1];
                    u32x4 w; w.x = pkbf(v0[0], v0[1]); w.y = pkbf(v0[2], v0[3]); w.z = pkbf(v1[0], v1[1]); w.w = pkbf(v1[2], v1[3]);
                    *(__attribute__((address_space(1))) u32x4*)(rowp + bj * HALF) = w; } }
    }
};

struct EpiU {
    static constexpr bool PERM = true, AFTER_DRAIN = false;
    __attribute__((address_space(1))) bf16_t* O; int sPM;
    __device__ __forceinline__ void operator()(const f32x4 (&acc)[2][2][4][2], const Unit& u, int wr, int wc, int fr, int fq) const {
        const int pm = u.pm % sPM; const int row0 = pm * BM + wr * 64 + fr, col0 = u.pn * BM + wc * 32 + 8 * fq;
#pragma unroll
        for (int ai = 0; ai < 2; ++ai)
#pragma unroll
            for (int m = 0; m < 4; ++m) { __attribute__((address_space(1))) bf16_t* rowp = O + (size_t)(row0 + ai * HALF + m * 16) * 3072 + col0;
#pragma unroll
                for (int bj = 0; bj < 2; ++bj) { const f32x4 v0 = acc[ai][bj][m][0], v1 = acc[ai][bj][m][1];
                    u32x4 w; w.x = pkbf(v0[0], v0[1]); w.y = pkbf(v0[2], v0[3]); w.z = pkbf(v1[0], v1[1]); w.w = pkbf(v1[2], v1[3]);
                    *(__attribute__((address_space(1))) u32x4*)(rowp + bj * HALF) = w; } }
    }
};

struct EpiNull {
    static constexpr bool PERM = true, AFTER_DRAIN = false;
    __device__ __forceinline__ void operator()(const f32x4 (&acc)[2][2][4][2], const Unit& u, int wr, int wc, int fr, int fq) const {
#pragma unroll
        for (int ai = 0; ai < 2; ++ai)
#pragma unroll
            for (int bj = 0; bj < 2; ++bj)
#pragma unroll
                for (int m = 0; m < 4; ++m)
#pragma unroll
                    for (int n = 0; n < 2; ++n) asm volatile("" :: "v"(acc[ai][bj][m][n]));
    }
};

struct EpiQ {
    static constexpr bool PERM = false, AFTER_DRAIN = false;
    bf16_t* O; const float* rope; int nlat;
    __device__ __forceinline__ void operator()(const f32x4 (&acc)[2][2][4][2], const Unit& u, int wr, int wc, int fr, int fq) const {
        const int row0 = u.pm * BM + wr * 64 + fr;
#pragma unroll
        for (int bj = 0; bj < 2; ++bj) {
            const int g32 = u.pn * 8 + bj * 4 + wc; const bool isrope = (g32 % 3) == 2; const int colb = g32 * 32 + 4 * fq;
#pragma unroll
            for (int ai = 0; ai < 2; ++ai)
#pragma unroll
                for (int m = 0; m < 4; ++m) { const int row = row0 + ai * HALF + m * 16;
                    f32x4 v0 = acc[ai][bj][m][0], v1 = acc[ai][bj][m][1];
                    if (isrope && row < nlat) { const float* cs = rope + ((size_t)(row & 8191) * 16 + 4 * fq) * 2;
                        const f32x4 c01 = *(const f32x4*)cs, c23 = *(const f32x4*)(cs + 4);
                        const float c[4] = {c01[0], c01[2], c23[0], c23[2]}, s[4] = {c01[1], c01[3], c23[1], c23[3]};
                        f32x4 a, b;
#pragma unroll
                        for (int i = 0; i < 4; ++i) { a[i] = v0[i] * c[i] - v1[i] * s[i]; b[i] = v1[i] * c[i] + v0[i] * s[i]; }
                        v0 = a; v1 = b; }
                    bf16_t* p = O + (size_t)row * 768 + colb;
                    u32x2e w0, w1; w0.x = pkbf(v0[0], v0[1]); w0.y = pkbf(v0[2], v0[3]); w1.x = pkbf(v1[0], v1[1]); w1.y = pkbf(v1[2], v1[3]);
                    *(u32x2e*)p = w0; *(u32x2e*)(p + 16) = w1; }
        }
    }
};

struct EpiKV {
    static constexpr bool PERM = false, AFTER_DRAIN = false;
    __attribute__((address_space(1))) bf16_t* KB; __attribute__((address_space(1))) bf16_t* VT; int nlat, keys, ctxl;
    __device__ __forceinline__ void operator()(const f32x4 (&acc)[2][2][4][2], const Unit& u, int wr, int wc, int fr, int fq) const {
        const int row0 = u.pm * BM + wr * 64 + fr;
#pragma unroll
        for (int ai = 0; ai < 2; ++ai)
#pragma unroll
            for (int m = 0; m < 4; ++m) { const int row = row0 + ai * HALF + m * 16;
                int b, key; if (row < nlat) { b = row >> 13; key = ctxl + (row & 8191); } else { const int r2 = row - nlat; b = r2 >> 8; key = r2 & 255; }
#pragma unroll
                for (int bj = 0; bj < 2; ++bj) { const int head = u.pn * 2 + bj; const size_t bh = (size_t)(b * 8 + head);
#pragma unroll
                    for (int n = 0; n < 2; ++n) { const f32x4 v = acc[ai][bj][m][n]; const int cw = (wc & 1) * 32 + n * 16 + 4 * fq;
                        if (wc < 2) { u32x2e w; w.x = pkbf(v[0], v[1]); w.y = pkbf(v[2], v[3]); *(__attribute__((address_space(1))) u32x2e*)(KB + (bh * keys + key) * 96 + cw) = w; }
                        else { __attribute__((address_space(1))) bf16_t* p = VT + (bh * 64 + cw) * keys + key; const unsigned w0 = pkbf(v[0], v[1]), w1 = pkbf(v[2], v[3]);
                            p[0] = (bf16_t)(w0 & 0xffff); p[(size_t)keys] = (bf16_t)(w0 >> 16); p[(size_t)2 * keys] = (bf16_t)(w1 & 0xffff); p[(size_t)3 * keys] = (bf16_t)(w1 >> 16); } } }
                asm volatile("" ::: "memory"); }
    }
};

struct EpiMerge {
    static constexpr bool PERM = false, AFTER_DRAIN = false;
    const bf16_t* P; float* YM; bf16_t* YMB; int nPM, ldp, ogate;
    __device__ __forceinline__ void operator()(const f32x4 (&acc)[2][2][4][2], const Unit& u, int wr, int wc, int fr, int fq) const {
        const int br = u.pm / nPM, pm = u.pm - br * nPM, pn = u.pn & 3;
        const int row0 = pm * BM + wr * 64 + fr;
#pragma unroll
        for (int ai = 0; ai < 2; ++ai)
#pragma unroll
            for (int m = 0; m < 4; ++m) { const int row = row0 + ai * HALF + m * 16;
#pragma unroll
                for (int bj = 0; bj < 2; ++bj)
#pragma unroll
                    for (int n = 0; n < 2; ++n) { const int col = pn * BM + bj * HALF + wc * 32 + n * 16 + 4 * fq;
                        const u32x2e gw = *(const u32x2e*)(P + (size_t)row * ldp + ogate + br * 1024 + col);
                        const float g0 = __builtin_bit_cast(float, gw.x << 16), g1 = __builtin_bit_cast(float, gw.x & 0xffff0000u), g2 = __builtin_bit_cast(float, gw.y << 16), g3 = __builtin_bit_cast(float, gw.y & 0xffff0000u);
                        f32x4 v = acc[ai][bj][m][n];
                        v[0] *= 1.f / (1.f + __expf(-g0)); v[1] *= 1.f / (1.f + __expf(-g1)); v[2] *= 1.f / (1.f + __expf(-g2)); v[3] *= 1.f / (1.f + __expf(-g3));
                        float* yp = YM + (size_t)row * 1024 + col;
                        if (br == 0) *(f32x4*)yp = v;
                        else if (br == 1) { const f32x4 o = *(const f32x4*)yp; *(f32x4*)yp = o + v; }
                        else { const f32x4 o = *(const f32x4*)yp + v; u32x2e w; w.x = pkbf(o[0], o[1]); w.y = pkbf(o[2], o[3]); *(u32x2e*)(YMB + (size_t)row * 1024 + col) = w; } } }
    }
};

struct EpiOut {
    static constexpr bool PERM = false, AFTER_DRAIN = false;
    const __attribute__((address_space(1))) float* XL; const __attribute__((address_space(1))) float* XC; __attribute__((address_space(1))) float* XPRE; const __attribute__((address_space(1))) float* mod; int nlat; float alpha;
    __device__ __forceinline__ void operator()(const f32x4 (&acc)[2][2][4][2], const Unit& u, int wr, int wc, int fr, int fq) const {
        const int row0 = u.pm * BM + wr * 64 + fr;
#pragma unroll
        for (int ai = 0; ai < 2; ++ai)
#pragma unroll
            for (int m = 0; m < 4; ++m) { const int row = row0 + ai * HALF + m * 16; const int mi = row < nlat ? (row >> 13) : 2; const __attribute__((address_space(1))) float* xr = (row < nlat ? XL : XC) + (size_t)row * 1024;
#pragma unroll
                for (int bj = 0; bj < 2; ++bj)
#pragma unroll
                    for (int n = 0; n < 2; ++n) { const int col = u.pn * BM + bj * HALF + wc * 32 + n * 16 + 4 * fq;
                        const f32x4 g = *(const __attribute__((address_space(1))) f32x4*)(mod + mi * 6144 + 2048 + col), x = *(const __attribute__((address_space(1))) f32x4*)(xr + col);
                        *(__attribute__((address_space(1))) f32x4*)(XPRE + (size_t)row * 1024 + col) = x * alpha + g * acc[ai][bj][m][n]; } }
    }
};

struct EpiMoe1 {
    static constexpr bool PERM = false, AFTER_DRAIN = false;
    __attribute__((address_space(1))) bf16_t* ACT; const __attribute__((address_space(1))) float* b1;
    __device__ __forceinline__ void operator()(const f32x4 (&acc)[2][2][4][2], const Unit& u, int wr, int wc, int fr, int fq) const {
        const int e = u.pn >> 3, j = u.pn & 7; const int row0 = u.pm * BM + wr * 64 + fr; const __attribute__((address_space(1))) float* be = b1 + (size_t)e * 2048;
        const int colb = 128 * j + wc * 32 + 4 * fq;
        const f32x4 bg0 = *(const __attribute__((address_space(1))) f32x4*)(be + colb), bl0 = *(const __attribute__((address_space(1))) f32x4*)(be + 1024 + colb), bg1 = *(const __attribute__((address_space(1))) f32x4*)(be + colb + 16), bl1 = *(const __attribute__((address_space(1))) f32x4*)(be + 1024 + colb + 16);
#pragma unroll
        for (int ai = 0; ai < 2; ++ai)
#pragma unroll
            for (int m = 0; m < 4; ++m) { const int row = row0 + ai * HALF + m * 16; __attribute__((address_space(1))) bf16_t* op = ACT + (size_t)row * 1024 + colb;
#pragma unroll
                for (int n = 0; n < 2; ++n) { const f32x4 g = acc[ai][0][m][n] + (n ? bg1 : bg0), l = acc[ai][1][m][n] + (n ? bl1 : bl0); f32x4 o;
#pragma unroll
                    for (int i = 0; i < 4; ++i) { const float gg = fminf(g[i], 7.f), ll = fminf(fmaxf(l[i], -7.f), 7.f);
                        o[i] = gg * __builtin_amdgcn_rcpf(1.f + __builtin_amdgcn_exp2f(-1.702f * 1.4426950408889634f * gg)) * (ll + 1.f); }
                    u32x2e w; w.x = pkbf(o[0], o[1]); w.y = pkbf(o[2], o[3]); *(__attribute__((address_space(1))) u32x2e*)(op + n * 16) = w; }
                __builtin_amdgcn_sched_barrier(0); }
    }
};

struct EpiMoe2 {
    static constexpr bool PERM = false, AFTER_DRAIN = false;
    __attribute__((address_space(1))) bf16_t* YSLOT; const __attribute__((address_space(1))) float* b2; const __attribute__((address_space(1))) int* rslot; const __attribute__((address_space(1))) float* gate;
    __device__ __forceinline__ void operator()(const f32x4 (&acc)[2][2][4][2], const Unit& u, int wr, int wc, int fr, int fq) const {
        const int e = u.pn >> 2, j = u.pn & 3; const int row0 = u.pm * BM + wr * 64 + fr; const __attribute__((address_space(1))) float* be = b2 + (size_t)e * 1024;
#pragma unroll
        for (int ai = 0; ai < 2; ++ai)
#pragma unroll
            for (int m = 0; m < 4; ++m) { const int row = row0 + ai * HALF + m * 16; const int slot = rslot[row];
                if (slot >= 0) { const float gt = gate[slot];
#pragma unroll
                    for (int bj = 0; bj < 2; ++bj)
#pragma unroll
                        for (int n = 0; n < 2; ++n) { const int col = j * BM + bj * HALF + wc * 32 + n * 16 + 4 * fq;
                            const f32x4 o = (acc[ai][bj][m][n] + *(const __attribute__((address_space(1))) f32x4*)(be + col)) * gt;
                            u32x2e w; w.x = pkbf(o[0], o[1]); w.y = pkbf(o[2], o[3]); *(__attribute__((address_space(1))) u32x2e*)(YSLOT + (size_t)slot * 1024 + col) = w; } }
                __builtin_amdgcn_sched_barrier(0); }
    }
};

struct MergeOrder {
    int nPM, sPM, G, c;
    __device__ __forceinline__ bool next(int i, Unit& u) const {
        const int L = i * G + c; if (L >= nPM * 12) return false;
        const int t = L / 3, br = L - 3 * t, pm = t >> 2, pn = t & 3; u.pm = br * sPM + pm; u.pn = br * 4 + pn; return true;
    }
    __device__ __forceinline__ void a_ready(const Unit&) const {}
    __device__ __forceinline__ void done(const Unit&) const {}
};
template <int nN> struct MoeOrder {
    const PG8_LAS int* ptab; int npanel, G, c;
    __device__ __forceinline__ bool next(int i, Unit& u) const {
        constexpr int PB = 32 / nN; int pm, pn;
        if (G == 256) { const int x = c & 7, w = c >> 3, s = i * 8 + x; pm = s * PB + w / nN; pn = w % nN; }
        else { const int L = i * G + c; pm = L / nN; pn = L - pm * nN; }
        if (pm >= npanel) return false;
        const int e = __builtin_amdgcn_readfirstlane(ptab[pm]);
        u.pm = pm; u.pn = e * nN + pn; return true;
    }
    __device__ __forceinline__ void a_ready(const Unit&) const {}
    __device__ __forceinline__ void done(const Unit&) const {}
};
template <class Epi, class Sched, bool ALIGN_EPI = false, bool SP2 = false>
__device__ __forceinline__ void gemm_phase(PG8_LAS unsigned char* lds, const Gemm g, const Sched& S, const Epi& E, const int tid) {
    const int wid = __builtin_amdgcn_readfirstlane(tid >> 6), lane = tid & 63, wr = wid >> 2, wc = wid & 3, fr = lane & 15, fq = lane >> 4;
    const int K = g.K, nt = K / BK;
    unsigned voffA[2], voffB[2];
#pragma unroll
    for (int i = 0; i < 2; ++i) { int R, C; stage_rc(tid * 16 + i * 8192, R, C); const int Rb = Epi::PERM ? ((R & ~31) + perm32(R & 31)) : R;
        voffA[i] = (unsigned)(R * K + C) * 2u; voffB[i] = (unsigned)(Rb * K + C) * 2u; }
    const size_t kstep = (size_t)(BK * 2);
    const size_t hstep = (size_t)HALF * K * 2;
    const size_t tstep = 2 * hstep;
    const unsigned ldsw = (unsigned)wid * 1024u;
    const int aoff = lds_byte(wr * 64 + fr, fq * 8), boff = lds_byte(wc * 32 + fr, fq * 8);
#define PG8_SA(b, h) (((b) * 2 + (h)) * HTB)
#define PG8_SB(b, h) ((4 + (b) * 2 + (h)) * HTB)
#define PG8_STAGE(bufoff, gbase, voff) do { _Pragma("unroll") for (int _i = 0; _i < 2; ++_i) \
        __builtin_amdgcn_global_load_lds((const unsigned*)((const char*)(gbase) + (voff)[_i]), (PG8_LAS unsigned*)(lds + (bufoff) + ldsw + _i * 8192), 16, 0, 0); } while (0)
#define PG8_LDA(dst, b, h) do { _Pragma("unroll") for (int m = 0; m < 4; ++m) _Pragma("unroll") for (int k = 0; k < 2; ++k) dst[m][k] = *(const PG8_LAS bf16x8*)(lds + PG8_SA(b, h) + aoff + m * 2048 + k * 1024); } while (0)
#define PG8_LDB(dst, b, h) do { _Pragma("unroll") for (int n = 0; n < 2; ++n) _Pragma("unroll") for (int k = 0; k < 2; ++k) dst[n][k] = *(const PG8_LAS bf16x8*)(lds + PG8_SB(b, h) + boff + n * 2048 + k * 1024); } while (0)
#define PG8_MMA(ai, bj, At, Bt) do { __builtin_amdgcn_s_setprio(1); _Pragma("unroll") for (int m = 0; m < 4; ++m) _Pragma("unroll") for (int n = 0; n < 2; ++n) _Pragma("unroll") for (int k = 0; k < 2; ++k) \
        acc[ai][bj][m][n] = __builtin_amdgcn_mfma_f32_16x16x32_bf16(Bt[n][k], At[m][k], acc[ai][bj][m][n], 0, 0, 0); __builtin_amdgcn_s_setprio(0); } while (0)
#define PG8_WAIT_V(n) asm volatile("s_waitcnt vmcnt(" #n ")" ::: "memory")
#define PG8_WAIT_L(n) asm volatile("s_waitcnt lgkmcnt(" #n ")" ::: "memory")
#define PG8_BAR __builtin_amdgcn_s_barrier()
#define PG8_SCHED __builtin_amdgcn_sched_barrier(0)
    Unit cur, nxt; int ui = 0;
    if (!S.next(0, cur)) return;
    f32x4 acc[2][2][4][2];
#pragma unroll
    for (int a = 0; a < 2; ++a)
#pragma unroll
        for (int b = 0; b < 2; ++b)
#pragma unroll
            for (int m = 0; m < 4; ++m)
#pragma unroll
                for (int n = 0; n < 2; ++n) acc[a][b][m][n] = (f32x4){0.f, 0.f, 0.f, 0.f};
    bf16x8 At[4][2], B0[2][2], B1[2][2];
    const char* cA = (const char*)g.A + (size_t)cur.pm * tstep; const char* cB = (const char*)g.Bt + (size_t)cur.pn * tstep;
    S.a_ready(cur);
    if constexpr (SP2) {
        PG8_STAGE(PG8_SB(0, 0), cB, voffB); PG8_STAGE(PG8_SB(0, 1), cB + hstep, voffB); PG8_STAGE(PG8_SA(0, 0), cA, voffA); PG8_STAGE(PG8_SA(0, 1), cA + hstep, voffA);
        if (wr == 1) PG8_BAR;
        PG8_WAIT_V(2); PG8_BAR;
        PG8_STAGE(PG8_SB(1, 0), cB + kstep, voffB); PG8_STAGE(PG8_SA(1, 0), cA + kstep, voffA); PG8_STAGE(PG8_SB(1, 1), cB + hstep + kstep, voffB);
        PG8_WAIT_V(6); PG8_BAR;
    } else {
        PG8_STAGE(PG8_SB(0, 0), cB, voffB); PG8_STAGE(PG8_SA(0, 0), cA, voffA); PG8_STAGE(PG8_SB(0, 1), cB + hstep, voffB); PG8_STAGE(PG8_SA(0, 1), cA + hstep, voffA);
        if (wr == 1) PG8_BAR;
        PG8_WAIT_V(4); PG8_BAR;
        PG8_STAGE(PG8_SB(1, 0), cB + kstep, voffB); PG8_STAGE(PG8_SA(1, 0), cA + kstep, voffA); PG8_STAGE(PG8_SB(1, 1), cB + hstep + kstep, voffB);
        PG8_WAIT_V(6); PG8_BAR;
    }
    for (;;) {
        const bool has_next = S.next(ui + 1, nxt);
        const char* nA = has_next ? (const char*)g.A + (size_t)nxt.pm * tstep : cA; const char* nB = has_next ? (const char*)g.Bt + (size_t)nxt.pn * tstep : cB;
#pragma unroll 1
        for (int t = 0; t < nt; t += 2) {
            const bool last = (t == nt - 2);
            const char* a1 = cA + (size_t)(t + 1) * kstep;
            const char* a2 = last ? nA : cA + (size_t)(t + 2) * kstep; const char* b2 = last ? nB : cB + (size_t)(t + 2) * kstep;
            const char* a3 = a2 + kstep; const char* b3 = b2 + kstep;
            if (last && has_next) S.a_ready(nxt);
            if constexpr (SP2) {
            PG8_LDB(B0, 0, 0); PG8_LDB(B1, 0, 1); PG8_SCHED; PG8_LDA(At, 0, 0); PG8_STAGE(PG8_SA(1, 1), a1 + hstep, voffA);
            PG8_WAIT_V(8); PG8_WAIT_L(0); PG8_BAR; PG8_MMA(0, 0, At, B0); PG8_MMA(0, 1, At, B1); PG8_BAR; PG8_SCHED;
            PG8_LDA(At, 0, 1); PG8_STAGE(PG8_SB(0, 0), b2, voffB); PG8_STAGE(PG8_SB(0, 1), b2 + hstep, voffB); PG8_STAGE(PG8_SA(0, 0), a2, voffA);
            PG8_WAIT_V(8); PG8_WAIT_L(0); PG8_BAR; PG8_MMA(1, 0, At, B0); PG8_MMA(1, 1, At, B1); PG8_BAR; PG8_SCHED;
            PG8_LDB(B0, 1, 0); PG8_LDB(B1, 1, 1); PG8_SCHED; PG8_LDA(At, 1, 0); PG8_STAGE(PG8_SA(0, 1), a2 + hstep, voffA);
            PG8_WAIT_V(8); PG8_WAIT_L(0); PG8_BAR; PG8_MMA(0, 0, At, B0); PG8_MMA(0, 1, At, B1); PG8_BAR; PG8_SCHED;
            PG8_LDA(At, 1, 1); PG8_STAGE(PG8_SB(1, 0), b3, voffB); PG8_STAGE(PG8_SB(1, 1), b3 + hstep, voffB); PG8_STAGE(PG8_SA(1, 0), a3, voffA);
            PG8_WAIT_V(8); PG8_WAIT_L(0); PG8_BAR; PG8_MMA(1, 0, At, B0); PG8_MMA(1, 1, At, B1); PG8_BAR; PG8_SCHED;
            } else {
            PG8_LDB(B0, 0, 0); PG8_SCHED; PG8_LDA(At, 0, 0); PG8_STAGE(PG8_SA(1, 1), a1 + hstep, voffA);
            PG8_WAIT_L(8); PG8_BAR; PG8_WAIT_L(0); PG8_MMA(0, 0, At, B0); PG8_BAR; PG8_SCHED;
            PG8_LDB(B1, 0, 1); PG8_STAGE(PG8_SB(0, 0), b2, voffB);
            PG8_BAR; PG8_WAIT_L(0); PG8_MMA(0, 1, At, B1); PG8_BAR;
            PG8_LDA(At, 0, 1); PG8_STAGE(PG8_SA(0, 0), a2, voffA);
            PG8_BAR; PG8_WAIT_L(0); PG8_MMA(1, 0, At, B0); PG8_BAR; PG8_SCHED;
            PG8_STAGE(PG8_SB(0, 1), b2 + hstep, voffB);
            PG8_WAIT_V(6); PG8_BAR; PG8_MMA(1, 1, At, B1); PG8_BAR;
            PG8_LDB(B0, 1, 0); PG8_SCHED; PG8_LDA(At, 1, 0); PG8_STAGE(PG8_SA(0, 1), a2 + hstep, voffA);
            PG8_WAIT_L(8); PG8_BAR; PG8_WAIT_L(0); PG8_MMA(0, 0, At, B0); PG8_BAR; PG8_SCHED;
            PG8_LDB(B1, 1, 1); PG8_STAGE(PG8_SB(1, 0), b3, voffB);
            PG8_BAR; PG8_WAIT_L(0); PG8_MMA(0, 1, At, B1); PG8_BAR;
            PG8_LDA(At, 1, 1); PG8_STAGE(PG8_SA(1, 0), a3, voffA);
            PG8_BAR; PG8_WAIT_L(0); PG8_MMA(1, 0, At, B0); PG8_BAR; PG8_SCHED;
            PG8_STAGE(PG8_SB(1, 1), b3 + hstep, voffB);
            PG8_WAIT_V(6); PG8_BAR; PG8_MMA(1, 1, At, B1); PG8_BAR;
            }
        }
        if constexpr (ALIGN_EPI) { if (wr == 0) PG8_BAR; }
        if constexpr (!Epi::AFTER_DRAIN) { E(acc, cur, wr, wc, fr, fq); S.done(cur); }
        if (!has_next) break;
#pragma unroll
        for (int a = 0; a < 2; ++a)
#pragma unroll
            for (int b = 0; b < 2; ++b)
#pragma unroll
                for (int m = 0; m < 4; ++m)
#pragma unroll
                    for (int n = 0; n < 2; ++n) acc[a][b][m][n] = (f32x4){0.f, 0.f, 0.f, 0.f};
        cur = nxt; cA = nA; cB = nB; ++ui;
        if constexpr (ALIGN_EPI) { if (wr == 1) PG8_BAR; }
    }
    PG8_WAIT_V(0);
    if constexpr (!ALIGN_EPI) { if (wr == 0) PG8_BAR; }
    PG8_BAR;
    if constexpr (Epi::AFTER_DRAIN) { E.fused(acc, cur, wr, wc, fr, fq, lds, wid, lane); S.done(cur); }
#undef PG8_SA
#undef PG8_SB
#undef PG8_STAGE
#undef PG8_LDA
#undef PG8_LDB
#undef PG8_MMA
#undef PG8_WAIT_V
#undef PG8_WAIT_L
#undef PG8_BAR
#undef PG8_SCHED
}
template <class Epi, class Sched, bool ALIGN_EPI = false, bool SP2 = false>
__device__ __forceinline__ void gemm_phase_g(PG8_LAS unsigned char* lds, const Gemm g, const Sched& S, const Epi& E, const int tid, const __attribute__((address_space(1))) int* rsl) {
    static_assert(SP2, "gather variant: SP2 loop only");
    const int wid = __builtin_amdgcn_readfirstlane(tid >> 6), lane = tid & 63, wr = wid >> 2, wc = wid & 3, fr = lane & 15, fq = lane >> 4;
    const int K = g.K, nt = K / BK;
    unsigned voffA[2] = {0u, 0u}, voffB[2]; int srR[2], srC[2]; unsigned vAc[2][2], vAn[2][2];
#pragma unroll
    for (int i = 0; i < 2; ++i) { int R, C; stage_rc(tid * 16 + i * 8192, R, C); const int Rb = Epi::PERM ? ((R & ~31) + perm32(R & 31)) : R;
        srR[i] = R; srC[i] = C; voffB[i] = (unsigned)(Rb * K + C) * 2u; }
#define PG8_GCALC(dst, un) do { _Pragma("unroll") for (int h_ = 0; h_ < 2; ++h_) _Pragma("unroll") for (int i_ = 0; i_ < 2; ++i_) { const int rr_ = rsl[(un).pm * 256 + h_ * 128 + srR[i_]]; \
        dst[h_][i_] = (unsigned)(((rr_ < 0 ? 0 : (rr_ >> 2)) * K + srC[i_]) * 2); } } while (0)
    const size_t kstep = (size_t)(BK * 2);
    const size_t hstep = (size_t)HALF * K * 2;
    const size_t tstep = 2 * hstep;
    const unsigned ldsw = (unsigned)wid * 1024u;
    const int aoff = lds_byte(wr * 64 + fr, fq * 8), boff = lds_byte(wc * 32 + fr, fq * 8);
#define PG8_SA(b, h) (((b) * 2 + (h)) * HTB)
#define PG8_SB(b, h) ((4 + (b) * 2 + (h)) * HTB)
#define PG8_STAGE(bufoff, gbase, voff) do { _Pragma("unroll") for (int _i = 0; _i < 2; ++_i) \
        __builtin_amdgcn_global_load_lds((const unsigned*)((const char*)(gbase) + (voff)[_i]), (PG8_LAS unsigned*)(lds + (bufoff) + ldsw + _i * 8192), 16, 0, 0); } while (0)
#define PG8_LDA(dst, b, h) do { _Pragma("unroll") for (int m = 0; m < 4; ++m) _Pragma("unroll") for (int k = 0; k < 2; ++k) dst[m][k] = *(const PG8_LAS bf16x8*)(lds + PG8_SA(b, h) + aoff + m * 2048 + k * 1024); } while (0)
#define PG8_LDB(dst, b, h) do { _Pragma("unroll") for (int n = 0; n < 2; ++n) _Pragma("unroll") for (int k = 0; k < 2; ++k) dst[n][k] = *(const PG8_LAS bf16x8*)(lds + PG8_SB(b, h) + boff + n * 2048 + k * 1024); } while (0)
#define PG8_MMA(ai, bj, At, Bt) do { __builtin_amdgcn_s_setprio(1); _Pragma("unroll") for (int m = 0; m < 4; ++m) _Pragma("unroll") for (int n = 0; n < 2; ++n) _Pragma("unroll") for (int k = 0; k < 2; ++k) \
        acc[ai][bj][m][n] = __builtin_amdgcn_mfma_f32_16x16x32_bf16(Bt[n][k], At[m][k], acc[ai][bj][m][n], 0, 0, 0); __builtin_amdgcn_s_setprio(0); } while (0)
#define PG8_WAIT_V(n) asm volatile("s_waitcnt vmcnt(" #n ")" ::: "memory")
#define PG8_WAIT_L(n) asm volatile("s_waitcnt lgkmcnt(" #n ")" ::: "memory")
#define PG8_BAR __builtin_amdgcn_s_barrier()
#define PG8_SCHED __builtin_amdgcn_sched_barrier(0)
    Unit cur, nxt; int ui = 0;
    if (!S.next(0, cur)) return;
    f32x4 acc[2][2][4][2];
#pragma unroll
    for (int a = 0; a < 2; ++a)
#pragma unroll
        for (int b = 0; b < 2; ++b)
#pragma unroll
            for (int m = 0; m < 4; ++m)
#pragma unroll
                for (int n = 0; n < 2; ++n) acc[a][b][m][n] = (f32x4){0.f, 0.f, 0.f, 0.f};
    bf16x8 At[4][2], B0[2][2], B1[2][2];
    const char* cA = (const char*)g.A; PG8_GCALC(vAc, cur); const char* cB = (const char*)g.Bt + (size_t)cur.pn * tstep;
    S.a_ready(cur);
    if constexpr (SP2) {
        PG8_STAGE(PG8_SB(0, 0), cB, voffB); PG8_STAGE(PG8_SB(0, 1), cB + hstep, voffB); PG8_STAGE(PG8_SA(0, 0), cA, vAc[0]); PG8_STAGE(PG8_SA(0, 1), cA, vAc[1]);
        if (wr == 1) PG8_BAR;
        PG8_WAIT_V(2); PG8_BAR;
        PG8_STAGE(PG8_SB(1, 0), cB + kstep, voffB); PG8_STAGE(PG8_SA(1, 0), cA + kstep, vAc[0]); PG8_STAGE(PG8_SB(1, 1), cB + hstep + kstep, voffB);
        PG8_WAIT_V(6); PG8_BAR;
    } else {
        PG8_STAGE(PG8_SB(0, 0), cB, voffB); PG8_STAGE(PG8_SA(0, 0), cA, voffA); PG8_STAGE(PG8_SB(0, 1), cB + hstep, voffB); PG8_STAGE(PG8_SA(0, 1), cA + hstep, voffA);
        if (wr == 1) PG8_BAR;
        PG8_WAIT_V(4); PG8_BAR;
        PG8_STAGE(PG8_SB(1, 0), cB + kstep, voffB); PG8_STAGE(PG8_SA(1, 0), cA + kstep, voffA); PG8_STAGE(PG8_SB(1, 1), cB + hstep + kstep, voffB);
        PG8_WAIT_V(6); PG8_BAR;
    }
    for (;;) {
        const bool has_next = S.next(ui + 1, nxt);
        const char* nA = cA; if (has_next) PG8_GCALC(vAn, nxt); else { vAn[0][0] = vAc[0][0]; vAn[0][1] = vAc[0][1]; vAn[1][0] = vAc[1][0]; vAn[1][1] = vAc[1][1]; } const char* nB = has_next ? (const char*)g.Bt + (size_t)nxt.pn * tstep : cB;
#pragma unroll 1
        for (int t = 0; t < nt; t += 2) {
            const bool last = (t == nt - 2);
            const char* a1 = cA + (size_t)(t + 1) * kstep;
            const char* a2 = last ? nA : cA + (size_t)(t + 2) * kstep; const char* b2 = last ? nB : cB + (size_t)(t + 2) * kstep;
            const char* a3 = a2 + kstep; const char* b3 = b2 + kstep;
            if (last && has_next) S.a_ready(nxt);
            if constexpr (SP2) {
            PG8_LDB(B0, 0, 0); PG8_LDB(B1, 0, 1); PG8_SCHED; PG8_LDA(At, 0, 0); PG8_STAGE(PG8_SA(1, 1), a1, vAc[1]);
            PG8_WAIT_V(8); PG8_WAIT_L(0); PG8_BAR; PG8_MMA(0, 0, At, B0); PG8_MMA(0, 1, At, B1); PG8_BAR; PG8_SCHED;
            PG8_LDA(At, 0, 1); PG8_STAGE(PG8_SB(0, 0), b2, voffB); PG8_STAGE(PG8_SB(0, 1), b2 + hstep, voffB); PG8_STAGE(PG8_SA(0, 0), a2, (last ? vAn[0] : vAc[0]));
            PG8_WAIT_V(8); PG8_WAIT_L(0); PG8_BAR; PG8_MMA(1, 0, At, B0); PG8_MMA(1, 1, At, B1); PG8_BAR; PG8_SCHED;
            PG8_LDB(B0, 1, 0); PG8_LDB(B1, 1, 1); PG8_SCHED; PG8_LDA(At, 1, 0); PG8_STAGE(PG8_SA(0, 1), a2, (last ? vAn[1] : vAc[1]));
            PG8_WAIT_V(8); PG8_WAIT_L(0); PG8_BAR; PG8_MMA(0, 0, At, B0); PG8_MMA(0, 1, At, B1); PG8_BAR; PG8_SCHED;
            PG8_LDA(At, 1, 1); PG8_STAGE(PG8_SB(1, 0), b3, voffB); PG8_STAGE(PG8_SB(1, 1), b3 + hstep, voffB); PG8_STAGE(PG8_SA(1, 0), a3, (last ? vAn[0] : vAc[0]));
            PG8_WAIT_V(8); PG8_WAIT_L(0); PG8_BAR; PG8_MMA(1, 0, At, B0); PG8_MMA(1, 1, At, B1); PG8_BAR; PG8_SCHED;
            } else {
            PG8_LDB(B0, 0, 0); PG8_SCHED; PG8_LDA(At, 0, 0); PG8_STAGE(PG8_SA(1, 1), a1 + hstep, voffA);
            PG8_WAIT_L(8); PG8_BAR; PG8_WAIT_L(0); PG8_MMA(0, 0, At, B0); PG8_BAR; PG8_SCHED;
            PG8_LDB(B1, 0, 1); PG8_STAGE(PG8_SB(0, 0), b2, voffB);
            PG8_BAR; PG8_WAIT_L(0); PG8_MMA(0, 1, At, B1); PG8_BAR;
            PG8_LDA(At, 0, 1); PG8_STAGE(PG8_SA(0, 0), a2, voffA);
            PG8_BAR; PG8_WAIT_L(0); PG8_MMA(1, 0, At, B0); PG8_BAR; PG8_SCHED;
            PG8_STAGE(PG8_SB(0, 1), b2 + hstep, voffB);
            PG8_WAIT_V(6); PG8_BAR; PG8_MMA(1, 1, At, B1); PG8_BAR;
            PG8_LDB(B0, 1, 0); PG8_SCHED; PG8_LDA(At, 1, 0); PG8_STAGE(PG8_SA(0, 1), a2 + hstep, voffA);
            PG8_WAIT_L(8); PG8_BAR; PG8_WAIT_L(0); PG8_MMA(0, 0, At, B0); PG8_BAR; PG8_SCHED;
            PG8_LDB(B1, 1, 1); PG8_STAGE(PG8_SB(1, 0), b3, voffB);
            PG8_BAR; PG8_WAIT_L(0); PG8_MMA(0, 1, At, B1); PG8_BAR;
            PG8_LDA(At, 1, 1); PG8_STAGE(PG8_SA(1, 0), a3, voffA);
            PG8_BAR; PG8_WAIT_L(0); PG8_MMA(1, 0, At, B0); PG8_BAR; PG8_SCHED;
            PG8_STAGE(PG8_SB(1, 1), b3 + hstep, voffB);
            PG8_WAIT_V(6); PG8_BAR; PG8_MMA(1, 1, At, B1); PG8_BAR;
            }
        }
        if constexpr (ALIGN_EPI) { if (wr == 0) PG8_BAR; }
        if constexpr (!Epi::AFTER_DRAIN) { E(acc, cur, wr, wc, fr, fq); S.done(cur); }
        if (!has_next) break;
#pragma unroll
        for (int a = 0; a < 2; ++a)
#pragma unroll
            for (int b = 0; b < 2; ++b)
#pragma unroll
                for (int m = 0; m < 4; ++m)
#pragma unroll
                    for (int n = 0; n < 2; ++n) acc[a][b][m][n] = (f32x4){0.f, 0.f, 0.f, 0.f};
        cur = nxt; cA = nA; cB = nB; ++ui; vAc[0][0] = vAn[0][0]; vAc[0][1] = vAn[0][1]; vAc[1][0] = vAn[1][0]; vAc[1][1] = vAn[1][1];
        if constexpr (ALIGN_EPI) { if (wr == 1) PG8_BAR; }
    }
    PG8_WAIT_V(0);
    if constexpr (!ALIGN_EPI) { if (wr == 0) PG8_BAR; }
    PG8_BAR;
    if constexpr (Epi::AFTER_DRAIN) { E.fused(acc, cur, wr, wc, fr, fq, lds, wid, lane); S.done(cur); }
#undef PG8_GCALC
#undef PG8_SA
#undef PG8_SB
#undef PG8_STAGE
#undef PG8_LDA
#undef PG8_LDB
#undef PG8_MMA
#undef PG8_WAIT_V
#undef PG8_WAIT_L
#undef PG8_BAR
#undef PG8_SCHED
}
}

#define XB_TMO      128
#define XB_XCNT(j)  (256  + 64 * (j))
#define XB_XSUB(j)  (1280 + 64 * (j))
#define XB_XGEN(j)  (2304 + 64 * (j))
#define XB_TOP      3328
#define XB_TOPGEN   3392
#define XCD_BAR_WORDS 3456
#define XB_SPIN_CAP (1u << 18)

__device__ __forceinline__ unsigned xb_ld(unsigned* p)              { return __hip_atomic_load(p, __ATOMIC_RELAXED, __HIP_MEMORY_SCOPE_AGENT); }
__device__ __forceinline__ unsigned xb_add(unsigned* p, unsigned v) { return __hip_atomic_fetch_add(p, v, __ATOMIC_RELAXED, __HIP_MEMORY_SCOPE_AGENT); }
__device__ __forceinline__ unsigned xb_xcc_id() { return (unsigned)__builtin_amdgcn_s_getreg((3 << 11) | 20) & 0xFu; }
#define XB_SPIN(cond, bar) do { unsigned _sp = 0; while (cond) { __builtin_amdgcn_s_sleep(1); \
    if ((++_sp & 255u) == 0u) { if (xb_ld(&(bar)[XB_TMO])) break; if (_sp > XB_SPIN_CAP) { atomicAdd(&(bar)[XB_TMO], 1u); break; } } } } while (0)

struct XcdBarrier {
    unsigned* bar; unsigned x;
    volatile LAS unsigned* st;
};
__device__ __forceinline__ XcdBarrier xcd_barrier_post(unsigned* bar, volatile LAS unsigned* st) {
    XcdBarrier b; b.bar = bar; b.x = xb_xcc_id(); b.st = st;
    if (threadIdx.x == 0) (void)xb_add(&bar[XB_XCNT(b.x)], 1u);
    return b;
}
__device__ __forceinline__ void xcd_barrier_complete(unsigned* bar, unsigned x, unsigned& nloc, unsigned& nx) {
    const unsigned G = gridDim.x * gridDim.y * gridDim.z;
    unsigned sum, cnt, mine, sp = 0u;
    for (;;) {
        sum = 0u; cnt = 0u; mine = 0u;
#pragma unroll
        for (unsigned j = 0; j < 16; ++j) { const unsigned c = xb_ld(&bar[XB_XCNT(j)]); sum += c; cnt += (c > 0u) ? 1u : 0u; mine = (j == x) ? c : mine; }
        if (sum == G) break;
        __builtin_amdgcn_s_sleep(1);
        if ((++sp & 255u) == 0u) { if (xb_ld(&bar[XB_TMO])) break; if (sp > XB_SPIN_CAP) { atomicAdd(&bar[XB_TMO], 1u); break; } }
    }
    nloc = mine > 0u ? mine : 1u; nx = cnt > 0u ? cnt : 1u;
}
__device__ __forceinline__ void xcd_barrier(const XcdBarrier& b) {
    asm volatile("s_waitcnt vmcnt(0)" ::: "memory");
    __syncthreads();
    if (threadIdx.x == 0) {
        unsigned* bar = b.bar;
        __builtin_amdgcn_s_waitcnt(0);
        unsigned nloc = b.st[0], nx = b.st[1];
        if (nloc == 0u) { xcd_barrier_complete(bar, b.x, nloc, nx); b.st[0] = nloc; b.st[1] = nx; }
        const unsigned old = xb_add(&bar[XB_XSUB(b.x)], 1u);
        const unsigned gen = old / nloc;
        if (old + 1u == (gen + 1u) * nloc) {
            __builtin_amdgcn_fence(__ATOMIC_RELEASE, "agent");
            asm volatile("s_waitcnt vmcnt(0)" ::: "memory");
            const unsigned og = xb_add(&bar[XB_TOP], 1u);
            const unsigned tg = og / nx;
            if (og + 1u == (tg + 1u) * nx) xb_add(&bar[XB_TOPGEN], 1u);
            else XB_SPIN(xb_ld(&bar[XB_TOPGEN]) == tg, bar);
            __builtin_amdgcn_fence(__ATOMIC_ACQUIRE, "agent");
            xb_add(&bar[XB_XGEN(b.x)], 1u);
            asm volatile("s_waitcnt vmcnt(0)" ::: "memory");
        } else {
            XB_SPIN(xb_ld(&bar[XB_XGEN(b.x)]) == gen, bar);
            __builtin_amdgcn_fence(__ATOMIC_ACQUIRE, "agent");
            asm volatile("s_waitcnt vmcnt(0)" ::: "memory");
        }
    }
    __syncthreads();
}

struct Args { const float* in[39]; float* out; unsigned char* ws; int ph_lo, ph_hi, dupk, pad; };
enum { I_X = 0, I_C, I_CTX, I_CCTX, I_ADAW, I_ADAB, I_WIN, I_WA2F, I_BAF, I_WA2B, I_BAB, I_GNORM, I_QNORM, I_WUQ, I_KVNORM, I_WUKV, I_HCW, I_HCB, I_HW1, I_HB1, I_HW2, I_HB2, I_HW3, I_HFREQ,
       I_HBIAS, I_WBG, I_WBM, I_WBH, I_WOUT, I_LN1G, I_LN1B, I_LN2G, I_LN2B, I_RW, I_RB, I_MW1, I_MB1, I_MW2, I_MB2 };

__device__ __forceinline__ int opq(int i) { asm volatile("" : "+s"(i)); return i; }
#define INP(A, i) ((const float*)(const GAS float*)((A).in[opq(i)]))
struct Fr { LAS unsigned char* L; int tid, lane, wave, G, bid; };

__device__ __forceinline__ void tr_item(const float* W, int K, int N, bf16* WT, int mode, const float* kscale, float scale, LAS float* scr, int item, int lane) {
    const int nblk = N / 32, kb = item / nblk, nb = item - kb * nblk, k0 = 64 * kb, n0 = 32 * nb;
#pragma unroll
    for (int i = 0; i < 8; ++i) { const int kk = 8 * i + (lane >> 3), c4 = (lane & 7) * 4; f32x4 v = *(const GAS f32x4*)((const GAS float*)W + (size_t)(k0 + kk) * N + n0 + c4) * scale; if (kscale) v = v * kscale[k0 + kk];
        scr[kk * 33 + c4] = v[0]; scr[kk * 33 + c4 + 1] = v[1]; scr[kk * 33 + c4 + 2] = v[2]; scr[kk * 33 + c4 + 3] = v[3]; }
    LDS_WAIT(); asm volatile("" ::: "memory");
    const int c = lane & 7;
#pragma unroll
    for (int j = 0; j < 4; ++j) { const int n = (lane >> 3) + 8 * j; const LAS float* s = scr + (8 * c) * 33 + n;
        v4u o; o.x = pk2(s[0 * 33], s[1 * 33]); o.y = pk2(s[2 * 33], s[3 * 33]); o.z = pk2(s[4 * 33], s[5 * 33]); o.w = pk2(s[6 * 33], s[7 * 33]);
        int nn = n0 + n; if (mode == 1) { nn = nn < 1024 ? ((nn >> 7) * 256 + (nn & 127)) : ((((nn - 1024) >> 7) * 256) + 128 + ((nn - 1024) & 127)); }
        *(GAS v4u*)((GAS bf16*)WT + (size_t)nn * K + k0 + 8 * c) = o; }
    LDS_WAIT(); asm volatile("" ::: "memory");
}

__device__ __forceinline__ float silu_(float x) { return x / (1.f + expf(-x)); }

__device__ __forceinline__ void hy_filter_item(LAS unsigned char* L_, int tid_, const float* w1, const float* b1, const float* w2, const float* b2, const float* fr, const float* w3, int Ln, int blk, float* FILT, float* HP) {
    LAS float* zE = (LAS float*)L_;
    LAS float* h1 = zE + 32 * 36;
    LAS float* h2 = h1 + 32 * 64;
    const int tid = tid_, p0 = blk * 32;
    { const int p = tid >> 4, j = tid & 15; const int i = p0 + p;
      const float w = 6.283185307179586f * (float)i / (float)Ln; const float f = 1e-4f + (float)j * ((15.f - 1e-4f) / 15.f); const float ang = f * w;
      zE[p * 36 + 1 + j] = __cosf(ang); zE[p * 36 + 17 + j] = -__sinf(ang); if (j == 0) zE[p * 36] = (float)i / (float)(Ln - 1); }
    __syncthreads();
    { const int n = tid & 63; const float frn = fr[n], bn = b1[n];
#pragma unroll 1
      for (int q = 0; q < 4; ++q) { const int p = (tid >> 6) + 8 * q; float s = bn;
#pragma unroll 3
          for (int k = 0; k < 33; ++k) s += zE[p * 36 + k] * w1[k * 64 + n];
          h1[p * 64 + n] = __sinf(frn * s); } }
    __syncthreads();
    { const int n = tid & 63; const float frn = fr[n], bn = b2[n];
#pragma unroll 1
      for (int q = 0; q < 4; ++q) { const int p = (tid >> 6) + 8 * q; float s = bn;
#pragma unroll 4
          for (int k = 0; k < 64; ++k) s += h1[p * 64 + k] * w2[k * 64 + n];
          h2[p * 64 + n] = __sinf(frn * s); } }
    __syncthreads();
    { const int lane = tid & 63, wave_ = tid >> 6, r = lane & 31, hh = lane >> 5; const float d0 = -3.0701134573253945f, d1 = -15.350567286626972f;
      for (int cbk = wave_; cbk < 16; cbk += 8) { const int c = cbk * 32 + r; const float delta = fabsf(d0 + (float)c * ((d1 - d0) / 511.f));
          for (int o_ = 0; o_ < 2; ++o_) { float asum = 0.f;
              for (int dr = 0; dr < 2; ++dr) { const int j = (o_ * 2 + dr) * 512 + c; f32x16 acc;
#pragma unroll
                  for (int i = 0; i < 16; ++i) acc[i] = 0.f;
                  float bw[32];
#pragma unroll
                  for (int st = 0; st < 32; ++st) bw[st] = w3[(size_t)(2 * st + hh) * 2048 + j];
#pragma unroll
                  for (int st = 0; st < 32; ++st) acc = __builtin_amdgcn_mfma_f32_32x32x2f32(h2[r * 64 + 2 * st + hh], bw[st], acc, 0, 0, 0);
                  float* dst = FILT + ((size_t)j * Ln + p0);
#pragma unroll
                  for (int g = 0; g < 4; ++g) { f32x4 o;
#pragma unroll
                      for (int i = 0; i < 4; ++i) { const int p = 8 * g + 4 * hh + i; const float v = acc[4 * g + i] * __builtin_amdgcn_exp2f(-zE[p * 36] * delta * 1.4426950408889634f); o[i] = v; asum += fabsf(v); }
                      *(f32x4*)(dst + 8 * g + 4 * hh) = o; } }
              asum += __shfl_xor(asum, 32);
              if (hh == 0) HP[((size_t)blk * 2 + o_) * 512 + c] = asum; } } }
    __syncthreads();
}

__device__ __forceinline__ void ln_mod_row(const float* xrow, const float* sh, const float* sc, bf16* orow, int lane) {
    const f32x4* xr = (const f32x4*)xrow + lane; f32x4 v[4]; float s = 0.f;
#pragma unroll
    for (int j = 0; j < 4; ++j) { v[j] = xr[64 * j]; s += (v[j].x + v[j].y) + (v[j].z + v[j].w); }
    const float mean = wave_sum(s) * (1.f / D); float s2 = 0.f;
#pragma unroll
    for (int j = 0; j < 4; ++j) { v[j] = v[j] - mean; s2 += (v[j].x * v[j].x + v[j].y * v[j].y) + (v[j].z * v[j].z + v[j].w * v[j].w); }
    const float rstd = 1.f / sqrtf(wave_sum(s2) * (1.f / D) + LN_EPS);
    v2u* o8 = (v2u*)orow + lane;
#pragma unroll
    for (int j = 0; j < 4; ++j) { const f32x4 a = ((const f32x4*)sc)[lane + 64 * j], b = ((const f32x4*)sh)[lane + 64 * j]; const f32x4 y = v[j] * rstd * (a + 1.f) + b;
        v2u w; w.x = pk2(y.x, y.y); w.y = pk2(y.z, y.w); o8[64 * j] = w; }
}

__device__ __forceinline__ f32x2 cmul(f32x2 a, f32x2 b) { const f32x2 axx = __builtin_shufflevector(a, a, 0, 0), ayy = __builtin_shufflevector(a, a, 1, 1); f32x2 bs = __builtin_shufflevector(b, b, 1, 0); bs.x = -bs.x;
    return __builtin_elementwise_fma(ayy, bs, axx * b); }
__device__ __forceinline__ f32x2 cmulc(f32x2 a, f32x2 b) {
    const f32x2 bxx = __builtin_shufflevector(b, b, 0, 0), byy = __builtin_shufflevector(b, b, 1, 1); f32x2 as = __builtin_shufflevector(a, a, 1, 0); as.y = -as.y;
    return __builtin_elementwise_fma(as, byy, a * bxx); }
__device__ __forceinline__ f32x4 cswn(f32x4 w) { f32x4 r = __builtin_shufflevector(w, w, 1, 0, 3, 2); r.x = -r.x; r.z = -r.z; return r; }
__device__ __forceinline__ f32x4 cmul4(f32x4 x, f32x4 w, f32x4 wsn) { return __builtin_elementwise_fma(__builtin_shufflevector(x, x, 1, 1, 3, 3), wsn, __builtin_shufflevector(x, x, 0, 0, 2, 2) * w); }
__device__ __forceinline__ f32x4 cmulc4(f32x4 x, f32x4 w, f32x4 wsn) { return __builtin_shufflevector(x, x, 0, 0, 2, 2) * w - __builtin_shufflevector(x, x, 1, 1, 3, 3) * wsn; }
__device__ __forceinline__ int fpad(int i) { return i + 2 * (i >> 4); }
constexpr int FFT_LDS_ELEMS = FFTN + FFTN / 8;
__device__ __forceinline__ void fft16_dif(f32x2 (&x)[16]) {
    constexpr float wr[8] = {1.000000000e+00f, 9.238795325e-01f, 7.071067812e-01f, 3.826834324e-01f, 6.123233996e-17f, -3.826834324e-01f, -7.071067812e-01f, -9.238795325e-01f}, wi[8] = {-0.000000000e+00f, -3.826834324e-01f, -7.071067812e-01f, -9.238795325e-01f, -1.000000000e+00f, -9.238795325e-01f, -7.071067812e-01f, -3.826834324e-01f};
#pragma unroll
    for (int m = 16; m >= 2; m >>= 1) {
#pragma unroll
        for (int base = 0; base < 16; base += m)
#pragma unroll
            for (int j = 0; j < m / 2; ++j) { const f32x2 a = x[base + j], b = x[base + j + m / 2]; const f32x2 d = a - b; x[base + j] = a + b;
                const float cr = wr[j * (16 / m)], ci = wi[j * (16 / m)]; f32x2 t; t.x = d.x * cr - d.y * ci; t.y = d.x * ci + d.y * cr; x[base + j + m / 2] = t; }
    }
}
__device__ __forceinline__ void fft16_dit_inv(f32x2 (&x)[16]) {
    constexpr float wr[8] = {1.000000000e+00f, 9.238795325e-01f, 7.071067812e-01f, 3.826834324e-01f, 6.123233996e-17f, -3.826834324e-01f, -7.071067812e-01f, -9.238795325e-01f}, wi[8] = {-0.000000000e+00f, -3.826834324e-01f, -7.071067812e-01f, -9.238795325e-01f, -1.000000000e+00f, -9.238795325e-01f, -7.071067812e-01f, -3.826834324e-01f};
#pragma unroll
    for (int m = 2; m <= 16; m <<= 1) {
#pragma unroll
        for (int base = 0; base < 16; base += m)
#pragma unroll
            for (int j = 0; j < m / 2; ++j) { const f32x2 a = x[base + j], b = x[base + j + m / 2]; const float cr = wr[j * (16 / m)], ci = -wi[j * (16 / m)];
                f32x2 t; t.x = b.x * cr - b.y * ci; t.y = b.x * ci + b.y * cr; x[base + j] = a + t; x[base + j + m / 2] = a - t; }
    }
}
template <bool INV, int M> __device__ __forceinline__ void fft_r16_pass(LAS f32x2* X, const GAS f32x2* TW, int tid) {
    constexpr int Q = M / 16, PQ = Q + 2 * (Q / 16);
#pragma unroll 2
    for (int g = tid; g < FFTN / 16; g += 512) {
        const int j = g & (Q - 1), i0 = (g / Q) * M + j; LAS f32x2* p = X + fpad(i0);
        f32x2 x[16], pw[16];
#pragma unroll
        for (int k = 0; k < 16; ++k) x[k] = p[k * PQ];
        const f32x2 t = TW[j * (FFTN / M)];
        pw[1] = t; pw[2] = cmul(t, t); pw[3] = cmul(pw[2], t); pw[4] = cmul(pw[2], pw[2]); pw[5] = cmul(pw[4], t); pw[6] = cmul(pw[4], pw[2]); pw[7] = cmul(pw[4], pw[3]); pw[8] = cmul(pw[4], pw[4]);
#pragma unroll
        for (int k = 1; k < 8; ++k) pw[8 + k] = cmul(pw[8], pw[k]);
        if (!INV) { fft16_dif(x);
#pragma unroll
            for (int k = 1; k < 16; ++k) { constexpr int dummy = 0; (void)dummy; const int f = ((k & 1) << 3) | ((k & 2) << 1) | ((k & 4) >> 1) | ((k & 8) >> 3); x[k] = cmul(x[k], pw[f]); } }
        else {
#pragma unroll
            for (int k = 1; k < 16; ++k) { const int f = ((k & 1) << 3) | ((k & 2) << 1) | ((k & 4) >> 1) | ((k & 8) >> 3); x[k] = cmulc(x[k], pw[f]); }
            fft16_dit_inv(x); }
#pragma unroll
        for (int k = 0; k < 16; ++k) p[k * PQ] = x[k];
    }
    __syncthreads();
}
__device__ __forceinline__ f32x2 twl(const LAS f32x2* TL, int idx) { return cmul(TL[idx & 63], TL[64 + (idx >> 6)]); }
__device__ __forceinline__ void fft_fwd(LAS f32x2* X, const GAS f32x2* TL, int tid) {
    { const int m = FFTN;
        const int q = m >> 2, lq = 31 - __builtin_clz(q), ts = FFTN / m;
#pragma unroll 2
        for (int g = tid; g < FFTN / 8; g += 512) {
            const int j = (g & (q / 2 - 1)) * 2, i0 = (g >> (lq - 1)) * m + j;
            LAS f32x4* P0 = (LAS f32x4*)(X + fpad(i0)); LAS f32x4* P1 = (LAS f32x4*)(X + fpad(i0 + q)); LAS f32x4* P2 = (LAS f32x4*)(X + fpad(i0 + 2 * q)); LAS f32x4* P3 = (LAS f32x4*)(X + fpad(i0 + 3 * q));
            const f32x4 x0 = *P0, x1 = *P1, x2 = *P2, x3 = *P3;
            const f32x2 w1a = TL[j * ts], w1b = TL[(j + 1) * ts];
            const f32x4 w1 = __builtin_shufflevector(w1a, w1b, 0, 1, 2, 3), w1s = cswn(w1), w2 = cmul4(w1, w1, w1s), w2s = cswn(w2);
            const f32x4 a0 = x0 + x2, d02 = x0 - x2, a1 = x1 + x3, t = x1 - x3;
            f32x4 tr = __builtin_shufflevector(t, t, 1, 0, 3, 2); tr.y = -tr.y; tr.w = -tr.w;
            const f32x4 a2 = cmul4(d02, w1, w1s), a3 = cmul4(tr, w1, w1s);
            const f32x4 o0 = a0 + a1, o1 = cmul4(a0 - a1, w2, w2s), o2 = a2 + a3, o3 = cmul4(a2 - a3, w2, w2s);
            *P0 = o0; *P1 = o1; *P2 = o2; *P3 = o3;
        }
        __syncthreads();
    }
    fft_r16_pass<false, 4096>(X, TL, tid);
    fft_r16_pass<false, 256>(X, TL, tid);
#pragma unroll 2
    for (int blk = tid; blk < FFTN / 16; blk += 512) { LAS f32x4* p = (LAS f32x4*)(X + blk * 18); f32x2 x[16];
#pragma unroll
        for (int i = 0; i < 8; ++i) { const f32x4 v = p[i]; x[2 * i].x = v[0]; x[2 * i].y = v[1]; x[2 * i + 1].x = v[2]; x[2 * i + 1].y = v[3]; }
        fft16_dif(x);
#pragma unroll
        for (int i = 0; i < 8; ++i) { f32x4 v; v[0] = x[2 * i].x; v[1] = x[2 * i].y; v[2] = x[2 * i + 1].x; v[3] = x[2 * i + 1].y; p[i] = v; } }
    __syncthreads();
}
__device__ __forceinline__ void fft_inv(LAS f32x2* X, const GAS f32x2* TL, int tid) {
#pragma unroll 2
    for (int blk = tid; blk < FFTN / 16; blk += 512) { LAS f32x4* p = (LAS f32x4*)(X + blk * 18); f32x2 x[16];
#pragma unroll
        for (int i = 0; i < 8; ++i) { const f32x4 v = p[i]; x[2 * i].x = v[0]; x[2 * i].y = v[1]; x[2 * i + 1].x = v[2]; x[2 * i + 1].y = v[3]; }
        fft16_dit_inv(x);
#pragma unroll
        for (int i = 0; i < 8; ++i) { f32x4 v; v[0] = x[2 * i].x; v[1] = x[2 * i].y; v[2] = x[2 * i + 1].x; v[3] = x[2 * i + 1].y; p[i] = v; } }
    __syncthreads();
    fft_r16_pass<true, 256>(X, TL, tid);
    fft_r16_pass<true, 4096>(X, TL, tid);
    { const int m = FFTN / 2;
        const int hm = m >> 1, lh = 31 - __builtin_clz(hm), ts1 = FFTN / m, ts2 = FFTN / (2 * m);
#pragma unroll 2
        for (int g = tid; g < FFTN / 8; g += 512) {
            const int j = (g & (hm / 2 - 1)) * 2, i0 = (g >> (lh - 1)) * 2 * m + j;
            LAS f32x4* P0 = (LAS f32x4*)(X + fpad(i0)); LAS f32x4* P1 = (LAS f32x4*)(X + fpad(i0 + hm)); LAS f32x4* P2 = (LAS f32x4*)(X + fpad(i0 + m)); LAS f32x4* P3 = (LAS f32x4*)(X + fpad(i0 + m + hm));
            const f32x4 x0 = *P0, x1 = *P1, x2 = *P2, x3 = *P3;
            const f32x2 w2a = TL[j * ts2], w2b = TL[(j + 1) * ts2];
            f32x4 w2 = __builtin_shufflevector(w2a, w2b, 0, 1, 2, 3); w2.y = -w2.y; w2.w = -w2.w;
            const f32x4 w2s = cswn(w2), w = cmul4(w2, w2, w2s), ws = cswn(w);
            const f32x4 t1 = cmul4(x1, w, ws), t3 = cmul4(x3, w, ws);
            const f32x4 a0 = x0 + t1, a1 = x0 - t1, a2 = x2 + t3, a3 = x2 - t3;
            const f32x4 u2 = cmul4(a2, w2, w2s), u3 = cmul4(a3, w2, w2s);
            f32x4 iu3 = __builtin_shufflevector(u3, u3, 1, 0, 3, 2); iu3.x = -iu3.x; iu3.z = -iu3.z;
            const f32x4 o0 = a0 + u2, o1 = a1 + iu3, o2 = a0 - u2, o3 = a1 - iu3;
            *P0 = o0; *P1 = o1; *P2 = o2; *P3 = o3;
        }
        __syncthreads();
    }
}
__device__ __forceinline__ void fft_table(LAS f32x2* TL, const GAS f32x2* TW, int tid) { if (tid < 320) TL[tid] = tid < 64 ? TW[tid] : TW[(tid - 64) * 64]; }
__device__ __forceinline__ int brev14(int p) { return (int)(__builtin_bitreverse32((unsigned)p) >> 18); }

__device__ __forceinline__ void kspec_item(const Fr& F, const unsigned char* ws, int c) {
    LAS f32x2* X = (LAS f32x2*)F.L; LAS float* red = (LAS float*)(F.L + LDS_TAB);
    const GAS float* HP = (const GAS float*)(ws + WS_HPART); const GAS float* FILT = (const GAS float*)(ws + WS_FILT); const GAS f32x2* TW = (const GAS f32x2*)(ws + WS_TW);
    const int tid = F.tid; const GAS f32x2* TL = TW;
    if (tid < 256) { const float v0 = wave_sum(HP[((size_t)tid * 2 + 0) * 512 + c]), v1 = wave_sum(HP[((size_t)tid * 2 + 1) * 512 + c]); if (F.lane == 0) { red[F.wave * 2] = v0; red[F.wave * 2 + 1] = v1; } }
    __syncthreads();
    const float inv0 = 1.f / (((red[0] + red[2]) + red[4]) + red[6]), inv1 = 1.f / (((red[1] + red[3]) + red[5]) + red[7]);
    const GAS float* f0 = FILT + ((size_t)0 * 512 + c) * 8192; const GAS float* b0 = FILT + ((size_t)1 * 512 + c) * 8192; const GAS float* f1 = FILT + ((size_t)2 * 512 + c) * 8192; const GAS float* b1 = FILT + ((size_t)3 * 512 + c) * 8192;
    for (int s = tid; s < 8192; s += 512) { f32x2 v; v.x = f0[s] * inv0; v.y = f1[s] * inv1; X[fpad(s)] = v;
        f32x2 w; if (s == 0) { w.x = 0.f; w.y = 0.f; } else { w.x = b0[8192 - s] * inv0; w.y = b1[8192 - s] * inv1; } X[fpad(8192 + s)] = w; }
    __syncthreads();
    fft_fwd(X, TL, tid);
    GAS f32x2* K0 = (GAS f32x2*)(ws + WS_K0S) + (size_t)c * FFTN; GAS f32x2* K1 = (GAS f32x2*)(ws + WS_K1S) + (size_t)c * FFTN;
    const float sc = 0.5f / (float)FFTN;
    for (int p = tid; p < FFTN; p += 512) { const int f = brev14(p), p2 = brev14((FFTN - f) & (FFTN - 1)); const f32x2 A = X[fpad(p)], B = X[fpad(p2)];
        f32x2 k0, k1; k0.x = (A.x + B.x) * sc; k0.y = (A.y - B.y) * sc; k1.x = (A.y + B.y) * sc; k1.y = (B.x - A.x) * sc; K0[p] = k0; K1[p] = k1; }
    __syncthreads();
}

__device__ __forceinline__ void hyconv_item(const Fr& F, const Args& a, const unsigned char* ws, int l, int c) {
    LAS f32x2* X = (LAS f32x2*)F.L; const GAS f32x2* TW = (const GAS f32x2*)(ws + WS_TW); const int tid = F.tid;
    const GAS bf16* vT = (const GAS bf16*)(ws + WS_HYT) + (size_t)c * NLAT; const GAS bf16* x1T = vT + (size_t)512 * NLAT; const GAS bf16* x2T = vT + (size_t)1024 * NLAT;
    const GAS f32x2* K0 = (const GAS f32x2*)(ws + WS_K0S) + (size_t)c * FFTN; const GAS f32x2* K1 = (const GAS f32x2*)(ws + WS_K1S) + (size_t)c * FFTN;
    const float bias0 = INP(a, I_HBIAS)[(size_t)l * 1024 + c], bias1 = INP(a, I_HBIAS)[(size_t)l * 1024 + 512 + c];
    f32x2 zero; zero.x = 0.f; zero.y = 0.f; const GAS f32x2* TL = TW;
#pragma unroll
    for (int i = 0; i < 16; ++i) { const int s = tid + 512 * i; f32x2 v; v.x = bf2f(vT[s]); v.y = bf2f(vT[8192 + s]); X[fpad(s)] = v; X[fpad(8192 + s)] = zero; }
    __syncthreads();
    fft_fwd(X, TL, tid);
    for (int p = tid; p < FFTN; p += 512) X[fpad(p)] = cmul(X[fpad(p)], K0[p]);
    __syncthreads();
    fft_inv(X, TL, tid);
    float z0[16], z1[16];
#pragma unroll
    for (int i = 0; i < 16; ++i) { const int s = tid + 512 * i; const f32x2 y = X[fpad(s)];
        z0[i] = bf2f(x1T[s]) * (y.x + bias0 * bf2f(vT[s])); z1[i] = bf2f(x1T[8192 + s]) * (y.y + bias0 * bf2f(vT[8192 + s]));
        f32x2 v; v.x = z0[i]; v.y = z1[i]; X[fpad(s)] = v; X[fpad(8192 + s)] = zero; }
    __syncthreads();
    fft_fwd(X, TL, tid);
    for (int p = tid; p < FFTN; p += 512) X[fpad(p)] = cmul(X[fpad(p)], K1[p]);
    __syncthreads();
    fft_inv(X, TL, tid);
    GAS bf16* o = (GAS bf16*)(ws + WS_OHYT) + (size_t)c * NLAT;
#pragma unroll
    for (int i = 0; i < 16; ++i) { const int s = tid + 512 * i; const f32x2 y = X[fpad(s)];
        o[s] = (bf16)f2bf(bf2f(x2T[s]) * (y.x + bias1 * z0[i])); o[8192 + s] = (bf16)f2bf(bf2f(x2T[8192 + s]) * (y.y + bias1 * z1[i])); }
    __syncthreads();
}

__device__ __forceinline__ void hyctx_item(const Fr& F, const Args& a, const unsigned char* ws, int l, int c) {
    LAS float* fl = (LAS float*)F.L;
    LAS float* vv = fl + 1024;
    LAS float* zz = vv + 512;
    LAS float* red = zz + 512;
    const float* HP = (const float*)(ws + WS_HPARTC); const float* FC = (const float*)(ws + WS_FILTC); const int tid = F.tid;
    if (tid < 16) red[tid] = HP[((size_t)(tid >> 1) * 2 + (tid & 1)) * 512 + c];
    __syncthreads();
    float s0 = 0.f, s1 = 0.f;
#pragma unroll
    for (int k = 0; k < 8; ++k) { s0 += red[2 * k]; s1 += red[2 * k + 1]; }
    const float inv0 = 1.f / s0, inv1 = 1.f / s1;
    const bf16* T = (const bf16*)(ws + WS_HYTC);
    for (int i = tid; i < 1024; i += 512) { const int q = i >> 8, s = i & 255; fl[i] = FC[((size_t)q * 512 + c) * 256 + s] * (q < 2 ? inv0 : inv1); }
    const int b = tid >> 8, t = tid & 255;
    const float v = bf2f(T[((size_t)c * 2 + b) * 256 + t]), x1 = bf2f(T[((size_t)(512 + c) * 2 + b) * 256 + t]), x2 = bf2f(T[((size_t)(1024 + c) * 2 + b) * 256 + t]);
    vv[tid] = v;
    __syncthreads();
    const float bias0 = INP(a, I_HBIAS)[(size_t)l * 1024 + c], bias1 = INP(a, I_HBIAS)[(size_t)l * 1024 + 512 + c];
    float y = 0.f;
    for (int s = 0; s <= t; ++s) y += fl[t - s] * vv[b * 256 + s];
    for (int s = t + 1; s < 256; ++s) y += fl[256 + s - t] * vv[b * 256 + s];
    const float z = x1 * (y + bias0 * v);
    zz[tid] = z;
    __syncthreads();
    float y2 = 0.f;
    for (int s = 0; s <= t; ++s) y2 += fl[512 + t - s] * zz[b * 256 + s];
    for (int s = t + 1; s < 256; ++s) y2 += fl[768 + s - t] * zz[b * 256 + s];
    bf16* OBR2 = (bf16*)(ws + WS_OBR) + (size_t)2 * MALL * 512;
    OBR2[(size_t)(NLAT + b * 256 + t) * 512 + c] = (bf16)f2bf(x2 * (y2 + bias1 * z));
    __syncthreads();
}

__device__ __forceinline__ void conv3_item(const Fr& F, const Args& a, const GAS bf16* Prows  , int Ls, GAS bf16* HT  , int l, int t0, int c0) {
    LAS float* T = (LAS float*)F.L;
    const int tid = F.tid;
    for (int idx = tid; idx < 130 * 8; idx += 512) { const int r = idx >> 3, c8 = (idx & 7) * 8; const int t = t0 - 1 + r;
        v4u v = (v4u){0u, 0u, 0u, 0u}; if (t >= 0 && t < Ls) v = *(const GAS v4u*)(Prows + (size_t)t * INPAD + O_HY + c0 + c8);
        LAS float* d = T + r * 65 + c8; d[0] = bflo(v.x); d[1] = bfhi(v.x); d[2] = bflo(v.y); d[3] = bfhi(v.y); d[4] = bflo(v.z); d[5] = bfhi(v.z); d[6] = bflo(v.w); d[7] = bfhi(v.w); }
    __syncthreads();
    const int cc = tid >> 3, tq = tid & 7; const int c3 = c0 + cc;
    const GAS float* cw = (const GAS float*)INP(a, I_HCW) + (size_t)l * 3 * 1536; const float w0 = cw[c3], w1 = cw[1536 + c3], w2 = cw[3072 + c3], bb = ((const GAS float*)INP(a, I_HCB))[(size_t)l * 1536 + c3];
#pragma unroll
    for (int hh = 0; hh < 2; ++hh) { float y[8];
#pragma unroll
        for (int j = 0; j < 8; ++j) { const int t = hh * 64 + tq * 8 + j; y[j] = T[t * 65 + cc] * w0 + T[(t + 1) * 65 + cc] * w1 + T[(t + 2) * 65 + cc] * w2 + bb; }
        v4u o; o.x = pk2(y[0], y[1]); o.y = pk2(y[2], y[3]); o.z = pk2(y[4], y[5]); o.w = pk2(y[6], y[7]);
        *(GAS v4u*)(HT + (size_t)c3 * (2 * Ls) + t0 + hh * 64 + tq * 8) = o; }
    __syncthreads();
}

__device__ __forceinline__ void post_row(const Fr& F, const Args& a, unsigned char* ws, int l, int row, const LAS float* wa  ) {
    const int lane = F.lane; const bf16* pr = (const bf16*)(ws + WS_P) + (size_t)row * INPAD;
    { float v[6]; float ss = 0.f;
#pragma unroll
      for (int j = 0; j < 3; ++j) { const unsigned w = *(const unsigned*)(pr + O_MQA + 2 * lane + 128 * j); v[2 * j] = bflo(w); v[2 * j + 1] = bfhi(w); ss += v[2 * j] * v[2 * j] + v[2 * j + 1] * v[2 * j + 1]; }
      const float r = 1.f / sqrtf(wave_sum(ss) * (1.f / 384.f) + RMS_EPS); bf16* o = (bf16*)(ws + WS_NQ) + (size_t)row * 384;
#pragma unroll
      for (int j = 0; j < 3; ++j) *(unsigned*)(o + 2 * lane + 128 * j) = pk2(v[2 * j] * r, v[2 * j + 1] * r); }
    { float v[4]; float ss = 0.f;
#pragma unroll
      for (int j = 0; j < 2; ++j) { const unsigned w = *(const unsigned*)(pr + O_MKVA + 2 * lane + 128 * j); v[2 * j] = bflo(w); v[2 * j + 1] = bfhi(w); ss += v[2 * j] * v[2 * j] + v[2 * j + 1] * v[2 * j + 1]; }
      const float r = 1.f / sqrtf(wave_sum(ss) * (1.f / 256.f) + RMS_EPS); bf16* o = (bf16*)(ws + WS_NKV) + (size_t)row * 256;
#pragma unroll
      for (int j = 0; j < 2; ++j) *(unsigned*)(o + 2 * lane + 128 * j) = pk2(v[2 * j] * r, v[2 * j + 1] * r); }
    { const float pa = bf2f(pr[O_GAF + (lane & 31)]);
      const float* baf = INP(a, I_BAF) + l * 256; const float* bab = INP(a, I_BAB) + l * 256;
      float xf[4], xb[4];
#pragma unroll
      for (int j = 0; j < 4; ++j) { xf[j] = baf[lane + 64 * j]; xb[j] = bab[lane + 64 * j]; }
#pragma unroll
      for (int r = 0; r < 16; ++r) { const float pf = __shfl(pa, r), pb = __shfl(pa, 16 + r);
#pragma unroll
          for (int j = 0; j < 4; ++j) { xf[j] += pf * wa[r * 256 + lane + 64 * j]; xb[j] += pb * wa[4096 + r * 256 + lane + 64 * j]; } }
      float* AFp = (float*)(ws + WS_AF) + (size_t)row * 256; float* ABp = (float*)(ws + WS_AB) + (size_t)row * 256;
#pragma unroll
      for (int j = 0; j < 4; ++j) {
          const float lf = fminf(xf[j], 0.f) - __logf(1.f + __expf(-fabsf(xf[j]))), lb = fminf(xb[j], 0.f) - __logf(1.f + __expf(-fabsf(xb[j])));
          AFp[lane + 64 * j] = lf * (1.f / 16.f); ABp[lane + 64 * j] = lb * (1.f / 16.f); } }
    if (lane < 16) { float x1 = bf2f(pr[O_MKR + lane]), x2 = bf2f(pr[O_MKR + 16 + lane]); int b, key;
        if (row < NLAT) { const int t = row & 8191; b = row >> 13; key = CTXL + t; const float* cs = (const float*)(ws + WS_ROPE) + ((size_t)t * 16 + lane) * 2; const float cc = cs[0], sn = cs[1];
            const float o1 = x1 * cc - x2 * sn, o2 = x2 * cc + x1 * sn; x1 = o1; x2 = o2; }
        else { const int r2 = row - NLAT; b = r2 >> 8; key = r2 & 255; }
        const bf16 h1 = (bf16)f2bf(x1), h2 = (bf16)f2bf(x2); bf16* kb = (bf16*)(ws + WS_KB) + ((size_t)(b * 8) * KEYS + key) * 96 + 64 + lane;
#pragma unroll
        for (int h = 0; h < 8; ++h) { kb[(size_t)h * KEYS * 96] = h1; kb[(size_t)h * KEYS * 96 + 16] = h2; } }
}

__device__ __forceinline__ float max3f(float a, float b, float c) { float r; asm("v_max3_f32 %0, %1, %2, %3" : "=v"(r) : "v"(a), "v"(b), "v"(c)); return r; }
__device__ __forceinline__ int kap(int r) { return (r & 0x13) | ((r & 4) << 1) | ((r & 8) >> 1); }
__device__ __forceinline__ unsigned pkbf2(float lo, float hi) { unsigned r; asm volatile("v_cvt_pk_bf16_f32 %0, %1, %2" : "=v"(r) : "v"(lo), "v"(hi)); return r; }
__device__ __forceinline__ void attn_unit(const int VAR, const Fr& F, const GAS bf16* QB, const GAS bf16* KBh, const GAS bf16* VTh, GAS bf16* O, int qrow0, int head, int ntiles, const GAS float* rope) {
    constexpr int KROW = 208, VROW = 144, KBYTES = 64 * KROW, BUF = KBYTES + 64 * VROW;
    const int tid = F.tid, lane = F.lane, wave = F.wave, r = lane & 31, hh = lane >> 5;
    LAS unsigned char* L = F.L;
    bf16x8 qf[6];
    { const GAS bf16* qp = QB + (size_t)(qrow0 + wave * 32 + r) * 768 + head * 96 + 8 * hh;
#pragma unroll
      for (int ks = 0; ks < 6; ++ks) qf[ks] = *(const GAS bf16x8*)(qp + 16 * ks);
      if (qrow0 < NLAT) {
          const GAS float* cs = rope + ((size_t)((qrow0 + wave * 32 + r) & 8191) * 16 + 8 * hh) * 2;
          v4u a = __builtin_bit_cast(v4u, qf[4]), b = __builtin_bit_cast(v4u, qf[5]);
#pragma unroll
          for (int i = 0; i < 4; ++i) { const f32x4 c4 = *(const GAS f32x4*)(cs + 4 * i);
              const float x1l = bflo(a[i]), x1h = bfhi(a[i]), x2l = bflo(b[i]), x2h = bfhi(b[i]);
              a[i] = pk2(x1l * c4[0] - x2l * c4[1], x1h * c4[2] - x2h * c4[3]); b[i] = pk2(x2l * c4[0] + x1l * c4[1], x2h * c4[2] + x1h * c4[3]); }
          qf[4] = __builtin_bit_cast(bf16x8, a); qf[5] = __builtin_bit_cast(bf16x8, b); } }
    const int kq0 = tid, kq1 = 512 + tid;
    const int kl0 = (kq0 / 12) * KROW + (kq0 % 12) * 16, kl1 = (kq1 / 12) * KROW + (kq1 % 12) * 16;
    const int vrow = tid >> 3, vch = tid & 7; const int vl = KBYTES + vrow * VROW + vch * 16;
    const GAS bf16* vsrc = VTh + (size_t)vrow * KEYS + vch * 8;
    v4u k0r, k1r, vr; k1r = (v4u){0u, 0u, 0u, 0u};
#define AT_LOAD(K0_, K1_, V_, t_) do { if (VAR == 4) break; const GAS unsigned char* kt_ = (const GAS unsigned char*)KBh + (size_t)(t_) * (64 * 192); K0_ = *(const GAS v4u*)(kt_ + (size_t)kq0 * 16); if (tid < 256) K1_ = *(const GAS v4u*)(kt_ + (size_t)kq1 * 16); \
        V_ = *(const GAS v4u*)(vsrc + (size_t)(t_) * 64); } while (0)
#define AT_WRITE(K0_, K1_, V_, bo_) do { if (VAR == 4) break; LAS unsigned char* Bn_ = L + (bo_); *(LAS v4u*)(Bn_ + kl0) = K0_; if (tid < 256) *(LAS v4u*)(Bn_ + kl1) = K1_; *(LAS v4u*)(Bn_ + vl) = V_; } while (0)
#define AT_SOFT(S_, PB_, RS_, MX_) do { f32x2 pp_[8]; \
        _Pragma("unroll") for (int i_ = 0; i_ < 8; ++i_) { pp_[i_].x = __builtin_amdgcn_exp2f(S_[2 * i_]); pp_[i_].y = __builtin_amdgcn_exp2f(S_[2 * i_ + 1]); } \
        _Pragma("unroll") for (int s2_ = 0; s2_ < 2; ++s2_) { v4u w_; w_.x = pkbf2(pp_[4 * s2_].x, pp_[4 * s2_].y); w_.y = pkbf2(pp_[4 * s2_ + 1].x, pp_[4 * s2_ + 1].y); w_.z = pkbf2(pp_[4 * s2_ + 2].x, pp_[4 * s2_ + 2].y); w_.w = pkbf2(pp_[4 * s2_ + 3].x, pp_[4 * s2_ + 3].y); \
            PB_[s2_] = __builtin_bit_cast(bf16x8, w_); } \
        MX_ = 0.f; \
        pp_[0] += pp_[4]; pp_[1] += pp_[5]; pp_[2] += pp_[6]; pp_[3] += pp_[7]; pp_[0] += pp_[2]; pp_[1] += pp_[3]; RS_ = pp_[0] + pp_[1]; } while (0)
#define AT_TILE(bo_) do { const LAS unsigned char* B_ = L + (bo_); bf16x8 ka_[12], va_[8], pb0_[2], pb1_[2]; f32x2 rs0_, rs1_; float mx0_, mx1_; \
        _Pragma("unroll") for (int ks_ = 0; ks_ < 6; ++ks_) { ka_[2 * ks_] = *(const LAS bf16x8*)(B_ + koff + ks_ * 32); ka_[2 * ks_ + 1] = *(const LAS bf16x8*)(B_ + koff + 32 * KROW + ks_ * 32); } \
        _Pragma("unroll") for (int kb_ = 0; kb_ < 2; ++kb_) _Pragma("unroll") for (int s2_ = 0; s2_ < 2; ++s2_) { \
            va_[(kb_ * 2 + s2_) * 2] = *(const LAS bf16x8*)(B_ + voff + (32 * kb_ + 16 * s2_) * 2); va_[(kb_ * 2 + s2_) * 2 + 1] = *(const LAS bf16x8*)(B_ + voff + 32 * VROW + (32 * kb_ + 16 * s2_) * 2); } \
        asm volatile("s_waitcnt lgkmcnt(8)" ::: "memory"); __builtin_amdgcn_sched_barrier(0); \
        _Pragma("unroll") for (int ks_ = 0; ks_ < 6; ++ks_) sA0 = __builtin_amdgcn_mfma_f32_32x32x16_bf16(ka_[2 * ks_], qf[ks_], sA0, 0, 0, 0); \
        __builtin_amdgcn_sched_barrier(0); \
        _Pragma("unroll") for (int ks_ = 0; ks_ < 6; ++ks_) sA1 = __builtin_amdgcn_mfma_f32_32x32x16_bf16(ka_[2 * ks_ + 1], qf[ks_], sA1, 0, 0, 0); \
        AT_SOFT(sA0, pb0_, rs0_, mx0_); \
        _Pragma("unroll") for (int g_ = 0; g_ < 6; ++g_) { __builtin_amdgcn_sched_group_barrier(0x008, 1, 0); __builtin_amdgcn_sched_group_barrier(0x402, 10, 0); } \
        asm volatile("s_waitcnt lgkmcnt(0)" ::: "memory"); __builtin_amdgcn_sched_barrier(0); \
        _Pragma("unroll") for (int s2_ = 0; s2_ < 2; ++s2_) { o0 = __builtin_amdgcn_mfma_f32_32x32x16_bf16(va_[s2_ * 2], pb0_[s2_], o0, 0, 0, 0); o1 = __builtin_amdgcn_mfma_f32_32x32x16_bf16(va_[s2_ * 2 + 1], pb0_[s2_], o1, 0, 0, 0); } \
        AT_SOFT(sA1, pb1_, rs1_, mx1_); \
        _Pragma("unroll") for (int g_ = 0; g_ < 4; ++g_) { __builtin_amdgcn_sched_group_barrier(0x008, 1, 0); __builtin_amdgcn_sched_group_barrier(0x402, 14, 0); } \
        __builtin_amdgcn_sched_barrier(0); \
        _Pragma("unroll") for (int s2_ = 0; s2_ < 2; ++s2_) { o0 = __builtin_amdgcn_mfma_f32_32x32x16_bf16(va_[4 + s2_ * 2], pb1_[s2_], o0, 0, 0, 0); o1 = __builtin_amdgcn_mfma_f32_32x32x16_bf16(va_[4 + s2_ * 2 + 1], pb1_[s2_], o1, 0, 0, 0); } \
        float pm_; { const f32x2 rs_ = rs0_ + rs1_; const float rsum_ = rs_.x + rs_.y; l_run += rsum_; pm_ = rsum_ + __shfl_xor(rsum_, 32); (void)mx0_; (void)mx1_; \
          const float nm_ = -m_run; _Pragma("unroll") for (int i_ = 0; i_ < 16; ++i_) { sA0[i_] = nm_; sA1[i_] = nm_; } }        \
        _Pragma("unroll") for (int g_ = 0; g_ < 4; ++g_) { __builtin_amdgcn_sched_group_barrier(0x008, 1, 0); __builtin_amdgcn_sched_group_barrier(0x402, 10, 0); } \
        __builtin_amdgcn_sched_barrier(0); \
        if (__any(pm_ > 2048.f)) { const float dl_ = fmaxf(__builtin_amdgcn_logf(pm_) - 5.f, 0.f), al_ = __builtin_amdgcn_exp2f(-dl_); m_run += dl_; l_run *= al_; const float nm_ = -m_run; \
            _Pragma("unroll") for (int i_ = 0; i_ < 16; ++i_) { o0[i_] *= al_; o1[i_] *= al_; sA0[i_] = nm_; sA1[i_] = nm_; } } \
        __builtin_amdgcn_sched_barrier(0); } while (0)
#define AT_QK0(S0_, S1_, bo_) do { const LAS unsigned char* B_ = L + (bo_); _Pragma("unroll") for (int i_ = 0; i_ < 16; ++i_) { S0_[i_] = 0.f; S1_[i_] = 0.f; } \
        _Pragma("unroll") for (int ks_ = 0; ks_ < 6; ++ks_) { const bf16x8 a0_ = *(const LAS bf16x8*)(B_ + koff + ks_ * 32), a1_ = *(const LAS bf16x8*)(B_ + koff + 32 * KROW + ks_ * 32); \
            S0_ = __builtin_amdgcn_mfma_f32_32x32x16_bf16(a0_, qf[ks_], S0_, 0, 0, 0); S1_ = __builtin_amdgcn_mfma_f32_32x32x16_bf16(a1_, qf[ks_], S1_, 0, 0, 0); } } while (0)
    f32x16 o0, o1, sA0, sA1;
    const bool late = wave >= 4;
#pragma unroll
    for (int i = 0; i < 16; ++i) { o0[i] = 0.f; o1[i] = 0.f; }
    float m_run = -100.f, l_run = 0.f;
    const int koff = kap(r) * KROW + 16 * hh, voff = KBYTES + r * VROW + 16 * hh;
    v4u k0y, k1y, vy; k1y = (v4u){0u, 0u, 0u, 0u};
    AT_LOAD(k0r, k1r, vr, 0); AT_WRITE(k0r, k1r, vr, 0); AT_LOAD(k0r, k1r, vr, 1); AT_WRITE(k0r, k1r, vr, BUF);
    if (ntiles > 2) { AT_LOAD(k0r, k1r, vr, 2); AT_LOAD(k0y, k1y, vy, 3); }
    __syncthreads();
    AT_QK0(sA0, sA1, 0);
    { float mx = fmaxf(sA0[0], sA1[0]);
#pragma unroll
      for (int i = 1; i < 16; ++i) mx = fmaxf(mx, fmaxf(sA0[i], sA1[i]));
      m_run = fmaxf(mx, __shfl_xor(mx, 32)); }
    { const float nm = -m_run;
#pragma unroll
      for (int i = 0; i < 16; ++i) { sA0[i] = nm; sA1[i] = nm; } }
    int B0 = 0, B1 = 2 * BUF;
    for (int t = 0; t < ntiles; t += 2) {
        AT_TILE(B0);
        if (t + 2 < ntiles) AT_WRITE(k0r, k1r, vr, B1);
        if (t + 4 < ntiles) AT_LOAD(k0r, k1r, vr, t + 4);
        AT_TILE(B0 + BUF);
        if (t + 3 < ntiles) AT_WRITE(k0y, k1y, vy, B1 + BUF);
        if (t + 5 < ntiles) AT_LOAD(k0y, k1y, vy, t + 5);
        __syncthreads();
        { const int n0 = B1; B1 = B0; B0 = n0; }
    }
#undef AT_LOAD
#undef AT_WRITE
#undef AT_TILE
#undef AT_SOFT
#undef AT_QK0
    const float inv = 1.f / (l_run + __shfl_xor(l_run, 32));
    GAS bf16* op = O + (size_t)(qrow0 + wave * 32 + r) * 512 + head * 64 + 4 * hh;
#pragma unroll
    for (int g = 0; g < 4; ++g) { v2u w; w.x = pk2(o0[4 * g] * inv, o0[4 * g + 1] * inv); w.y = pk2(o0[4 * g + 2] * inv, o0[4 * g + 3] * inv); *(GAS v2u*)(op + 8 * g) = w;
        v2u w2; w2.x = pk2(o1[4 * g] * inv, o1[4 * g + 1] * inv); w2.y = pk2(o1[4 * g + 2] * inv, o1[4 * g + 3] * inv); *(GAS v2u*)(op + 32 + 8 * g) = w2; }
}


constexpr int GR = 72;
__device__ __forceinline__ int gla_mb(int c) { return c < 4 ? 3 - c : 4 + (131 - c); }
__device__ __forceinline__ int gla_row0(int b, int c) { return c < 4 ? NLAT + b * CTXL + 64 * c : b * SEQ + 64 * (c - 4); }
constexpr int GL_BF = 0, GL_BB = GL_BF + 64 * 65 * 4, GL_A0 = GL_BB + 64 * 65 * 4;
__device__ __forceinline__ void gla_cumsum(const Fr& F, const unsigned char* ws, int row0, int h) {
    LAS float* BF = (LAS float*)(F.L + GL_BF); LAS float* BB = (LAS float*)(F.L + GL_BB); const int tid = F.tid;
    { const int t = tid >> 3, d8 = (tid & 7) * 8; const GAS float* gf = (const GAS float*)(ws + WS_AF) + (size_t)(row0 + t) * 256 + h * 64 + d8; const GAS float* gb = (const GAS float*)(ws + WS_AB) + (size_t)(row0 + t) * 256 + h * 64 + d8;
      const f32x4 f0 = *(const f32x4*)gf, f1 = *(const GAS f32x4*)(gf + 4), b0 = *(const f32x4*)gb, b1 = *(const GAS f32x4*)(gb + 4);
#pragma unroll
      for (int i = 0; i < 4; ++i) { BF[t * 65 + d8 + i] = f0[i]; BF[t * 65 + d8 + 4 + i] = f1[i]; BB[t * 65 + d8 + i] = b0[i]; BB[t * 65 + d8 + 4 + i] = b1[i]; } }
    __syncthreads();
    if (tid < 64) { float s = 0.f;
#pragma unroll 8
        for (int t = 0; t < 64; ++t) { s += BF[t * 65 + tid]; BF[t * 65 + tid] = s; } }
    else if (tid < 128) { const int d = tid - 64; float s = 0.f;
#pragma unroll 8
        for (int t = 63; t >= 0; --t) { s += BB[t * 65 + d]; BB[t * 65 + d] = s; } }
    __syncthreads();
}

__device__ __forceinline__ void gla_a_item(const Fr& F, unsigned char* ws, int item) {
    const int c = item % 132, bh = item / 132, h = bh & 3, b = bh >> 2; const int row0 = gla_row0(b, c); const int tid = F.tid, lane = F.lane, wave = F.wave;
    gla_cumsum(F, ws, row0, h);
    LAS float* BF = (LAS float*)(F.L + GL_BF); LAS float* BB = (LAS float*)(F.L + GL_BB);
    LAS bf16* KTF = (LAS bf16*)(F.L + GL_A0);
    LAS bf16* KTB = KTF + 64 * GR;
    LAS bf16* VT = KTB + 64 * GR;
    const GAS bf16* P = (const GAS bf16*)(ws + WS_P);
    { const int t = tid >> 3, d8 = (tid & 7) * 8; const v4u kr = *(const GAS v4u*)(P + (size_t)(row0 + t) * INPAD + O_GK + h * 64 + d8);
#pragma unroll
      for (int i = 0; i < 8; ++i) { const int d = d8 + i; const float k = (i & 1) ? bfhi(kr[i >> 1]) : bflo(kr[i >> 1]);
          KTF[d * GR + t] = (bf16)f2bf(k * __expf(BF[63 * 65 + d] - BF[t * 65 + d])); KTB[d * GR + t] = (bf16)f2bf(k * __expf(BB[d] - BB[t * 65 + d])); }
#pragma unroll
      for (int q = 0; q < 2; ++q) { const int e8 = ((tid & 7) + 8 * q) * 8; const v4u vr = *(const GAS v4u*)(P + (size_t)(row0 + t) * INPAD + O_GV + h * 128 + e8);
#pragma unroll
          for (int i = 0; i < 8; ++i) VT[(e8 + i) * GR + t] = (bf16)((i & 1) ? (vr[i >> 1] >> 16) : (vr[i >> 1] & 0xffffu)); } }
    __syncthreads();
    const int r = lane & 31, hh = lane >> 5, eb = wave & 3, db = wave >> 2;
#pragma unroll
    for (int dir = 0; dir < 2; ++dir) { const LAS bf16* KT = dir ? KTB : KTF; f32x16 acc;
#pragma unroll
        for (int i = 0; i < 16; ++i) acc[i] = 0.f;
#pragma unroll
        for (int s = 0; s < 4; ++s) { const bf16x8 av = *(const LAS bf16x8*)(VT + (32 * eb + r) * GR + 16 * s + 8 * hh), bk = *(const LAS bf16x8*)(KT + (32 * db + r) * GR + 16 * s + 8 * hh);
            acc = __builtin_amdgcn_mfma_f32_32x32x16_bf16(av, bk, acc, 0, 0, 0); }
        const int chain = bh * 2 + dir, m = dir ? gla_mb(c) : c; GAS float* dst = (GAS float*)(ws + WS_GST) + ((size_t)chain * 132 + m) * 8192;
#pragma unroll
        for (int g = 0; g < 16; ++g) { const int e = 32 * eb + (g & 3) + 8 * (g >> 2) + 4 * hh; dst[e * 64 + 32 * db + r] = acc[g]; }
        if (wave == 0 && dir == 0) ((GAS float*)(ws + WS_GDEC))[((size_t)chain * 132 + m) * 64 + lane] = __expf(BF[63 * 65 + lane]);
        if (wave == 1 && dir == 1) ((GAS float*)(ws + WS_GDEC))[((size_t)chain * 132 + m) * 64 + lane] = __expf(BB[lane]); }
    __syncthreads();
}

__device__ __forceinline__ void gla_scan_q(const Fr& F, unsigned char* ws, int item) {
    const int chain = item >> 4, part = item & 15; const int idx = part * 512 + F.tid;
    GAS float* st = (GAS float*)(ws + WS_GST) + (size_t)chain * 132 * 8192 + idx; const GAS float* dec = (const GAS float*)(ws + WS_GDEC) + (size_t)chain * 132 * 64 + (idx & 63);
    float s = 0.f; float dn[6], an[6];
#pragma unroll
    for (int k = 0; k < 6; ++k) { dn[k] = st[(size_t)k * 8192]; an[k] = dec[k * 64]; }
    for (int m = 0; m < 132; m += 6) {
        float d2[6], a2[6];
#pragma unroll
        for (int k = 0; k < 6; ++k) { d2[k] = dn[k]; a2[k] = an[k]; }
        if (m + 6 < 132) {
#pragma unroll
            for (int k = 0; k < 6; ++k) { dn[k] = st[(size_t)(m + 6 + k) * 8192]; an[k] = dec[(m + 6 + k) * 64]; } }
#pragma unroll
        for (int k = 0; k < 6; ++k) { st[(size_t)(m + k) * 8192] = s; s = a2[k] * s + d2[k]; }
    }
}

__device__ __forceinline__ void gla_c_item(const Fr& F, const Args& a, unsigned char* ws, int l, int item) {
    const int c = item % 132, bh = item / 132, h = bh & 3, b = bh >> 2; const int row0 = gla_row0(b, c); const int tid = F.tid, lane = F.lane, wave = F.wave;
    gla_cumsum(F, ws, row0, h);
    LAS float* BF = (LAS float*)(F.L + GL_BF); LAS float* BB = (LAS float*)(F.L + GL_BB);
    LAS bf16* QF = (LAS bf16*)(F.L + GL_A0);
    LAS bf16* KF = QF + 64 * GR;
    LAS bf16* QBk = KF + 64 * GR;
    LAS bf16* KBk = QBk + 64 * GR;
    LAS bf16* VT = KBk + 64 * GR;
    LAS bf16* SF = VT + 128 * GR;
    LAS bf16* SB = SF + 128 * GR;
    LAS float* red = (LAS float*)(SB + 128 * GR);
    const GAS bf16* P = (const GAS bf16*)(ws + WS_P);
    { const int t = tid >> 3, d8 = (tid & 7) * 8; const GAS bf16* pr = P + (size_t)(row0 + t) * INPAD; const v4u qr = *(const GAS v4u*)(pr + O_GQ + h * 64 + d8), kr = *(const GAS v4u*)(pr + O_GK + h * 64 + d8);
      v4u qf, kf, qb, kb;
#pragma unroll
      for (int i = 0; i < 4; ++i) { const float q0 = bflo(qr[i]) * 0.125f, q1 = bfhi(qr[i]) * 0.125f, k0 = bflo(kr[i]), k1 = bfhi(kr[i]);
          const float f0 = BF[t * 65 + d8 + 2 * i], f1 = BF[t * 65 + d8 + 2 * i + 1], g0 = BB[t * 65 + d8 + 2 * i], g1 = BB[t * 65 + d8 + 2 * i + 1];
          qf[i] = pk2(q0 * __expf(f0), q1 * __expf(f1)); kf[i] = pk2(k0 * __expf(-f0), k1 * __expf(-f1)); qb[i] = pk2(q0 * __expf(g0), q1 * __expf(g1)); kb[i] = pk2(k0 * __expf(-g0), k1 * __expf(-g1)); }
      *(LAS v4u*)(QF + t * GR + d8) = qf; *(LAS v4u*)(KF + t * GR + d8) = kf; *(LAS v4u*)(QBk + t * GR + d8) = qb; *(LAS v4u*)(KBk + t * GR + d8) = kb;
#pragma unroll
      for (int q = 0; q < 2; ++q) { const int e8 = ((tid & 7) + 8 * q) * 8; const v4u vr = *(const GAS v4u*)(pr + O_GV + h * 128 + e8);
#pragma unroll
          for (int i = 0; i < 8; ++i) VT[(e8 + i) * GR + t] = (bf16)((i & 1) ? (vr[i >> 1] >> 16) : (vr[i >> 1] & 0xffffu)); } }
    { const GAS float* sf = (const GAS float*)(ws + WS_GST) + ((size_t)(bh * 2) * 132 + c) * 8192; const GAS float* sb = (const GAS float*)(ws + WS_GST) + ((size_t)(bh * 2 + 1) * 132 + gla_mb(c)) * 8192;
#pragma unroll
      for (int q = 0; q < 2; ++q) { const int idx = (tid + 512 * q) * 8, e = idx >> 6, d = idx & 63;
          const f32x4 x0 = *(const GAS f32x4*)(sf + idx), x1 = *(const GAS f32x4*)(sf + idx + 4), y0 = *(const GAS f32x4*)(sb + idx), y1 = *(const GAS f32x4*)(sb + idx + 4);
          v4u w; w.x = pk2(x0[0], x0[1]); w.y = pk2(x0[2], x0[3]); w.z = pk2(x1[0], x1[1]); w.w = pk2(x1[2], x1[3]); *(LAS v4u*)(SF + e * GR + d) = w;
          v4u z; z.x = pk2(y0[0], y0[1]); z.y = pk2(y0[2], y0[3]); z.z = pk2(y1[0], y1[1]); z.w = pk2(y1[2], y1[3]); *(LAS v4u*)(SB + e * GR + d) = z; } }
    __syncthreads();
    const int r = lane & 31, hh = lane >> 5, eb = wave & 3, ib = wave >> 2;
    f32x16 O;
#pragma unroll
    for (int i = 0; i < 16; ++i) O[i] = 0.f;
#pragma unroll
    for (int dir = 0; dir < 2; ++dir) { const LAS bf16* Qd = dir ? QBk : QF; const LAS bf16* Kd = dir ? KBk : KF; const LAS bf16* Sd = dir ? SB : SF;
        bf16x8 qfr[4];
#pragma unroll
        for (int s = 0; s < 4; ++s) qfr[s] = *(const LAS bf16x8*)(Qd + (32 * ib + r) * GR + 16 * s + 8 * hh);
#pragma unroll
        for (int jb = 0; jb < 2; ++jb) { f32x16 pt;
#pragma unroll
            for (int i = 0; i < 16; ++i) pt[i] = 0.f;
#pragma unroll
            for (int s = 0; s < 4; ++s) { const bf16x8 ka = *(const LAS bf16x8*)(Kd + (32 * jb + kap(r)) * GR + 16 * s + 8 * hh); pt = __builtin_amdgcn_mfma_f32_32x32x16_bf16(ka, qfr[s], pt, 0, 0, 0); }
            const int ti = 32 * ib + r;
#pragma unroll
            for (int g = 0; g < 16; ++g) { const int tj = 32 * jb + kap((g & 3) + 8 * (g >> 2) + 4 * hh); const bool keep = dir ? (tj >= ti) : (tj <= ti); pt[g] = keep ? pt[g] : 0.f; }
#pragma unroll
            for (int s2 = 0; s2 < 2; ++s2) { v4u w; w.x = pkbf2(pt[8 * s2 + 0], pt[8 * s2 + 1]); w.y = pkbf2(pt[8 * s2 + 2], pt[8 * s2 + 3]); w.z = pkbf2(pt[8 * s2 + 4], pt[8 * s2 + 5]); w.w = pkbf2(pt[8 * s2 + 6], pt[8 * s2 + 7]);
                const bf16x8 va = *(const LAS bf16x8*)(VT + (32 * eb + r) * GR + 32 * jb + 16 * s2 + 8 * hh);
                O = __builtin_amdgcn_mfma_f32_32x32x16_bf16(va, __builtin_bit_cast(bf16x8, w), O, 0, 0, 0); } }
#pragma unroll
        for (int s = 0; s < 4; ++s) { const bf16x8 sa = *(const LAS bf16x8*)(Sd + (32 * eb + r) * GR + 16 * s + 8 * hh); O = __builtin_amdgcn_mfma_f32_32x32x16_bf16(sa, qfr[s], O, 0, 0, 0); } }
    { float ss = 0.f;
#pragma unroll
      for (int g = 0; g < 16; ++g) ss += O[g] * O[g];
      ss += __shfl_xor(ss, 32);
      if (hh == 0) red[eb * 64 + 32 * ib + r] = ss; }
    __syncthreads();
    { const int ti = 32 * ib + r; const float tot = (red[ti] + red[64 + ti]) + (red[128 + ti] + red[192 + ti]); const float rs = 1.f / sqrtf(tot * (1.f / 128.f) + RMS_EPS);
      const GAS float* gn = (const GAS float*)INP(a, I_GNORM) + l * 128; const GAS bf16* pr = P + (size_t)(row0 + ti) * INPAD + O_GR + h * 128; GAS bf16* o = (GAS bf16*)(ws + WS_OBR) + (size_t)(row0 + ti) * 512 + h * 128;
#pragma unroll
      for (int g4 = 0; g4 < 4; ++g4) { const int e = 32 * eb + 8 * g4 + 4 * hh; const f32x4 gv = *(const GAS f32x4*)(gn + e); const v2u rw = *(const GAS v2u*)(pr + e);
          const float r0 = bflo(rw.x), r1 = bfhi(rw.x), r2 = bflo(rw.y), r3 = bfhi(rw.y);
          const float y0 = O[4 * g4] * rs * gv[0] * (r0 / (1.f + __expf(-r0))), y1 = O[4 * g4 + 1] * rs * gv[1] * (r1 / (1.f + __expf(-r1)));
          const float y2 = O[4 * g4 + 2] * rs * gv[2] * (r2 / (1.f + __expf(-r2))), y3 = O[4 * g4 + 3] * rs * gv[3] * (r3 / (1.f + __expf(-r3)));
          v2u w; w.x = pk2(y0, y1); w.y = pk2(y2, y3); *(GAS v2u*)(o + e) = w; } }
    __syncthreads();
}

__device__ __forceinline__ void gate_row(const Fr& F, unsigned char* ws, int row) {
    const int lane = F.lane; const GAS bf16* pg = (const GAS bf16*)(ws + WS_P) + (size_t)row * INPAD + O_GATE; const GAS bf16* pu = (const GAS bf16*)(ws + WS_U) + (size_t)row * 3072; GAS bf16* po = (GAS bf16*)(ws + WS_YMB) + (size_t)row * 1024;
#pragma unroll
    for (int j = 0; j < 2; ++j) { const int c = 8 * lane + 512 * j; float y[8];
#pragma unroll
        for (int i = 0; i < 8; ++i) y[i] = 0.f;
#pragma unroll
        for (int br = 0; br < 3; ++br) { const v4u g = *(const GAS v4u*)(pg + br * 1024 + c), u = *(const GAS v4u*)(pu + br * 1024 + c);
#pragma unroll
            for (int i = 0; i < 4; ++i) { y[2 * i] += bflo(u[i]) * __builtin_amdgcn_rcpf(1.f + __expf(-bflo(g[i]))); y[2 * i + 1] += bfhi(u[i]) * __builtin_amdgcn_rcpf(1.f + __expf(-bfhi(g[i]))); } }
        v4u o; o.x = pk2(y[0], y[1]); o.y = pk2(y[2], y[3]); o.z = pk2(y[4], y[5]); o.w = pk2(y[6], y[7]); *(GAS v4u*)(po + c) = o; }
}
__device__ __forceinline__ void hy_tr_item(const Fr& F, unsigned char* ws, int item) {
    LAS bf16* T = (LAS bf16*)F.L;
    const int tid = F.tid; const int cb = item & 7, sb = (item >> 3) & 127, b = item >> 10; const int c0 = cb * 64, s0 = sb * 64;
    { const int cc = tid >> 3, sq = tid & 7; const v4u v = *(const v4u*)((const bf16*)(ws + WS_OHYT) + ((size_t)(c0 + cc) * 2 + b) * 8192 + s0 + sq * 8);
      *(LAS v4u*)(T + cc * 72 + sq * 8) = v; }
    __syncthreads();
    { const int ss = tid >> 3, cq = tid & 7; unsigned short e[8];
#pragma unroll
      for (int j = 0; j < 8; ++j) e[j] = T[(cq * 8 + j) * 72 + ss];
      v4u o; o.x = e[0] | ((unsigned)e[1] << 16); o.y = e[2] | ((unsigned)e[3] << 16); o.z = e[4] | ((unsigned)e[5] << 16); o.w = e[6] | ((unsigned)e[7] << 16);
      *(v4u*)((bf16*)(ws + WS_OBR) + (size_t)2 * MALL * 512 + (size_t)(b * 8192 + s0 + ss) * 512 + c0 + cq * 8) = o; }
    __syncthreads();
}

__device__ __forceinline__ void ln1_mod2(const GAS float* xp, GAS float* xs, GAS bf16* hb, const GAS float* g1, const GAS float* b1, const GAS float* sh2, const GAS float* sc2, float (&x)[16], int lane) {
    float s = 0.f;
#pragma unroll
    for (int i = 0; i < 16; ++i) { x[i] = xp[lane + 64 * i]; s += x[i]; }
    float mean = wave_sum(s) * (1.f / 1024.f); float q = 0.f;
#pragma unroll
    for (int i = 0; i < 16; ++i) { x[i] -= mean; q += x[i] * x[i]; }
    float rstd = 1.f / sqrtf(wave_sum(q) * (1.f / 1024.f) + LN_EPS);
    s = 0.f;
#pragma unroll
    for (int i = 0; i < 16; ++i) { x[i] = x[i] * rstd * g1[lane + 64 * i] + b1[lane + 64 * i]; xs[lane + 64 * i] = x[i]; s += x[i]; }
    mean = wave_sum(s) * (1.f / 1024.f); q = 0.f;
#pragma unroll
    for (int i = 0; i < 16; ++i) { x[i] -= mean; q += x[i] * x[i]; }
    rstd = 1.f / sqrtf(wave_sum(q) * (1.f / 1024.f) + LN_EPS);
#pragma unroll
    for (int i = 0; i < 16; ++i) { x[i] = x[i] * rstd * (1.f + sc2[lane + 64 * i]) + sh2[lane + 64 * i]; hb[lane + 64 * i] = (bf16)f2bf(x[i]); }
}
__device__ __forceinline__ float reduce32(float (&p)[32], int lane) {
    float a[16], b[8], c[4], d[2];
    { const bool up = (lane & 32) != 0;
#pragma unroll
      for (int e = 0; e < 16; ++e) { const float send = up ? p[e] : p[e + 16], keep = up ? p[e + 16] : p[e]; a[e] = keep + __shfl_xor(send, 32); } }
    { const bool up = (lane & 16) != 0;
#pragma unroll
      for (int e = 0; e < 8; ++e) { const float send = up ? a[e] : a[e + 8], keep = up ? a[e + 8] : a[e]; b[e] = keep + __shfl_xor(send, 16); } }
    { const bool up = (lane & 8) != 0;
#pragma unroll
      for (int e = 0; e < 4; ++e) { const float send = up ? b[e] : b[e + 4], keep = up ? b[e + 4] : b[e]; c[e] = keep + __shfl_xor(send, 8); } }
    { const bool up = (lane & 4) != 0;
#pragma unroll
      for (int e = 0; e < 2; ++e) { const float send = up ? c[e] : c[e + 2], keep = up ? c[e + 2] : c[e]; d[e] = keep + __shfl_xor(send, 4); } }
    float r;
    { const bool up = (lane & 2) != 0; const float send = up ? d[0] : d[1], keep = up ? d[1] : d[0]; r = keep + __shfl_xor(send, 2); }
    return r + __shfl_xor(r, 1);
}
__device__ __forceinline__ void route_row(unsigned char* ws, int l, int row, float tot, const GAS float* rb, int lane, bool dry, LAS unsigned* lcnt) {
    float mylogit = (lane & 1) ? -3.0e38f : tot + rb[lane >> 1];
    float tv[4]; int ti[4];
#pragma unroll
    for (int k = 0; k < 4; ++k) { const float mx = wave_max(mylogit); const unsigned long long bal = __ballot(mylogit == mx); const int idx = __builtin_ctzll(bal); tv[k] = mx; ti[k] = idx >> 1; if (lane == idx) mylogit = -3.0e38f; }
    const float e1 = expf(tv[1] - tv[0]), e2 = expf(tv[2] - tv[0]), e3 = expf(tv[3] - tv[0]); const float inv = 1.f / (1.f + e1 + e2 + e3);
    if (lane < 4 && !dry) { const int e = lane == 0 ? ti[0] : lane == 1 ? ti[1] : lane == 2 ? ti[2] : ti[3]; const float g = (lane == 0 ? 1.f : lane == 1 ? e1 : lane == 2 ? e2 : e3) * inv;
        const unsigned pos = __hip_atomic_fetch_add(lcnt + e, 1u, __ATOMIC_RELAXED, __HIP_MEMORY_SCOPE_WORKGROUP);
        ((GAS int*)(ws + WS_TOPE))[row * 4 + lane] = e; ((GAS float*)(ws + WS_TOPG))[row * 4 + lane] = g; ((GAS int*)(ws + WS_SPOS))[row * 4 + lane] = (int)pos; }
}
__device__ __forceinline__ void ln1_router_row2(const Fr& F, const Args& a, unsigned char* ws, int l, int row0, const LAS float* wT  , bool dry, LAS unsigned* lcnt) {
    const int lane = F.lane; const GAS float* g1 = (const GAS float*)INP(a, I_LN1G) + l * 1024; const GAS float* b1 = (const GAS float*)INP(a, I_LN1B) + l * 1024;
    const int mi = row0 < NLAT ? (row0 >> 13) : 2; const GAS float* mod = (const GAS float*)(ws + WS_MOD) + ((size_t)l * 3 + mi) * 6144;
    float x0[16], x1[16];
    ln1_mod2((const GAS float*)(ws + WS_XPRE) + (size_t)row0 * 1024, (GAS float*)(ws + WS_XS) + (size_t)row0 * 1024, (GAS bf16*)(ws + WS_HBF) + (size_t)row0 * 1024, g1, b1, mod + 3072, mod + 4096, x0, lane);
    ln1_mod2((const GAS float*)(ws + WS_XPRE) + (size_t)(row0 + 1) * 1024, (GAS float*)(ws + WS_XS) + (size_t)(row0 + 1) * 1024, (GAS bf16*)(ws + WS_HBF) + (size_t)(row0 + 1) * 1024, g1, b1, mod + 3072, mod + 4096, x1, lane);
    float p0[32], p1[32];
#pragma unroll
    for (int e = 0; e < 32; ++e) { float s0 = 0.f, s1 = 0.f;
#pragma unroll
        for (int i = 0; i < 16; ++i) { const float w = wT[e * 1025 + lane + 64 * i]; s0 += x0[i] * w; s1 += x1[i] * w; }
        p0[e] = s0; p1[e] = s1; }
    const float t0 = reduce32(p0, lane), t1 = reduce32(p1, lane);
    const GAS float* rb = (const GAS float*)INP(a, I_RB) + l * 32;
    route_row(ws, l, row0, t0, rb, lane, dry, lcnt); route_row(ws, l, row0 + 1, t1, rb, lane, dry, lcnt);
}

__device__ __forceinline__ int moe_table(const Fr& F, unsigned char* ws, int l, LAS int* pst, LAS int* cntl, LAS int* ptab) {
    if (F.tid == 0) { const GAS unsigned* cnt = (const GAS unsigned*)(ws + WS_CTL) + CW_CNT + l * 32 * 64; int acc = 0;
#pragma unroll 1
        for (int e = 0; e < 32; ++e) { const int c = (int)__hip_atomic_load(cnt + e * 64, __ATOMIC_RELAXED, __HIP_MEMORY_SCOPE_AGENT); cntl[e] = c; pst[e] = acc; const int np = (c + 255) >> 8;
#pragma unroll 1
            for (int j = 0; j < np; ++j) ptab[(acc >> 8) + j] = e;
            acc += np << 8; }
        pst[32] = acc; }
    __syncthreads();
    return __builtin_amdgcn_readfirstlane(pst[32] >> 8);
}

__device__ __forceinline__ void combine_row(const Fr& F, const Args& a, unsigned char* ws, int l, int row, GAS float* xso) {
    const int lane = F.lane; const GAS bf16* ys = (const GAS bf16*)(ws + WS_YSLOT) + (size_t)row * 4 * 1024; GAS float* xs = (GAS float*)(ws + WS_XS) + (size_t)row * 1024;
    const int mi = row < NLAT ? (row >> 13) : 2; const GAS float* mod = (const GAS float*)(ws + WS_MOD) + ((size_t)l * 3 + mi) * 6144; const GAS float* g2 = mod + 5120;
    const GAS float* lg = (const GAS float*)INP(a, I_LN2G) + l * 1024; const GAS float* lb = (const GAS float*)INP(a, I_LN2B) + l * 1024;
    f32x4 v[4]; float s = 0.f;
#pragma unroll
    for (int j = 0; j < 4; ++j) { const int k = 4 * lane + 256 * j; f32x4 f; f.x = 0.f; f.y = 0.f; f.z = 0.f; f.w = 0.f;
#pragma unroll
        for (int kk = 0; kk < 4; ++kk) { const v2u w = *(const GAS v2u*)(ys + (size_t)kk * 1024 + k); f.x += bflo(w.x); f.y += bfhi(w.x); f.z += bflo(w.y); f.w += bfhi(w.y); }
        v[j] = *(const GAS f32x4*)(xs + k) * DN_ALPHA + *(const GAS f32x4*)(g2 + k) * f; s += (v[j].x + v[j].y) + (v[j].z + v[j].w); }
    const float mean = wave_sum(s) * (1.f / 1024.f); float q = 0.f;
#pragma unroll
    for (int j = 0; j < 4; ++j) { v[j] = v[j] - mean; q += (v[j].x * v[j].x + v[j].y * v[j].y) + (v[j].z * v[j].z + v[j].w * v[j].w); }
    const float rstd = 1.f / sqrtf(wave_sum(q) * (1.f / 1024.f) + LN_EPS);
#pragma unroll
    for (int j = 0; j < 4; ++j) { const int k = 4 * lane + 256 * j; v[j] = v[j] * rstd * *(const GAS f32x4*)(lg + k) + *(const GAS f32x4*)(lb + k); if (l == 0) *(GAS f32x4*)(xso + (size_t)row * 1024 + k) = v[j]; }
    if (l == 1) {
#pragma unroll
        for (int j = 0; j < 4; ++j) *(GAS f32x4*)((GAS float*)a.out + (size_t)row * 1024 + 4 * lane + 256 * j) = v[j];
    }
}

constexpr int NPH_PRO = 3, NPH_LAYER = 12, NPH = NPH_PRO + 2 * NPH_LAYER;
constexpr float QSCALE = 0.10206207261596575f * 1.4426950408889634f;

__global__ void __launch_bounds__(512, 2) fwd(Args args) {
    extern __shared__ __attribute__((aligned(16))) unsigned char lds[];
    Fr F; F.L = (LAS unsigned char*)lds; F.tid = threadIdx.x; F.lane = F.tid & 63; F.wave = __builtin_amdgcn_readfirstlane(F.tid >> 6); F.G = gridDim.x; F.bid = blockIdx.x;
    volatile LAS unsigned* MISC = (volatile LAS unsigned*)(F.L + LDS_MISC);
    unsigned char* wsraw = args.ws; unsigned char* ws = (unsigned char*)(GAS unsigned char*)wsraw;
#define ctl ((unsigned*)(ws + WS_CTL))
    for (int u = F.tid; u < (LDS_BYTES - LDS_MISC) / 4; u += 512) ((LAS unsigned*)(F.L + LDS_MISC))[u] = 0u;
    __syncthreads();
#if !MK_PER_PHASE
    XcdBarrier bar = xcd_barrier_post(ctl + CW_BAR, MISC + 8);
#define SEAM() xcd_barrier(bar)
#else
#define SEAM() do {} while (0)
#endif
#define HYF(l_, Ln_, blk_, FILT_, HP_) hy_filter_item(F.L, F.tid, INP(args, I_HW1) + (size_t)(l_) * 33 * 64, INP(args, I_HB1) + (l_) * 64, INP(args, I_HW2) + (size_t)(l_) * 64 * 64, INP(args, I_HB2) + (l_) * 64, INP(args, I_HFREQ) + (l_) * 64, INP(args, I_HW3) + (size_t)(l_) * 64 * 2048, Ln_, blk_, FILT_, HP_)
#define PHASE_BEGIN() do { asm volatile("" : "+v"(F.tid)); F.lane = F.tid & 63; asm volatile("" : "+s"(wsraw)); ws = (unsigned char*)(GAS unsigned char*)wsraw; gw = F.bid * 8 + F.wave; gt = F.bid * 512 + F.tid; } while (0)
    const int lo = args.ph_lo, hi = args.ph_hi;
#ifndef MK_ATTVAR
#define MK_ATTVAR 0
#endif
#ifndef MK_DUP
#define MK_DUP 0
#endif
#ifndef MK_DUPN
#define MK_DUPN 1
#endif
#define TIMES(k) (1 + ((MK_DUP >> (k)) & 1) * MK_DUPN)
#ifndef MK_SUB
#define MK_SUB 0xffff
#endif
#define SUB(k) ((MK_SUB >> (k)) & 1)
#ifndef MK_MASK
#define MK_MASK 0x7fff
#endif
#define IN(k) (((MK_MASK >> (k)) & 1) && lo <= (k) && (k) < hi)
#define INL(j) (((MK_MASK >> (3 + (j))) & 1) && lo <= (pb + (j)) && (pb + (j)) < hi)
    int gw = F.bid * 8 + F.wave, gt = F.bid * 512 + F.tid; const int NGW = F.G * 8, NGT = F.G * 512;

    if (IN(0)) for (int r_ = 0; r_ < 1 + (args.dupk == 0); ++r_) {
        PHASE_BEGIN();
        for (int rep_ = 0; rep_ < TIMES(0); ++rep_) {
        __syncthreads();
        for (int step_ = 0; step_ < 2; ++step_) { const bool do_filt = (step_ == 0) == ((F.bid & 1) != 0); __syncthreads();
        if (!do_filt) {
        { LAS float* scr = (LAS float*)(F.L + F.wave * 8448);
          constexpr int I_IN = 16 * 214, I_UQ = 6 * 24, I_UKV = 4 * 32, I_BR = 8 * 32, I_OUT = 16 * 32, I_M1 = 32 * 16 * 64, I_M2 = 32 * 16 * 32, PER_LAYER = I_IN + I_UQ + I_UKV + 3 * I_BR + I_OUT + I_M1 + I_M2;
          for (int it = gw; it < 2 * PER_LAYER; it += NGW) {
              const int l = it / PER_LAYER; int r = it - l * PER_LAYER; unsigned char* wbl = ws + WS_W + (size_t)l * WB_LAYER;
              if (r < I_IN) { tr_item(INP(args, I_WIN) + (size_t)l * 1024 * INTOT, 1024, INTOT, (bf16*)(wbl + WB_IN), 0, nullptr, 1.f, scr, r, F.lane); continue; } r -= I_IN;
              if (r < I_UQ) { tr_item(INP(args, I_WUQ) + (size_t)l * 384 * 768, 384, 768, (bf16*)(wbl + WB_UQ), 0, INP(args, I_QNORM) + l * 384, QSCALE, scr, r, F.lane); continue; } r -= I_UQ;
              if (r < I_UKV) { tr_item(INP(args, I_WUKV) + (size_t)l * 256 * 1024, 256, 1024, (bf16*)(wbl + WB_UKV), 0, INP(args, I_KVNORM) + l * 256, 1.f, scr, r, F.lane); continue; } r -= I_UKV;
              if (r < 3 * I_BR) { const int br = r / I_BR; tr_item(INP(args, I_WBG + br) + (size_t)l * 512 * 1024, 512, 1024, (bf16*)(wbl + WB_BR) + (size_t)br * 1024 * 512, 0, nullptr, 1.f, scr, r - br * I_BR, F.lane); continue; } r -= 3 * I_BR;
              if (r < I_OUT) { tr_item(INP(args, I_WOUT) + (size_t)l * 1024 * 1024, 1024, 1024, (bf16*)(wbl + WB_OUT), 0, nullptr, 1.f, scr, r, F.lane); continue; } r -= I_OUT;
              if (r < I_M1) { const int e = r >> 10; tr_item(INP(args, I_MW1) + ((size_t)l * 32 + e) * 1024 * 2048, 1024, 2048, (bf16*)(wbl + WB_M1) + (size_t)e * 2048 * 1024, 1, nullptr, 1.f, scr, r & 1023, F.lane); continue; } r -= I_M1;
              { const int e = r >> 9; tr_item(INP(args, I_MW2) + ((size_t)l * 32 + e) * 1024 * 1024, 1024, 1024, (bf16*)(wbl + WB_M2) + (size_t)e * 1024 * 1024, 0, nullptr, 1.f, scr, r & 511, F.lane); }
          }
          for (int i = gt; i < 2 * 64 * 1024 / 8; i += NGT) { const int l = i >> 13, j = i & 8191; *(v4u*)((bf16*)(ws + WS_W + (size_t)l * WB_LAYER + WB_IN) + (size_t)INTOT * 1024 + (size_t)j * 8) = (v4u){0u, 0u, 0u, 0u}; }
        }
        if (F.bid < 192) { LAS float* act = (LAS float*)(F.L + 98304);
            __syncthreads();
            for (int i = F.tid; i < 3072; i += 512) { const float x = i < 2048 ? INP(args, I_C)[i] : INP(args, I_CCTX)[i - 2048]; act[i] = silu_(x); }
            __syncthreads();
            for (int it = F.bid; it < 192; it += F.G) { const int l = it / 96, r = it - l * 96, kb = r / 12, nb = r - kb * 12, n = nb * 512 + F.tid;
                const float* W = INP(args, I_ADAW) + (size_t)l * 1024 * 6144; float a0 = 0.f, a1 = 0.f, a2 = 0.f;
#pragma unroll 8
                for (int k = kb * 128; k < kb * 128 + 128; ++k) { const float w = W[(size_t)k * 6144 + n]; a0 += act[k] * w; a1 += act[1024 + k] * w; a2 += act[2048 + k] * w; }
                float* mp = (float*)(ws + WS_MODP) + (((size_t)kb * 2 + l) * 3) * 6144 + n; mp[0] = a0; mp[6144] = a1; mp[2 * 6144] = a2; } }
        for (int i = gt; i < 8192 * 16; i += NGT) { const int t = i >> 4, j = i & 15; const float pos = (float)((j < 8) ? (t >> 6) : (t & 63)); const float inv = powf(10000.f, -(float)(j & 7) / 8.f); const float ang = pos * inv;
            float* rp = (float*)(ws + WS_ROPE) + (size_t)i * 2; rp[0] = cosf(ang); rp[1] = sinf(ang); }
        for (int i = gt; i < FFTN; i += NGT) { float sn, cs; sincospif((float)i / 8192.f, &sn, &cs); f32x2 w; w.x = cs; w.y = -sn; ((f32x2*)(ws + WS_TW))[i] = w; }
        } else {
        __syncthreads();
        for (int it = F.bid; it < 264; it += F.G) { if (it < 256) HYF(0, 8192, it, (float*)(ws + WS_FILT), (float*)(ws + WS_HPART)); else HYF(0, 256, it - 256, (float*)(ws + WS_FILTC), (float*)(ws + WS_HPARTC)); }
        } }
        }
        SEAM();
    }
#ifdef MK_XBAR
    for (int k_ = 0; k_ < MK_XBAR; ++k_) SEAM();
#endif
    if (IN(1)) {
        PHASE_BEGIN();
        for (int i = gt; i < 2 * 3 * 6144; i += NGT) { const int l = i / 18432, n = i % 6144; float s = INP(args, I_ADAB)[l * 6144 + n];
#pragma unroll
            for (int kb = 0; kb < 8; ++kb) s += ((const float*)(ws + WS_MODP))[(size_t)kb * 2 * 18432 + i];
            ((float*)(ws + WS_MOD))[i] = s; }
        SEAM();
    }
    if (IN(2)) for (int r_ = 0; r_ < 1 + (args.dupk == 2); ++r_) {
        PHASE_BEGIN();
        for (int row = gw; row < MALL; row += NGW) { const int mi = row < NLAT ? (row >> 13) : 2; const float* mod = (const float*)(ws + WS_MOD) + (size_t)mi * 6144;
            ln_mod_row(row < NLAT ? INP(args, I_X) + (size_t)row * 1024 : INP(args, I_CTX) + (size_t)(row - NLAT) * 1024, mod, mod + 1024, (bf16*)(ws + WS_HBF) + (size_t)row * 1024, F.lane); }
        SEAM();
    }

    for (int l = 0; l < 2; ++l) {
        const int pb = NPH_PRO + l * NPH_LAYER;
#define wb (ws + WS_W + (size_t)l * WB_LAYER)
        const int nrows = l == 1 ? NLAT : MALL, nPM = nrows / 256;
        if (INL(0)) for (int r_ = 0; r_ < 1 + (args.dupk == 3); ++r_) {
            PHASE_BEGIN();
            if (SUB(0)) { pg8::Gemm g{(const bf16*)(ws + WS_HBF), (const bf16*)(wb + WB_IN), MALL, INPAD, 1024}; pg8::StaticOrder S; S.init(MALL, INPAD, F.G, F.bid);
              pg8::EpiP E{(GAS bf16*)(ws + WS_P), INPAD};
              pg8::gemm_phase<pg8::EpiP, pg8::StaticOrder, true, true>(F.L, g, S, E, F.tid); }
            if (TIMES(2) > 1) { PHASE_BEGIN(); pg8::Gemm g{(const bf16*)(ws + WS_HBF), (const bf16*)(wb + WB_IN), MALL, INPAD, 1024}; pg8::StaticOrder S; S.init(MALL, INPAD, F.G, F.bid);
#ifdef MK_NULLEPI
              pg8::EpiNull E{}; pg8::gemm_phase<pg8::EpiNull, pg8::StaticOrder, true, true>(F.L, g, S, E, F.tid);
#else
              pg8::EpiP E{(GAS bf16*)(ws + WS_P), INPAD}; pg8::gemm_phase<pg8::EpiP, pg8::StaticOrder, true, true>(F.L, g, S, E, F.tid);
#endif
            }
            PHASE_BEGIN();
            for (int rep_ = 0; rep_ < TIMES(3); ++rep_) if (SUB(1)) for (int c = F.bid; c < 512; c += F.G) kspec_item(F, ws, c);
            SEAM();
        }
        if (INL(1)) for (int r_ = 0; r_ < 1 + (args.dupk == 4); ++r_) {
            PHASE_BEGIN();
            for (int rep_ = 0; rep_ < TIMES(4); ++rep_) {
            __syncthreads();
            const int nconv = 2 * 64 * 24 + (l == 0 ? 2 * 2 * 24 : 0);
            for (int it = F.bid; it < nconv; it += F.G) {
                if (it < 2 * 64 * 24) { const int cb = it % 24, tb = (it / 24) & 63, b = it / (24 * 64);
                    conv3_item(F, args, (const GAS bf16*)(ws + WS_P) + (size_t)b * SEQ * INPAD, SEQ, (GAS bf16*)(ws + WS_HYT) + (size_t)b * SEQ, l, tb * 128, cb * 64); }
                else { const int i2 = it - 2 * 64 * 24; const int cb = i2 % 24, tb = (i2 / 24) & 1, b = i2 / (24 * 2);
                    conv3_item(F, args, (const GAS bf16*)(ws + WS_P) + (size_t)(NLAT + b * CTXL) * INPAD, CTXL, (GAS bf16*)(ws + WS_HYTC) + (size_t)b * CTXL, l, tb * 128, cb * 64); }
            }
            LAS float* wa = (LAS float*)(F.L + 65536);
            for (int i = F.tid; i < 8192; i += 512) wa[i] = i < 4096 ? INP(args, I_WA2F)[(size_t)l * 4096 + i] : INP(args, I_WA2B)[(size_t)l * 4096 + i - 4096];
            __syncthreads();
            for (int row = gw; row < MALL; row += NGW) post_row(F, args, ws, l, row, wa);
            }
            SEAM();
        }
        if (INL(2)) for (int r_ = 0; r_ < 1 + (args.dupk == 5); ++r_) {
            PHASE_BEGIN();
            for (int rep_ = 0; rep_ < TIMES(5); ++rep_) if (SUB(2)) { pg8::Gemm g{(const bf16*)(ws + WS_NQ), (const bf16*)(wb + WB_UQ), nrows, 768, 384}; pg8::StaticOrder S; S.init(nrows, 768, F.G, F.bid);
              pg8::EpiP E{(GAS bf16*)(ws + WS_QB), 768};
              pg8::gemm_phase<pg8::EpiP, pg8::StaticOrder, true, true>(F.L, g, S, E, F.tid); }
            PHASE_BEGIN();
            for (int rep_ = 0; rep_ < TIMES(5); ++rep_) if (SUB(3)) { pg8::Gemm g{(const bf16*)(ws + WS_NKV), (const bf16*)(wb + WB_UKV), MALL, 1024, 256}; pg8::StaticOrder S; S.init(MALL, 1024, F.G, (F.bid + F.G - 230 % F.G) % F.G);
              pg8::EpiKV E{(GAS bf16*)(ws + WS_KB), (GAS bf16*)(ws + WS_VT), NLAT, KEYS, CTXL};
              pg8::gemm_phase<pg8::EpiKV, pg8::StaticOrder, true, true>(F.L, g, S, E, F.tid); }
            PHASE_BEGIN();
            for (int rep_ = 0; rep_ < TIMES(7); ++rep_) for (int it = (F.bid + F.G - 198 % F.G) % F.G; it < 1056; it += F.G) gla_a_item(F, ws, it);
            PHASE_BEGIN();
            for (int rep_ = 0; rep_ < TIMES(6); ++rep_) if (SUB(4)) for (int c = F.bid; c < 512; c += F.G) hyconv_item(F, args, ws, l, c);
            PHASE_BEGIN();
            for (int rep_ = 0; rep_ < TIMES(15); ++rep_) if (SUB(5) && l == 0) for (int c = F.bid; c < 512; c += F.G) hyctx_item(F, args, ws, l, c);
            SEAM();
        }
        if (INL(3)) {
            PHASE_BEGIN();
            const int nunits = 512 + (l == 0 ? 16 : 0);
            for (int it = F.bid; it < 256; it += F.G) gla_scan_q(F, ws, it);
            for (int rep_ = 0; rep_ < TIMES(8); ++rep_) { unsigned* qh = ctl + CW_QCTR + (l * 4 + rep_) * 64;
            for (;;) {
                if (F.tid == 0) MISC[0] = __hip_atomic_fetch_add(qh, 1u, __ATOMIC_RELAXED, __HIP_MEMORY_SCOPE_AGENT);
                __syncthreads();
                int u = __builtin_amdgcn_readfirstlane((int)MISC[0]);
                __syncthreads();
                if (u >= nunits) break;
                int bh, qrow0, nt;
                if (u < 512) { bh = u >> 5; qrow0 = (bh >> 3) * SEQ + (u & 31) * 256; nt = KEYS / 64; } else { bh = u - 512; qrow0 = NLAT + (bh >> 3) * CTXL; nt = CTXL / 64; }
                attn_unit(rep_ == 0 ? 0 : MK_ATTVAR, F, (const GAS bf16*)(ws + WS_QB), (const GAS bf16*)(ws + WS_KB) + (size_t)bh * KEYS * 96, (const GAS bf16*)(ws + WS_VT) + (size_t)bh * 64 * KEYS, rep_ == 0 ? (GAS bf16*)(ws + WS_OBR) + (size_t)MALL * 512 : (GAS bf16*)(ws + WS_XPRE), qrow0, bh & 7, nt, (const GAS float*)(ws + WS_ROPE));
            }
            }
            SEAM();
        }
        if (INL(4)) for (int r_ = 0; r_ < 1 + (args.dupk == 7); ++r_) {
            PHASE_BEGIN();
            for (int rep_ = 0; rep_ < TIMES(9); ++rep_) {
            for (int it = F.bid; it < 1056; it += F.G) { if (l == 1 && (it % 132) < 4) continue; gla_c_item(F, args, ws, l, it); }
            for (int it = F.bid; it < 2048; it += F.G) hy_tr_item(F, ws, it);
            }
            SEAM();
        }
        if (INL(5)) for (int r_ = 0; r_ < 1 + (args.dupk == 8); ++r_) {
            PHASE_BEGIN();
            pg8::Gemm g{(const bf16*)(ws + WS_OBR), (const bf16*)(wb + WB_BR), MALL, 1024, 512}; pg8::MergeOrder S{nPM, MALL / 256, F.G, F.bid};
            pg8::EpiU E{(GAS bf16*)(ws + WS_U), MALL / 256};
            pg8::gemm_phase<pg8::EpiU, pg8::MergeOrder, true, true>(F.L, g, S, E, F.tid);
            if (TIMES(10) > 1) { PHASE_BEGIN(); pg8::gemm_phase<pg8::EpiU, pg8::MergeOrder, true, true>(F.L, g, S, E, F.tid); }
            SEAM();
            PHASE_BEGIN();
            for (int rep_ = 0; rep_ < TIMES(17); ++rep_) for (int row = gw; row < nrows; row += NGW) gate_row(F, ws, row);
            SEAM();
        }
        if (INL(6)) for (int r_ = 0; r_ < 1 + (args.dupk == 9); ++r_) {
            PHASE_BEGIN();
            pg8::Gemm g{(const bf16*)(ws + WS_YMB), (const bf16*)(wb + WB_OUT), nrows, 1024, 1024}; pg8::StaticOrder S; S.init(nrows, 1024, F.G, F.bid);
            pg8::EpiOut E{l == 0 ? (const GAS float*)INP(args, I_X) : (const GAS float*)(ws + WS_XS), l == 0 ? (const GAS float*)INP(args, I_CTX) - (size_t)NLAT * 1024 : (const GAS float*)(ws + WS_XS), (GAS float*)(ws + WS_XPRE), (const GAS float*)(ws + WS_MOD) + (size_t)l * 18432, NLAT, DN_ALPHA};
            pg8::gemm_phase<pg8::EpiOut, pg8::StaticOrder, true, true>(F.L, g, S, E, F.tid);
            if (TIMES(11) > 1) { PHASE_BEGIN(); pg8::gemm_phase<pg8::EpiOut, pg8::StaticOrder, true, true>(F.L, g, S, E, F.tid); }
            SEAM();
        }
        if (INL(7)) {
            PHASE_BEGIN();
            LAS float* wT = (LAS float*)F.L; const float* rw = INP(args, I_RW) + (size_t)l * 1024 * 32;
            LAS unsigned* lcnt = (LAS unsigned*)(F.L + LDS_TAB + 512); LAS unsigned* lbase = lcnt + 32;
#pragma unroll 8
            for (int i = F.tid; i < 32768; i += 512) wT[(i & 31) * 1025 + (i >> 5)] = rw[i];
            if (F.tid < 32) lcnt[F.tid] = 0u;
            __syncthreads();
            for (int rep_ = TIMES(1) - 1; rep_ >= 0; --rep_) for (int rp = gw; rp < nrows / 2; rp += NGW) ln1_router_row2(F, args, ws, l, 2 * rp, wT, rep_ > 0, lcnt);
            __syncthreads();
            if (F.tid < 32) lbase[F.tid] = __hip_atomic_fetch_add(ctl + CW_CNT + (l * 32 + F.tid) * 64, lcnt[F.tid], __ATOMIC_RELAXED, __HIP_MEMORY_SCOPE_AGENT);
            __syncthreads();
            if (F.lane < 8) { int* tope = (int*)(ws + WS_TOPE); int* spos = (int*)(ws + WS_SPOS);
                for (int rp = gw; rp < nrows / 2; rp += NGW) { const int s_ = rp * 8 + F.lane; spos[s_] += (int)lbase[tope[s_]]; } }
            SEAM();
        }
        LAS int* pst = (LAS int*)(F.L + LDS_TAB); LAS int* cntl = pst + 64; LAS int* ptab = pst + 128;
        if (INL(8)) for (int r_ = 0; r_ < 1 + (args.dupk == 11); ++r_) {
            PHASE_BEGIN();
            moe_table(F, ws, l, pst, cntl, ptab);
            for (int rep_ = 0; rep_ < TIMES(12); ++rep_) {
            const int nslot = nrows * 4; const int* tope = (const int*)(ws + WS_TOPE); const int* spos = (const int*)(ws + WS_SPOS); int* rslot = (int*)(ws + WS_RSLOT);
            for (int s = gt; s < nslot; s += NGT) rslot[pst[tope[s]] + spos[s]] = s;
            for (int i = gt; i < 32 * 256; i += NGT) { const int e = i >> 8, r = pst[e] + cntl[e] + (i & 255); if (r < pst[e + 1]) rslot[r] = -1; }
            }
            SEAM();
        }
        if (INL(9)) for (int r_ = 0; r_ < 1 + (args.dupk == 12); ++r_) {
            PHASE_BEGIN();
            const int npanel = moe_table(F, ws, l, pst, cntl, ptab);
            pg8::Gemm g{(const bf16*)(ws + WS_HBF), (const bf16*)(wb + WB_M1), XG_ROWS, 2048, 1024}; pg8::MoeOrder<8> S{(const LAS int*)ptab, npanel, F.G, F.bid};
            pg8::EpiMoe1 E{(GAS bf16*)(ws + WS_ACT), (const GAS float*)INP(args, I_MB1) + (size_t)l * 32 * 2048};
            pg8::gemm_phase_g<pg8::EpiMoe1, pg8::MoeOrder<8>, true, true>(F.L, g, S, E, F.tid, (const GAS int*)(ws + WS_RSLOT));
            if (TIMES(13) > 1) { PHASE_BEGIN(); pg8::gemm_phase_g<pg8::EpiMoe1, pg8::MoeOrder<8>, true, true>(F.L, g, S, E, F.tid, (const GAS int*)(ws + WS_RSLOT)); }
            SEAM();
        }
        if (INL(10)) for (int r_ = 0; r_ < 1 + (args.dupk == 13); ++r_) {
            PHASE_BEGIN();
            const int npanel = moe_table(F, ws, l, pst, cntl, ptab);
            pg8::Gemm g{(const bf16*)(ws + WS_ACT), (const bf16*)(wb + WB_M2), XG_ROWS, 1024, 1024}; pg8::MoeOrder<4> S{(const LAS int*)ptab, npanel, F.G, F.bid};
            pg8::EpiMoe2 E{(GAS bf16*)(ws + WS_YSLOT), (const GAS float*)INP(args, I_MB2) + (size_t)l * 32 * 1024, (const GAS int*)(ws + WS_RSLOT), (const GAS float*)(ws + WS_TOPG)};
            pg8::gemm_phase<pg8::EpiMoe2, pg8::MoeOrder<4>, true, true>(F.L, g, S, E, F.tid);
            if (TIMES(14) > 1) { PHASE_BEGIN(); pg8::gemm_phase<pg8::EpiMoe2, pg8::MoeOrder<4>, true, true>(F.L, g, S, E, F.tid); }
            if (l == 0) { PHASE_BEGIN(); __syncthreads();
                for (int it = (F.G - 1 - F.bid); it < 256; it += F.G) HYF(1, 8192, it, (float*)(ws + WS_FILT), (float*)(ws + WS_HPART)); }
            SEAM();
        }
        if (INL(11)) {
            PHASE_BEGIN();
            for (int rep_ = TIMES(16) - 1; rep_ >= 0; --rep_) for (int row = gw; row < nrows; row += NGW) { combine_row(F, args, ws, l, row, rep_ > 0 ? (GAS float*)(ws + WS_XPRE) : (GAS float*)(ws + WS_XS));
                if (l == 0) { const int mi = row < NLAT ? (row >> 13) : 2; const float* mod = (const float*)(ws + WS_MOD) + (size_t)(3 + mi) * 6144;
                    ln_mod_row((const float*)(ws + WS_XS) + (size_t)row * 1024, mod, mod + 1024, (bf16*)(ws + WS_HBF) + (size_t)row * 1024, F.lane); } }
            if (l == 0) SEAM();
        }
    }
#undef wb
#undef ctl
#undef IN
#undef INL
}

extern "C" void kernel_launch(void* const* d_in, const int* in_sizes, int n_in, void* d_out, int out_size, void* d_ws, size_t ws_size, hipStream_t stream) {
    static int grid = 0;
    if (grid == 0) {
        if (n_in != 39 || out_size != NLAT * D || ws_size < WS_END) { fprintf(stderr, "kernel_launch: expected 39 inputs, %d outputs, >= %zu B workspace; got %d, %d, %zu\n", NLAT * D, (size_t)WS_END, n_in, out_size, ws_size); grid = -1; return; }
        int dev = 0, cus = 0, per_cu = 0;
        if (hipGetDevice(&dev) != hipSuccess || hipDeviceGetAttribute(&cus, hipDeviceAttributeMultiprocessorCount, dev) != hipSuccess) { grid = -1; return; }
        if (hipFuncSetAttribute((const void*)fwd, hipFuncAttributeMaxDynamicSharedMemorySize, LDS_BYTES) != hipSuccess) { fprintf(stderr, "kernel_launch: hipFuncSetAttribute failed\n"); grid = -1; return; }
        if (hipOccupancyMaxActiveBlocksPerMultiprocessor(&per_cu, (const void*)fwd, 512, LDS_BYTES) != hipSuccess || per_cu < 1) fprintf(stderr, "kernel_launch: occupancy query says %d\n", per_cu);
        (void)hipGetLastError();
        grid = cus;
    }
    if (grid < 0) return;
    (void)hipMemsetAsync((char*)d_ws + WS_CTL, 0, (size_t)CW_DBG * 4, stream);
    Args a{};
    for (int i = 0; i < 39; ++i) a.in[i] = (const float*)d_in[i];
    a.out = (float*)d_out; a.ws = (unsigned char*)d_ws;
#ifdef MK_DUPPH
    a.dupk = MK_DUPPH;
#else
    a.dupk = -1;
#endif
#if MK_PER_PHASE
    for (int ph = 0; ph < NPH; ++ph) { a.ph_lo = ph; a.ph_hi = ph + 1; hipLaunchKernelGGL(fwd, dim3(grid), dim3(512), LDS_BYTES, stream, a); }
#else
    a.ph_lo = 0; a.ph_hi = NPH;
    hipLaunchKernelGGL(fwd, dim3(grid), dim3(512), LDS_BYTES, stream, a);
#endif
}
```

```cpp
#include <hip/hip_runtime.h>
#include <cstdio>
#include <cstdint>

#ifndef MK_PER_PHASE
#define MK_PER_PHASE 0
#endif

constexpr int D = 1024, NB = 2, SEQ = 8192, CTXL = 256, NLAT = NB * SEQ, NCTX = NB * CTXL, MALL = NLAT + NCTX;
constexpr int KEYS = CTXL + SEQ;
constexpr int INTOT = 6848, INPAD = 6912;
constexpr int O_GK = 0, O_GV = 256, O_GAF = 768, O_GAB = 784, O_MKVA = 800, O_MKR = 1056, O_GQ = 1088, O_GR = 1344, O_MQA = 1856, O_HY = 2240, O_GATE = 3776;
constexpr int NEXP = 32, TOPK = 4, NSLOT = MALL * TOPK;
constexpr int XG_ROWS = 75776;
constexpr int NPANEL_MAX = XG_ROWS / 256;
constexpr float LN_EPS = 1e-5f, RMS_EPS = 1e-6f, DN_ALPHA = 1.41421356237f;
constexpr int FFTN = 16384;

constexpr size_t al256(size_t x) { return (x + 255) & ~(size_t)255; }
constexpr size_t WS_CTL = 0, CTL_ZERO_BYTES = 1u << 20;
constexpr size_t WS_MODP = CTL_ZERO_BYTES;
constexpr size_t WS_MOD = WS_MODP + al256((size_t)8 * 2 * 3 * 6144 * 4);
constexpr size_t WS_ROPE = WS_MOD + al256((size_t)2 * 3 * 6144 * 4);
constexpr size_t WS_TW = WS_ROPE + al256((size_t)8192 * 16 * 2 * 4);
constexpr size_t WS_HPART = WS_TW + al256((size_t)FFTN * 8);
constexpr size_t WS_HPARTC = WS_HPART + al256((size_t)256 * 1024 * 4);
constexpr size_t WS_TOPE = WS_HPARTC + al256((size_t)8 * 1024 * 4);
constexpr size_t WS_TOPG = WS_TOPE + al256((size_t)NSLOT * 4);
constexpr size_t WS_SPOS = WS_TOPG + al256((size_t)NSLOT * 4);
constexpr size_t WS_RSLOT = WS_SPOS + al256((size_t)NSLOT * 4);
constexpr size_t WS_GDEC = WS_RSLOT + al256((size_t)XG_ROWS * 4);
constexpr size_t WB_IN = 0, WB_UQ = WB_IN + (size_t)INPAD * 1024 * 2, WB_UKV = WB_UQ + (size_t)768 * 384 * 2, WB_BR = WB_UKV + (size_t)1024 * 256 * 2,
                 WB_OUT = WB_BR + (size_t)3 * 1024 * 512 * 2, WB_M1 = WB_OUT + (size_t)1024 * 1024 * 2, WB_M2 = WB_M1 + (size_t)32 * 2048 * 1024 * 2,
                 WB_LAYER = WB_M2 + (size_t)32 * 1024 * 1024 * 2;
constexpr size_t WS_W = WS_GDEC + al256((size_t)16 * 132 * 64 * 4);
constexpr size_t WS_XS = WS_W + 2 * WB_LAYER;
constexpr size_t WS_XPRE = WS_XS + (size_t)MALL * D * 4;
constexpr size_t WS_HBF = WS_XPRE + (size_t)MALL * D * 4;
constexpr size_t WS_P = WS_HBF + (size_t)MALL * D * 2;
constexpr size_t WS_XG = WS_P;
constexpr size_t WS_NQ = WS_P + (size_t)MALL * INPAD * 2;
constexpr size_t WS_NKV = WS_NQ + (size_t)MALL * 384 * 2;
constexpr size_t WS_QB = WS_NKV + (size_t)MALL * 256 * 2;
constexpr size_t WS_KB = WS_QB + (size_t)MALL * 768 * 2;
constexpr size_t WS_VT = WS_KB + (size_t)16 * KEYS * 96 * 2;
constexpr size_t WS_AF = WS_VT + (size_t)16 * 64 * KEYS * 2;
constexpr size_t WS_AB = WS_AF + (size_t)MALL * 256 * 4;
constexpr size_t WS_YM = WS_AB + (size_t)MALL * 256 * 4;
constexpr size_t WS_YMB = WS_YM + (size_t)MALL * D * 4;
constexpr size_t WS_U = WS_YMB + (size_t)MALL * D * 2;
constexpr size_t WS_R1 = WS_U + (size_t)MALL * 3072 * 2;
constexpr size_t WS_OF = WS_R1;
constexpr size_t WS_GST = WS_R1;
constexpr size_t WS_OB = WS_OF + (size_t)MALL * 512 * 4;
constexpr size_t WS_HYT = WS_OB + (size_t)MALL * 512 * 4;
constexpr size_t WS_HYTC = WS_HYT + (size_t)1536 * NLAT * 2;
constexpr size_t WS_OHYT = WS_HYTC + (size_t)1536 * NCTX * 2;
constexpr size_t WS_OBR = WS_OHYT + (size_t)512 * NLAT * 2;
constexpr size_t WS_R1_END = WS_OBR + (size_t)3 * MALL * 512 * 2;
constexpr size_t WS_YSLOT = WS_R1;
static_assert(WS_YSLOT + (size_t)NSLOT * D * 2 <= WS_R1_END, "YSLOT overlay");
static_assert(WS_GST + (size_t)16 * 132 * 8192 * 4 <= WS_HYT, "GST overlay");
constexpr size_t WS_FILT = WS_R1_END;
constexpr size_t WS_FILTC = WS_FILT + (size_t)4 * 512 * 8192 * 4;
constexpr size_t WS_R2 = WS_FILTC + (size_t)4 * 512 * 256 * 4;
constexpr size_t WS_K0S = WS_R2;
constexpr size_t WS_K1S = WS_K0S + (size_t)512 * FFTN * 8;
constexpr size_t WS_R2_END = WS_R2 + (size_t)XG_ROWS * D * 2;
constexpr size_t WS_ACT = WS_R2;
static_assert(WS_ACT + (size_t)XG_ROWS * D * 2 <= WS_R2_END && WS_K1S + (size_t)512 * FFTN * 8 <= WS_R2_END, "ACT overlay");
static_assert((size_t)XG_ROWS * D * 2 <= (size_t)MALL * INPAD * 2, "XG overlay");
constexpr size_t WS_END = WS_R2_END;

constexpr int CW_BAR = 4096;
constexpr int CW_CNT = 8192;
constexpr int CW_QCTR = 8192 + 2 * 32 * 64;
constexpr int CW_DBG = 16384;
static_assert(CW_QCTR + 8 * 64 <= CW_DBG, "ctl map");

constexpr int LDS_STAGE = 147456;
constexpr int LDS_TAB = LDS_STAGE;
constexpr int LDS_MISC = LDS_STAGE + 4096;
constexpr int LDS_BYTES = 155648;

#define GAS __attribute__((address_space(1)))
#define LAS __attribute__((address_space(3)))
typedef unsigned short bf16;
typedef unsigned v4u __attribute__((ext_vector_type(4)));
typedef unsigned v2u __attribute__((ext_vector_type(2)));
typedef float f32x2 __attribute__((ext_vector_type(2)));
typedef float f32x4 __attribute__((ext_vector_type(4)));
typedef float f32x16 __attribute__((ext_vector_type(16)));
typedef short bf16x8 __attribute__((ext_vector_type(8)));
#define LDS_WAIT() asm volatile("s_waitcnt lgkmcnt(0)" ::: "memory")
#define VM_WAIT() asm volatile("s_waitcnt vmcnt(0)" ::: "memory")
__device__ __forceinline__ unsigned f2bf(float f) { unsigned u = __builtin_bit_cast(unsigned, f); return (u + 0x7fffu + ((u >> 16) & 1u)) >> 16; }
__device__ __forceinline__ unsigned pk2(float lo, float hi) { return f2bf(lo) | (f2bf(hi) << 16); }
__device__ __forceinline__ float bf2f(unsigned h) { return __builtin_bit_cast(float, h << 16); }
__device__ __forceinline__ float bflo(unsigned w) { return __builtin_bit_cast(float, w << 16); }
__device__ __forceinline__ float bfhi(unsigned w) { return __builtin_bit_cast(float, w & 0xffff0000u); }
__device__ __forceinline__ float wave_sum(float v) {
#pragma unroll
    for (int o = 1; o < 64; o <<= 1) v += __shfl_xor(v, o);
    return v;
}
__device__ __forceinline__ float wave_max(float v) {
#pragma unroll
    for (int o = 1; o < 64; o <<= 1) v = fmaxf(v, __shfl_xor(v, o));
    return v;
}
__device__ __forceinline__ float sigmoidf_(float x) { return 1.f / (1.f + __expf(-x)); }

namespace pg8 {
#define PG8_LAS __attribute__((address_space(3)))
typedef unsigned short bf16_t;
typedef short bf16x8 __attribute__((ext_vector_type(8)));
typedef float f32x4 __attribute__((ext_vector_type(4)));
typedef unsigned u32x4 __attribute__((ext_vector_type(4)));
constexpr int BM = 256, BK = 64, HALF = 128, HTB = HALF * BK * 2  , STAGE_BYTES = 8 * HTB, NXCD = 8, WGM = 8;

__host__ __device__ __forceinline__ int lds_byte(int r, int c) { const int st = (r >> 4) * 2 + (c >> 5), rr = r & 15, cc = c & 31, ob = rr * 64 + cc * 2; return st * 1024 + (ob ^ (((ob >> 9) & 1) << 5)); }
__host__ __device__ __forceinline__ void stage_rc(int b, int& R, int& C) { const int st = b / 1024, sb = b % 1024, swz = sb ^ (((sb >> 9) & 1) << 5); R = (st >> 1) * 16 + swz / 64; C = (st & 1) * 32 + (swz % 64) / 2; }
__host__ __device__ __forceinline__ int perm32(int rho) { const int n = rho >> 4, i = rho & 15; return 8 * (i >> 2) + 4 * n + (i & 3); }

struct Unit { int pm, pn; };
struct Gemm { const bf16_t* A; const bf16_t* Bt; int M, N, K; };

struct StaticOrder {
    int nM, nN, nwg, G, c;
    __host__ __device__ void init(int M, int N, int G_, int c_) { nM = M / BM; nN = N / BM; nwg = nM * nN; G = G_; c = c_; }
    __host__ __device__ bool next(int i, Unit& u) const {
        const long L = (long)i * G + c; if (L >= nwg) return false;
        int wgid = (int)L; { const int q = nwg / NXCD, r = nwg % NXCD, xcd = wgid % NXCD, off = wgid / NXCD; wgid = (xcd < r ? xcd * (q + 1) : r * (q + 1) + (xcd - r) * q) + off; }
        const int nig = WGM * nN, gid = wgid / nig, fm = gid * WGM, gsz = (nM - fm) < WGM ? (nM - fm) : WGM;
        u.pm = fm + ((wgid % nig) % gsz); u.pn = (wgid % nig) / gsz; return true;
    }
    __device__ __forceinline__ void a_ready(const Unit&) const {}
    __device__ __forceinline__ void done(const Unit&) const {}
};

__device__ __forceinline__ unsigned cvt_pk_bf16(float lo, float hi) { unsigned r; asm volatile("v_cvt_pk_bf16_f32 %0, %1, %2" : "=v"(r) : "v"(lo), "v"(hi)); return r; }
typedef float f32x2 __attribute__((ext_vector_type(2)));

typedef unsigned u32x2e __attribute__((ext_vector_type(2)));
__device__ __forceinline__ unsigned pkbf(float lo, float hi) { return cvt_pk_bf16(lo, hi); }

struct EpiP {
    static constexpr bool PERM = true, AFTER_DRAIN = false;
    __attribute__((address_space(1))) bf16_t* O; int ldc;
    __device__ __forceinline__ void operator()(const f32x4 (&acc)[2][2][4][2], const Unit& u, int wr, int wc, int fr, int fq) const {
        const int row0 = u.pm * BM + wr * 64 + fr, col0 = u.pn * BM + wc * 32 + 8 * fq;
#pragma unroll
        for (int ai = 0; ai < 2; ++ai)
#pragma unroll
            for (int m = 0; m < 4; ++m) { __attribute__((address_space(1))) bf16_t* rowp = O + (size_t)(row0 + ai * HALF + m * 16) * ldc + col0;
#pragma unroll
                for (int bj = 0; bj < 2; ++bj) { const f32x4 v0 = acc[ai][bj][m][0], v1 = acc[ai][bj][m][1];
                    u32x4 w; w.x = pkbf(v0[0], v0[1]); w.y = pkbf(v0[2], v0[3]); w.z = pkbf(v1[0], v1[1]); w.w = pkbf(v1[2], v1[3]);
                    *(__attribute__((address_space(1))) u32x4*)(rowp + bj * HALF) = w; } }
    }
};

struct EpiU {
    static constexpr bool PERM = true, AFTER_DRAIN = false;
    __attribute__((address_space(1))) bf16_t* O; int sPM;
    __device__ __forceinline__ void operator()(const f32x4 (&acc)[2][2][4][2], const Unit& u, int wr, int wc, int fr, int fq) const {
        const int pm = u.pm % sPM; const int row0 = pm * BM + wr * 64 + fr, col0 = u.pn * BM + wc * 32 + 8 * fq;
#pragma unroll
        for (int ai = 0; ai < 2; ++ai)
#pragma unroll
            for (int m = 0; m < 4; ++m) { __attribute__((address_space(1))) bf16_t* rowp = O + (size_t)(row0 + ai * HALF + m * 16) * 3072 + col0;
#pragma unroll
                for (int bj = 0; bj < 2; ++bj) { const f32x4 v0 = acc[ai][bj][m][0], v1 = acc[ai][bj][m][1];
                    u32x4 w; w.x = pkbf(v0[0], v0[1]); w.y = pkbf(v0[2], v0[3]); w.z = pkbf(v1[0], v1[1]); w.w = pkbf(v1[2], v1[3]);
                    *(__attribute__((address_space(1))) u32x4*)(rowp + bj * HALF) = w; } }
    }
};

struct EpiNull {
    static constexpr bool PERM = true, AFTER_DRAIN = false;
    __device__ __forceinline__ void operator()(const f32x4 (&acc)[2][2][4][2], const Unit& u, int wr, int wc, int fr, int fq) const {
#pragma unroll
        for (int ai = 0; ai < 2; ++ai)
#pragma unroll
            for (int bj = 0; bj < 2; ++bj)
#pragma unroll
                for (int m = 0; m < 4; ++m)
#pragma unroll
                    for (int n = 0; n < 2; ++n) asm volatile("" :: "v"(acc[ai][bj][m][n]));
    }
};

struct EpiQ {
    static constexpr bool PERM = false, AFTER_DRAIN = false;
    bf16_t* O; const float* rope; int nlat;
    __device__ __forceinline__ void operator()(const f32x4 (&acc)[2][2][4][2], const Unit& u, int wr, int wc, int fr, int fq) const {
        const int row0 = u.pm * BM + wr * 64 + fr;
#pragma unroll
        for (int bj = 0; bj < 2; ++bj) {
            const int g32 = u.pn * 8 + bj * 4 + wc; const bool isrope = (g32 % 3) == 2; const int colb = g32 * 32 + 4 * fq;
#pragma unroll
            for (int ai = 0; ai < 2; ++ai)
#pragma unroll
                for (int m = 0; m < 4; ++m) { const int row = row0 + ai * HALF + m * 16;
                    f32x4 v0 = acc[ai][bj][m][0], v1 = acc[ai][bj][m][1];
                    if (isrope && row < nlat) { const float* cs = rope + ((size_t)(row & 8191) * 16 + 4 * fq) * 2;
                        const f32x4 c01 = *(const f32x4*)cs, c23 = *(const f32x4*)(cs + 4);
                        const float c[4] = {c01[0], c01[2], c23[0], c23[2]}, s[4] = {c01[1], c01[3], c23[1], c23[3]};
                        f32x4 a, b;
#pragma unroll
                        for (int i = 0; i < 4; ++i) { a[i] = v0[i] * c[i] - v1[i] * s[i]; b[i] = v1[i] * c[i] + v0[i] * s[i]; }
                        v0 = a; v1 = b; }
                    bf16_t* p = O + (size_t)row * 768 + colb;
                    u32x2e w0, w1; w0.x = pkbf(v0[0], v0[1]); w0.y = pkbf(v0[2], v0[3]); w1.x = pkbf(v1[0], v1[1]); w1.y = pkbf(v1[2], v1[3]);
                    *(u32x2e*)p = w0; *(u32x2e*)(p + 16) = w1; }
        }
    }
};

struct EpiKV {
    static constexpr bool PERM = false, AFTER_DRAIN = false;
    __attribute__((address_space(1))) bf16_t* KB; __attribute__((address_space(1))) bf16_t* VT; int nlat, keys, ctxl;
    __device__ __forceinline__ void operator()(const f32x4 (&acc)[2][2][4][2], const Unit& u, int wr, int wc, int fr, int fq) const {
        const int row0 = u.pm * BM + wr * 64 + fr;
#pragma unroll
        for (int ai = 0; ai < 2; ++ai)
#pragma unroll
            for (int m = 0; m < 4; ++m) { const int row = row0 + ai * HALF + m * 16;
                int b, key; if (row < nlat) { b = row >> 13; key = ctxl + (row & 8191); } else { const int r2 = row - nlat; b = r2 >> 8; key = r2 & 255; }
#pragma unroll
                for (int bj = 0; bj < 2; ++bj) { const int head = u.pn * 2 + bj; const size_t bh = (size_t)(b * 8 + head);
#pragma unroll
                    for (int n = 0; n < 2; ++n) { const f32x4 v = acc[ai][bj][m][n]; const int cw = (wc & 1) * 32 + n * 16 + 4 * fq;
                        if (wc < 2) { u32x2e w; w.x = pkbf(v[0], v[1]); w.y = pkbf(v[2], v[3]); *(__attribute__((address_space(1))) u32x2e*)(KB + (bh * keys + key) * 96 + cw) = w; }
                        else { __attribute__((address_space(1))) bf16_t* p = VT + (bh * 64 + cw) * keys + key; const unsigned w0 = pkbf(v[0], v[1]), w1 = pkbf(v[2], v[3]);
                            p[0] = (bf16_t)(w0 & 0xffff); p[(size_t)keys] = (bf16_t)(w0 >> 16); p[(size_t)2 * keys] = (bf16_t)(w1 & 0xffff); p[(size_t)3 * keys] = (bf16_t)(w1 >> 16); } } }
                asm volatile("" ::: "memory"); }
    }
};

struct EpiMerge {
    static constexpr bool PERM = false, AFTER_DRAIN = false;
    const bf16_t* P; float* YM; bf16_t* YMB; int nPM, ldp, ogate;
    __device__ __forceinline__ void operator()(const f32x4 (&acc)[2][2][4][2], const Unit& u, int wr, int wc, int fr, int fq) const {
        const int br = u.pm / nPM, pm = u.pm - br * nPM, pn = u.pn & 3;
        const int row0 = pm * BM + wr * 64 + fr;
#pragma unroll
        for (int ai = 0; ai < 2; ++ai)
#pragma unroll
            for (int m = 0; m < 4; ++m) { const int row = row0 + ai * HALF + m * 16;
#pragma unroll
                for (int bj = 0; bj < 2; ++bj)
#pragma unroll
                    for (int n = 0; n < 2; ++n) { const int col = pn * BM + bj * HALF + wc * 32 + n * 16 + 4 * fq;
                        const u32x2e gw = *(const u32x2e*)(P + (size_t)row * ldp + ogate + br * 1024 + col);
                        const float g0 = __builtin_bit_cast(float, gw.x << 16), g1 = __builtin_bit_cast(float, gw.x & 0xffff0000u), g2 = __builtin_bit_cast(float, gw.y << 16), g3 = __builtin_bit_cast(float, gw.y & 0xffff0000u);
                        f32x4 v = acc[ai][bj][m][n];
                        v[0] *= 1.f / (1.f + __expf(-g0)); v[1] *= 1.f / (1.f + __expf(-g1)); v[2] *= 1.f / (1.f + __expf(-g2)); v[3] *= 1.f / (1.f + __expf(-g3));
                        float* yp = YM + (size_t)row * 1024 + col;
                        if (br == 0) *(f32x4*)yp = v;
                        else if (br == 1) { const f32x4 o = *(const f32x4*)yp; *(f32x4*)yp = o + v; }
                        else { const f32x4 o = *(const f32x4*)yp + v; u32x2e w; w.x = pkbf(o[0], o[1]); w.y = pkbf(o[2], o[3]); *(u32x2e*)(YMB + (size_t)row * 1024 + col) = w; } } }
    }
};

struct EpiOut {
    static constexpr bool PERM = false, AFTER_DRAIN = false;
    const __attribute__((address_space(1))) float* XL; const __attribute__((address_space(1))) float* XC; __attribute__((address_space(1))) float* XPRE; const __attribute__((address_space(1))) float* mod; int nlat; float alpha;
    __device__ __forceinline__ void operator()(const f32x4 (&acc)[2][2][4][2], const Unit& u, int wr, int wc, int fr, int fq) const {
        const int row0 = u.pm * BM + wr * 64 + fr;
#pragma unroll
        for (int ai = 0; ai < 2; ++ai)
#pragma unroll
            for (int m = 0; m < 4; ++m) { const int row = row0 + ai * HALF + m * 16; const int mi = row < nlat ? (row >> 13) : 2; const __attribute__((address_space(1))) float* xr = (row < nlat ? XL : XC) + (size_t)row * 1024;
#pragma unroll
                for (int bj = 0; bj < 2; ++bj)
#pragma unroll
                    for (int n = 0; n < 2; ++n) { const int col = u.pn * BM + bj * HALF + wc * 32 + n * 16 + 4 * fq;
                        const f32x4 g = *(const __attribute__((address_space(1))) f32x4*)(mod + mi * 6144 + 2048 + col), x = *(const __attribute__((address_space(1))) f32x4*)(xr + col);
                        *(__attribute__((address_space(1))) f32x4*)(XPRE + (size_t)row * 1024 + col) = x * alpha + g * acc[ai][bj][m][n]; } }
    }
};

struct EpiMoe1 {
    static constexpr bool PERM = false, AFTER_DRAIN = false;
    __attribute__((address_space(1))) bf16_t* ACT; const __attribute__((address_space(1))) float* b1;
    __device__ __forceinline__ void operator()(const f32x4 (&acc)[2][2][4][2], const Unit& u, int wr, int wc, int fr, int fq) const {
        const int e = u.pn >> 3, j = u.pn & 7; const int row0 = u.pm * BM + wr * 64 + fr; const __attribute__((address_space(1))) float* be = b1 + (size_t)e * 2048;
        const int colb = 128 * j + wc * 32 + 4 * fq;
        const f32x4 bg0 = *(const __attribute__((address_space(1))) f32x4*)(be + colb), bl0 = *(const __attribute__((address_space(1))) f32x4*)(be + 1024 + colb), bg1 = *(const __attribute__((address_space(1))) f32x4*)(be + colb + 16), bl1 = *(const __attribute__((address_space(1))) f32x4*)(be + 1024 + colb + 16);
#pragma unroll
        for (int ai = 0; ai < 2; ++ai)
#pragma unroll
            for (int m = 0; m < 4; ++m) { const int row = row0 + ai * HALF + m * 16; __attribute__((address_space(1))) bf16_t* op = ACT + (size_t)row * 1024 + colb;
#pragma unroll
                for (int n = 0; n < 2; ++n) { const f32x4 g = acc[ai][0][m][n] + (n ? bg1 : bg0), l = acc[ai][1][m][n] + (n ? bl1 : bl0); f32x4 o;
#pragma unroll
                    for (int i = 0; i < 4; ++i) { const float gg = fminf(g[i], 7.f), ll = fminf(fmaxf(l[i], -7.f), 7.f);
                        o[i] = gg * __builtin_amdgcn_rcpf(1.f + __builtin_amdgcn_exp2f(-1.702f * 1.4426950408889634f * gg)) * (ll + 1.f); }
                    u32x2e w; w.x = pkbf(o[0], o[1]); w.y = pkbf(o[2], o[3]); *(__attribute__((address_space(1))) u32x2e*)(op + n * 16) = w; }
                __builtin_amdgcn_sched_barrier(0); }
    }
};

struct EpiMoe2 {
    static constexpr bool PERM = false, AFTER_DRAIN = false;
    __attribute__((address_space(1))) bf16_t* YSLOT; const __attribute__((address_space(1))) float* b2; const __attribute__((address_space(1))) int* rslot; const __attribute__((address_space(1))) float* gate;
    __device__ __forceinline__ void operator()(const f32x4 (&acc)[2][2][4][2], const Unit& u, int wr, int wc, int fr, int fq) const {
        const int e = u.pn >> 2, j = u.pn & 3; const int row0 = u.pm * BM + wr * 64 + fr; const __attribute__((address_space(1))) float* be = b2 + (size_t)e * 1024;
#pragma unroll
        for (int ai = 0; ai < 2; ++ai)
#pragma unroll
            for (int m = 0; m < 4; ++m) { const int row = row0 + ai * HALF + m * 16; const int slot = rslot[row];
                if (slot >= 0) { const float gt = gate[slot];
#pragma unroll
                    for (int bj = 0; bj < 2; ++bj)
#pragma unroll
                        for (int n = 0; n < 2; ++n) { const int col = j * BM + bj * HALF + wc * 32 + n * 16 + 4 * fq;
                            const f32x4 o = (acc[ai][bj][m][n] + *(const __attribute__((address_space(1))) f32x4*)(be + col)) * gt;
                            u32x2e w; w.x = pkbf(o[0], o[1]); w.y = pkbf(o[2], o[3]); *(__attribute__((address_space(1))) u32x2e*)(YSLOT + (size_t)slot * 1024 + col) = w; } }
                __builtin_amdgcn_sched_barrier(0); }
    }
};

struct MergeOrder {
    int nPM, sPM, G, c;
    __device__ __forceinline__ bool next(int i, Unit& u) const {
        const int L = i * G + c; if (L >= nPM * 12) return false;
        const int t = L / 3, br = L - 3 * t, pm = t >> 2, pn = t & 3; u.pm = br * sPM + pm; u.pn = br * 4 + pn; return true;
    }
    __device__ __forceinline__ void a_ready(const Unit&) const {}
    __device__ __forceinline__ void done(const Unit&) const {}
};
template <int nN> struct MoeOrder {
    const PG8_LAS int* ptab; int npanel, G, c;
    __device__ __forceinline__ bool next(int i, Unit& u) const {
        constexpr int PB = 32 / nN; int pm, pn;
        if (G == 256) { const int x = c & 7, w = c >> 3, s = i * 8 + x; pm = s * PB + w / nN; pn = w % nN; }
        else { const int L = i * G + c; pm = L / nN; pn = L - pm * nN; }
        if (pm >= npanel) return false;
        const int e = __builtin_amdgcn_readfirstlane(ptab[pm]);
        u.pm = pm; u.pn = e * nN + pn; return true;
    }
    __device__ __forceinline__ void a_ready(const Unit&) const {}
    __device__ __forceinline__ void done(const Unit&) const {}
};
template <class Epi, class Sched, bool ALIGN_EPI = false, bool SP2 = false>
__device__ __forceinline__ void gemm_phase(PG8_LAS unsigned char* lds, const Gemm g, const Sched& S, const Epi& E, const int tid) {
    const int wid = __builtin_amdgcn_readfirstlane(tid >> 6), lane = tid & 63, wr = wid >> 2, wc = wid & 3, fr = lane & 15, fq = lane >> 4;
    const int K = g.K, nt = K / BK;
    unsigned voffA[2], voffB[2];
#pragma unroll
    for (int i = 0; i < 2; ++i) { int R, C; stage_rc(tid * 16 + i * 8192, R, C); const int Rb = Epi::PERM ? ((R & ~31) + perm32(R & 31)) : R;
        voffA[i] = (unsigned)(R * K + C) * 2u; voffB[i] = (unsigned)(Rb * K + C) * 2u; }
    const size_t kstep = (size_t)(BK * 2);
    const size_t hstep = (size_t)HALF * K * 2;
    const size_t tstep = 2 * hstep;
    const unsigned ldsw = (unsigned)wid * 1024u;
    const int aoff = lds_byte(wr * 64 + fr, fq * 8), boff = lds_byte(wc * 32 + fr, fq * 8);
#define PG8_SA(b, h) (((b) * 2 + (h)) * HTB)
#define PG8_SB(b, h) ((4 + (b) * 2 + (h)) * HTB)
#define PG8_STAGE(bufoff, gbase, voff) do { _Pragma("unroll") for (int _i = 0; _i < 2; ++_i) \
        __builtin_amdgcn_global_load_lds((const unsigned*)((const char*)(gbase) + (voff)[_i]), (PG8_LAS unsigned*)(lds + (bufoff) + ldsw + _i * 8192), 16, 0, 0); } while (0)
#define PG8_LDA(dst, b, h) do { _Pragma("unroll") for (int m = 0; m < 4; ++m) _Pragma("unroll") for (int k = 0; k < 2; ++k) dst[m][k] = *(const PG8_LAS bf16x8*)(lds + PG8_SA(b, h) + aoff + m * 2048 + k * 1024); } while (0)
#define PG8_LDB(dst, b, h) do { _Pragma("unroll") for (int n = 0; n < 2; ++n) _Pragma("unroll") for (int k = 0; k < 2; ++k) dst[n][k] = *(const PG8_LAS bf16x8*)(lds + PG8_SB(b, h) + boff + n * 2048 + k * 1024); } while (0)
#define PG8_MMA(ai, bj, At, Bt) do { __builtin_amdgcn_s_setprio(1); _Pragma("unroll") for (int m = 0; m < 4; ++m) _Pragma("unroll") for (int n = 0; n < 2; ++n) _Pragma("unroll") for (int k = 0; k < 2; ++k) \
        acc[ai][bj][m][n] = __builtin_amdgcn_mfma_f32_16x16x32_bf16(Bt[n][k], At[m][k], acc[ai][bj][m][n], 0, 0, 0); __builtin_amdgcn_s_setprio(0); } while (0)
#define PG8_WAIT_V(n) asm volatile("s_waitcnt vmcnt(" #n ")" ::: "memory")
#define PG8_WAIT_L(n) asm volatile("s_waitcnt lgkmcnt(" #n ")" ::: "memory")
#define PG8_BAR __builtin_amdgcn_s_barrier()
#define PG8_SCHED __builtin_amdgcn_sched_barrier(0)
    Unit cur, nxt; int ui = 0;
    if (!S.next(0, cur)) return;
    f32x4 acc[2][2][4][2];
#pragma unroll
    for (int a = 0; a < 2; ++a)
#pragma unroll
        for (int b = 0; b < 2; ++b)
#pragma unroll
            for (int m = 0; m < 4; ++m)
#pragma unroll
                for (int n = 0; n < 2; ++n) acc[a][b][m][n] = (f32x4){0.f, 0.f, 0.f, 0.f};
    bf16x8 At[4][2], B0[2][2], B1[2][2];
    const char* cA = (const char*)g.A + (size_t)cur.pm * tstep; const char* cB = (const char*)g.Bt + (size_t)cur.pn * tstep;
    S.a_ready(cur);
    if constexpr (SP2) {
        PG8_STAGE(PG8_SB(0, 0), cB, voffB); PG8_STAGE(PG8_SB(0, 1), cB + hstep, voffB); PG8_STAGE(PG8_SA(0, 0), cA, voffA); PG8_STAGE(PG8_SA(0, 1), cA + hstep, voffA);
        if (wr == 1) PG8_BAR;
        PG8_WAIT_V(2); PG8_BAR;
        PG8_STAGE(PG8_SB(1, 0), cB + kstep, voffB); PG8_STAGE(PG8_SA(1, 0), cA + kstep, voffA); PG8_STAGE(PG8_SB(1, 1), cB + hstep + kstep, voffB);
        PG8_WAIT_V(6); PG8_BAR;
    } else {
        PG8_STAGE(PG8_SB(0, 0), cB, voffB); PG8_STAGE(PG8_SA(0, 0), cA, voffA); PG8_STAGE(PG8_SB(0, 1), cB + hstep, voffB); PG8_STAGE(PG8_SA(0, 1), cA + hstep, voffA);
        if (wr == 1) PG8_BAR;
        PG8_WAIT_V(4); PG8_BAR;
        PG8_STAGE(PG8_SB(1, 0), cB + kstep, voffB); PG8_STAGE(PG8_SA(1, 0), cA + kstep, voffA); PG8_STAGE(PG8_SB(1, 1), cB + hstep + kstep, voffB);
        PG8_WAIT_V(6); PG8_BAR;
    }
    for (;;) {
        const bool has_next = S.next(ui + 1, nxt);
        const char* nA = has_next ? (const char*)g.A + (size_t)nxt.pm * tstep : cA; const char* nB = has_next ? (const char*)g.Bt + (size_t)nxt.pn * tstep : cB;
#pragma unroll 1
        for (int t = 0; t < nt; t += 2) {
            const bool last = (t == nt - 2);
            const char* a1 = cA + (size_t)(t + 1) * kstep;
            const char* a2 = last ? nA : cA + (size_t)(t + 2) * kstep; const char* b2 = last ? nB : cB + (size_t)(t + 2) * kstep;
            const char* a3 = a2 + kstep; const char* b3 = b2 + kstep;
            if (last && has_next) S.a_ready(nxt);
            if constexpr (SP2) {
            PG8_LDB(B0, 0, 0); PG8_LDB(B1, 0, 1); PG8_SCHED; PG8_LDA(At, 0, 0); PG8_STAGE(PG8_SA(1, 1), a1 + hstep, voffA);
            PG8_WAIT_V(8); PG8_WAIT_L(0); PG8_BAR; PG8_MMA(0, 0, At, B0); PG8_MMA(0, 1, At, B1); PG8_BAR; PG8_SCHED;
            PG8_LDA(At, 0, 1); PG8_STAGE(PG8_SB(0, 0), b2, voffB); PG8_STAGE(PG8_SB(0, 1), b2 + hstep, voffB); PG8_STAGE(PG8_SA(0, 0), a2, voffA);
            PG8_WAIT_V(8); PG8_WAIT_L(0); PG8_BAR; PG8_MMA(1, 0, At, B0); PG8_MMA(1, 1, At, B1); PG8_BAR; PG8_SCHED;
            PG8_LDB(B0, 1, 0); PG8_LDB(B1, 1, 1); PG8_SCHED; PG8_LDA(At, 1, 0); PG8_STAGE(PG8_SA(0, 1), a2 + hstep, voffA);
            PG8_WAIT_V(8); PG8_WAIT_L(0); PG8_BAR; PG8_MMA(0, 0, At, B0); PG8_MMA(0, 1, At, B1); PG8_BAR; PG8_SCHED;
            PG8_LDA(At, 1, 1); PG8_STAGE(PG8_SB(1, 0), b3, voffB); PG8_STAGE(PG8_SB(1, 1), b3 + hstep, voffB); PG8_STAGE(PG8_SA(1, 0), a3, voffA);
            PG8_WAIT_V(8); PG8_WAIT_L(0); PG8_BAR; PG8_MMA(1, 0, At, B0); PG8_MMA(1, 1, At, B1); PG8_BAR; PG8_SCHED;
            } else {
            PG8_LDB(B0, 0, 0); PG8_SCHED; PG8_LDA(At, 0, 0); PG8_STAGE(PG8_SA(1, 1), a1 + hstep, voffA);
            PG8_WAIT_L(8); PG8_BAR; PG8_WAIT_L(0); PG8_MMA(0, 0, At, B0); PG8_BAR; PG8_SCHED;
            PG8_LDB(B1, 0, 1); PG8_STAGE(PG8_SB(0, 0), b2, voffB);
            PG8_BAR; PG8_WAIT_L(0); PG8_MMA(0, 1, At, B1); PG8_BAR;
            PG8_LDA(At, 0, 1); PG8_STAGE(PG8_SA(0, 0), a2, voffA);
            PG8_BAR; PG8_WAIT_L(0); PG8_MMA(1, 0, At, B0); PG8_BAR; PG8_SCHED;
            PG8_STAGE(PG8_SB(0, 1), b2 + hstep, voffB);
            PG8_WAIT_V(6); PG8_BAR; PG8_MMA(1, 1, At, B1); PG8_BAR;
            PG8_LDB(B0, 1, 0); PG8_SCHED; PG8_LDA(At, 1, 0); PG8_STAGE(PG8_SA(0, 1), a2 + hstep, voffA);
            PG8_WAIT_L(8); PG8_BAR; PG8_WAIT_L(0); PG8_MMA(0, 0, At, B0); PG8_BAR; PG8_SCHED;
            PG8_LDB(B1, 1, 1); PG8_STAGE(PG8_SB(1, 0), b3, voffB);
            PG8_BAR; PG8_WAIT_L(0); PG8_MMA(0, 1, At, B1); PG8_BAR;
            PG8_LDA(At, 1, 1); PG8_STAGE(PG8_SA(1, 0), a3, voffA);
            PG8_BAR; PG8_WAIT_L(0); PG8_MMA(1, 0, At, B0); PG8_BAR; PG8_SCHED;
            PG8_STAGE(PG8_SB(1, 1), b3 + hstep, voffB);
            PG8_WAIT_V(6); PG8_BAR; PG8_MMA(1, 1, At, B1); PG8_BAR;
            }
        }
        if constexpr (ALIGN_EPI) { if (wr == 0) PG8_BAR; }
        if constexpr (!Epi::AFTER_DRAIN) { E(acc, cur, wr, wc, fr, fq); S.done(cur); }
        if (!has_next) break;
#pragma unroll
        for (int a = 0; a < 2; ++a)
#pragma unroll
            for (int b = 0; b < 2; ++b)
#pragma unroll
                for (int m = 0; m < 4; ++m)
#pragma unroll
                    for (int n = 0; n < 2; ++n) acc[a][b][m][n] = (f32x4){0.f, 0.f, 0.f, 0.f};
        cur = nxt; cA = nA; cB = nB; ++ui;
        if constexpr (ALIGN_EPI) { if (wr == 1) PG8_BAR; }
    }
    PG8_WAIT_V(0);
    if constexpr (!ALIGN_EPI) { if (wr == 0) PG8_BAR; }
    PG8_BAR;
    if constexpr (Epi::AFTER_DRAIN) { E.fused(acc, cur, wr, wc, fr, fq, lds, wid, lane); S.done(cur); }
#undef PG8_SA
#undef PG8_SB
#undef PG8_STAGE
#undef PG8_LDA
#undef PG8_LDB
#undef PG8_MMA
#undef PG8_WAIT_V
#undef PG8_WAIT_L
#undef PG8_BAR
#undef PG8_SCHED
}
template <class Epi, class Sched, bool ALIGN_EPI = false, bool SP2 = false>
__device__ __forceinline__ void gemm_phase_g(PG8_LAS unsigned char* lds, const Gemm g, const Sched& S, const Epi& E, const int tid, const __attribute__((address_space(1))) int* rsl) {
    static_assert(SP2, "gather variant: SP2 loop only");
    const int wid = __builtin_amdgcn_readfirstlane(tid >> 6), lane = tid & 63, wr = wid >> 2, wc = wid & 3, fr = lane & 15, fq = lane >> 4;
    const int K = g.K, nt = K / BK;
    unsigned voffA[2] = {0u, 0u}, voffB[2]; int srR[2], srC[2]; unsigned vAc[2][2], vAn[2][2];
#pragma unroll
    for (int i = 0; i < 2; ++i) { int R, C; stage_rc(tid * 16 + i * 8192, R, C); const int Rb = Epi::PERM ? ((R & ~31) + perm32(R & 31)) : R;
        srR[i] = R; srC[i] = C; voffB[i] = (unsigned)(Rb * K + C) * 2u; }
#define PG8_GCALC(dst, un) do { _Pragma("unroll") for (int h_ = 0; h_ < 2; ++h_) _Pragma("unroll") for (int i_ = 0; i_ < 2; ++i_) { const int rr_ = rsl[(un).pm * 256 + h_ * 128 + srR[i_]]; \
        dst[h_][i_] = (unsigned)(((rr_ < 0 ? 0 : (rr_ >> 2)) * K + srC[i_]) * 2); } } while (0)
    const size_t kstep = (size_t)(BK * 2);
    const size_t hstep = (size_t)HALF * K * 2;
    const size_t tstep = 2 * hstep;
    const unsigned ldsw = (unsigned)wid * 1024u;
    const int aoff = lds_byte(wr * 64 + fr, fq * 8), boff = lds_byte(wc * 32 + fr, fq * 8);
#define PG8_SA(b, h) (((b) * 2 + (h)) * HTB)
#define PG8_SB(b, h) ((4 + (b) * 2 + (h)) * HTB)
#define PG8_STAGE(bufoff, gbase, voff) do { _Pragma("unroll") for (int _i = 0; _i < 2; ++_i) \
        __builtin_amdgcn_global_load_lds((const unsigned*)((const char*)(gbase) + (voff)[_i]), (PG8_LAS unsigned*)(lds + (bufoff) + ldsw + _i * 8192), 16, 0, 0); } while (0)
#define PG8_LDA(dst, b, h) do { _Pragma("unroll") for (int m = 0; m < 4; ++m) _Pragma("unroll") for (int k = 0; k < 2; ++k) dst[m][k] = *(const PG8_LAS bf16x8*)(lds + PG8_SA(b, h) + aoff + m * 2048 + k * 1024); } while (0)
#define PG8_LDB(dst, b, h) do { _Pragma("unroll") for (int n = 0; n < 2; ++n) _Pragma("unroll") for (int k = 0; k < 2; ++k) dst[n][k] = *(const PG8_LAS bf16x8*)(lds + PG8_SB(b, h) + boff + n * 2048 + k * 1024); } while (0)
#define PG8_MMA(ai, bj, At, Bt) do { __builtin_amdgcn_s_setprio(1); _Pragma("unroll") for (int m = 0; m < 4; ++m) _Pragma("unroll") for (int n = 0; n < 2; ++n) _Pragma("unroll") for (int k = 0; k < 2; ++k) \
        acc[ai][bj][m][n] = __builtin_amdgcn_mfma_f32_16x16x32_bf16(Bt[n][k], At[m][k], acc[ai][bj][m][n], 0, 0, 0); __builtin_amdgcn_s_setprio(0); } while (0)
#define PG8_WAIT_V(n) asm volatile("s_waitcnt vmcnt(" #n ")" ::: "memory")
#define PG8_WAIT_L(n) asm volatile("s_waitcnt lgkmcnt(" #n ")" ::: "memory")
#define PG8_BAR __builtin_amdgcn_s_barrier()
#define PG8_SCHED __builtin_amdgcn_sched_barrier(0)
    Unit cur, nxt; int ui = 0;
    if (!S.next(0, cur)) return;
    f32x4 acc[2][2][4][2];
#pragma unroll
    for (int a = 0; a < 2; ++a)
#pragma unroll
        for (int b = 0; b < 2; ++b)
#pragma unroll
            for (int m = 0; m < 4; ++m)
#pragma unroll
                for (int n = 0; n < 2; ++n) acc[a][b][m][n] = (f32x4){0.f, 0.f, 0.f, 0.f};
    bf16x8 At[4][2], B0[2][2], B1[2][2];
    const char* cA = (const char*)g.A; PG8_GCALC(vAc, cur); const char* cB = (const char*)g.Bt + (size_t)cur.pn * tstep;
    S.a_ready(cur);
    if constexpr (SP2) {
        PG8_STAGE(PG8_SB(0, 0), cB, voffB); PG8_STAGE(PG8_SB(0, 1), cB + hstep, voffB); PG8_STAGE(PG8_SA(0, 0), cA, vAc[0]); PG8_STAGE(PG8_SA(0, 1), cA, vAc[1]);
        if (wr == 1) PG8_BAR;
        PG8_WAIT_V(2); PG8_BAR;
        PG8_STAGE(PG8_SB(1, 0), cB + kstep, voffB); PG8_STAGE(PG8_SA(1, 0), cA + kstep, vAc[0]); PG8_STAGE(PG8_SB(1, 1), cB + hstep + kstep, voffB);
        PG8_WAIT_V(6); PG8_BAR;
    } else {
        PG8_STAGE(PG8_SB(0, 0), cB, voffB); PG8_STAGE(PG8_SA(0, 0), cA, voffA); PG8_STAGE(PG8_SB(0, 1), cB + hstep, voffB); PG8_STAGE(PG8_SA(0, 1), cA + hstep, voffA);
        if (wr == 1) PG8_BAR;
        PG8_WAIT_V(4); PG8_BAR;
        PG8_STAGE(PG8_SB(1, 0), cB + kstep, voffB); PG8_STAGE(PG8_SA(1, 0), cA + kstep, voffA); PG8_STAGE(PG8_SB(1, 1), cB + hstep + kstep, voffB);
        PG8_WAIT_V(6); PG8_BAR;
    }
    for (;;) {
        const bool has_next = S.next(ui + 1, nxt);
        const char* nA = cA; if (has_next) PG8_GCALC(vAn, nxt); else { vAn[0][0] = vAc[0][0]; vAn[0][1] = vAc[0][1]; vAn[1][0] = vAc[1][0]; vAn[1][1] = vAc[1][1]; } const char* nB = has_next ? (const char*)g.Bt + (size_t)nxt.pn * tstep : cB;
#pragma unroll 1
        for (int t = 0; t < nt; t += 2) {
            const bool last = (t == nt - 2);
            const char* a1 = cA + (size_t)(t + 1) * kstep;
            const char* a2 = last ? nA : cA + (size_t)(t + 2) * kstep; const char* b2 = last ? nB : cB + (size_t)(t + 2) * kstep;
            const char* a3 = a2 + kstep; const char* b3 = b2 + kstep;
            if (last && has_next) S.a_ready(nxt);
            if constexpr (SP2) {
            PG8_LDB(B0, 0, 0); PG8_LDB(B1, 0, 1); PG8_SCHED; PG8_LDA(At, 0, 0); PG8_STAGE(PG8_SA(1, 1), a1, vAc[1]);
            PG8_WAIT_V(8); PG8_WAIT_L(0); PG8_BAR; PG8_MMA(0, 0, At, B0); PG8_MMA(0, 1, At, B1); PG8_BAR; PG8_SCHED;
            PG8_LDA(At, 0, 1); PG8_STAGE(PG8_SB(0, 0), b2, voffB); PG8_STAGE(PG8_SB(0, 1), b2 + hstep, voffB); PG8_STAGE(PG8_SA(0, 0), a2, (last ? vAn[0] : vAc[0]));
            PG8_WAIT_V(8); PG8_WAIT_L(0); PG8_BAR; PG8_MMA(1, 0, At, B0); PG8_MMA(1, 1, At, B1); PG8_BAR; PG8_SCHED;
            PG8_LDB(B0, 1, 0); PG8_LDB(B1, 1, 1); PG8_SCHED; PG8_LDA(At, 1, 0); PG8_STAGE(PG8_SA(0, 1), a2, (last ? vAn[1] : vAc[1]));
            PG8_WAIT_V(8); PG8_WAIT_L(0); PG8_BAR; PG8_MMA(0, 0, At, B0); PG8_MMA(0, 1, At, B1); PG8_BAR; PG8_SCHED;
            PG8_LDA(At, 1, 1); PG8_STAGE(PG8_SB(1, 0), b3, voffB); PG8_STAGE(PG8_SB(1, 1), b3 + hstep, voffB); PG8_STAGE(PG8_SA(1, 0), a3, (last ? vAn[0] : vAc[0]));
            PG8_WAIT_V(8); PG8_WAIT_L(0); PG8_BAR; PG8_MMA(1, 0, At, B0); PG8_MMA(1, 1, At, B1); PG8_BAR; PG8_SCHED;
            } else {
            PG8_LDB(B0, 0, 0); PG8_SCHED; PG8_LDA(At, 0, 0); PG8_STAGE(PG8_SA(1, 1), a1 + hstep, voffA);
            PG8_WAIT_L(8); PG8_BAR; PG8_WAIT_L(0); PG8_MMA(0, 0, At, B0); PG8_BAR; PG8_SCHED;
            PG8_LDB(B1, 0, 1); PG8_STAGE(PG8_SB(0, 0), b2, voffB);
            PG8_BAR; PG8_WAIT_L(0); PG8_MMA(0, 1, At, B1); PG8_BAR;
            PG8_LDA(At, 0, 1); PG8_STAGE(PG8_SA(0, 0), a2, voffA);
            PG8_BAR; PG8_WAIT_L(0); PG8_MMA(1, 0, At, B0); PG8_BAR; PG8_SCHED;
            PG8_STAGE(PG8_SB(0, 1), b2 + hstep, voffB);
            PG8_WAIT_V(6); PG8_BAR; PG8_MMA(1, 1, At, B1); PG8_BAR;
            PG8_LDB(B0, 1, 0); PG8_SCHED; PG8_LDA(At, 1, 0); PG8_STAGE(PG8_SA(0, 1), a2 + hstep, voffA);
            PG8_WAIT_L(8); PG8_BAR; PG8_WAIT_L(0); PG8_MMA(0, 0, At, B0); PG8_BAR; PG8_SCHED;
            PG8_LDB(B1, 1, 1); PG8_STAGE(PG8_SB(1, 0), b3, voffB);
            PG8_BAR; PG8_WAIT_L(0); PG8_MMA(0, 1, At, B1); PG8_BAR;
            PG8_LDA(At, 1, 1); PG8_STAGE(PG8_SA(1, 0), a3, voffA);
            PG8_BAR; PG8_WAIT_L(0); PG8_MMA(1, 0, At, B0); PG8_BAR; PG8_SCHED;
            PG8_STAGE(PG8_SB(1, 1), b3 + hstep, voffB);
            PG8_WAIT_V(6); PG8_BAR; PG8_MMA(1, 1, At, B1); PG8_BAR;
            }
        }
        if constexpr (ALIGN_EPI) { if (wr == 0) PG8_BAR; }
        if constexpr (!Epi::AFTER_DRAIN) { E(acc, cur, wr, wc, fr, fq); S.done(cur); }
        if (!has_next) break;
#pragma unroll
        for (int a = 0; a < 2; ++a)
#pragma unroll
            for (int b = 0; b < 2; ++b)
#pragma unroll
                for (int m = 0; m < 4; ++m)
#pragma unroll
                    for (int n = 0; n < 2; ++n) acc[a][b][m][n] = (f32x4){0.f, 0.f, 0.f, 0.f};
        cur = nxt; cA = nA; cB = nB; ++ui; vAc[0][0] = vAn[0][0]; vAc[0][1] = vAn[0][1]; vAc[1][0] = vAn[1][0]; vAc[1][1] = vAn[1][1];
        if constexpr (ALIGN_EPI) { if (wr == 1) PG8_BAR; }
    }
    PG8_WAIT_V(0);
    if constexpr (!ALIGN_EPI) { if (wr == 0) PG8_BAR; }
    PG8_BAR;
    if constexpr (Epi::AFTER_DRAIN) { E.fused(acc, cur, wr, wc, fr, fq, lds, wid, lane); S.done(cur); }
#undef PG8_GCALC
#undef PG8_SA
#undef PG8_SB
#undef PG8_STAGE
#undef PG8_LDA
#undef PG8_LDB
#undef PG8_MMA
#undef PG8_WAIT_V
#undef PG8_WAIT_L
#undef PG8_BAR
#undef PG8_SCHED
}
}

#define XB_TMO      128
#define XB_XCNT(j)  (256  + 64 * (j))
#define XB_XSUB(j)  (1280 + 64 * (j))
#define XB_XGEN(j)  (2304 + 64 * (j))
#define XB_TOP      3328
#define XB_TOPGEN   3392
#define XCD_BAR_WORDS 3456
#define XB_SPIN_CAP (1u << 18)

__device__ __forceinline__ unsigned xb_ld(unsigned* p)              { return __hip_atomic_load(p, __ATOMIC_RELAXED, __HIP_MEMORY_SCOPE_AGENT); }
__device__ __forceinline__ unsigned xb_add(unsigned* p, unsigned v) { return __hip_atomic_fetch_add(p, v, __ATOMIC_RELAXED, __HIP_MEMORY_SCOPE_AGENT); }
__device__ __forceinline__ unsigned xb_xcc_id() { return (unsigned)__builtin_amdgcn_s_getreg((3 << 11) | 20) & 0xFu; }
#define XB_SPIN(cond, bar) do { unsigned _sp = 0; while (cond) { __builtin_amdgcn_s_sleep(1); \
    if ((++_sp & 255u) == 0u) { if (xb_ld(&(bar)[XB_TMO])) break; if (_sp > XB_SPIN_CAP) { atomicAdd(&(bar)[XB_TMO], 1u); break; } } } } while (0)

struct XcdBarrier {
    unsigned* bar; unsigned x;
    volatile LAS unsigned* st;
};
__device__ __forceinline__ XcdBarrier xcd_barrier_post(unsigned* bar, volatile LAS unsigned* st) {
    XcdBarrier b; b.bar = bar; b.x = xb_xcc_id(); b.st = st;
    if (threadIdx.x == 0) (void)xb_add(&bar[XB_XCNT(b.x)], 1u);
    return b;
}
__device__ __forceinline__ void xcd_barrier_complete(unsigned* bar, unsigned x, unsigned& nloc, unsigned& nx) {
    const unsigned G = gridDim.x * gridDim.y * gridDim.z;
    unsigned sum, cnt, mine, sp = 0u;
    for (;;) {
        sum = 0u; cnt = 0u; mine = 0u;
#pragma unroll
        for (unsigned j = 0; j < 16; ++j) { const unsigned c = xb_ld(&bar[XB_XCNT(j)]); sum += c; cnt += (c > 0u) ? 1u : 0u; mine = (j == x) ? c : mine; }
        if (sum == G) break;
        __builtin_amdgcn_s_sleep(1);
        if ((++sp & 255u) == 0u) { if (xb_ld(&bar[XB_TMO])) break; if (sp > XB_SPIN_CAP) { atomicAdd(&bar[XB_TMO], 1u); break; } }
    }
    nloc = mine > 0u ? mine : 1u; nx = cnt > 0u ? cnt : 1u;
}
__device__ __forceinline__ void xcd_barrier(const XcdBarrier& b) {
    asm volatile("s_waitcnt vmcnt(0)" ::: "memory");
    __syncthreads();
    if (threadIdx.x == 0) {
        unsigned* bar = b.bar;
        __builtin_amdgcn_s_waitcnt(0);
        unsigned nloc = b.st[0], nx = b.st[1];
        if (nloc == 0u) { xcd_barrier_complete(bar, b.x, nloc, nx); b.st[0] = nloc; b.st[1] = nx; }
        const unsigned old = xb_add(&bar[XB_XSUB(b.x)], 1u);
        const unsigned gen = old / nloc;
        if (old + 1u == (gen + 1u) * nloc) {
            __builtin_amdgcn_fence(__ATOMIC_RELEASE, "agent");
            asm volatile("s_waitcnt vmcnt(0)" ::: "memory");
            const unsigned og = xb_add(&bar[XB_TOP], 1u);
            const unsigned tg = og / nx;
            if (og + 1u == (tg + 1u) * nx) xb_add(&bar[XB_TOPGEN], 1u);
            else XB_SPIN(xb_ld(&bar[XB_TOPGEN]) == tg, bar);
            __builtin_amdgcn_fence(__ATOMIC_ACQUIRE, "agent");
            xb_add(&bar[XB_XGEN(b.x)], 1u);
            asm volatile("s_waitcnt vmcnt(0)" ::: "memory");
        } else {
            XB_SPIN(xb_ld(&bar[XB_XGEN(b.x)]) == gen, bar);
            __builtin_amdgcn_fence(__ATOMIC_ACQUIRE, "agent");
            asm volatile("s_waitcnt vmcnt(0)" ::: "memory");
        }
    }
    __syncthreads();
}

struct Args { const float* in[39]; float* out; unsigned char* ws; int ph_lo, ph_hi, dupk, pad; };
enum { I_X = 0, I_C, I_CTX, I_CCTX, I_ADAW, I_ADAB, I_WIN, I_WA2F, I_BAF, I_WA2B, I_BAB, I_GNORM, I_QNORM, I_WUQ, I_KVNORM, I_WUKV, I_HCW, I_HCB, I_HW1, I_HB1, I_HW2, I_HB2, I_HW3, I_HFREQ,
       I_HBIAS, I_WBG, I_WBM, I_WBH, I_WOUT, I_LN1G, I_LN1B, I_LN2G, I_LN2B, I_RW, I_RB, I_MW1, I_MB1, I_MW2, I_MB2 };

__device__ __forceinline__ int opq(int i) { asm volatile("" : "+s"(i)); return i; }
#define INP(A, i) ((const float*)(const GAS float*)((A).in[opq(i)]))
struct Fr { LAS unsigned char* L; int tid, lane, wave, G, bid; };

__device__ __forceinline__ void tr_item(const float* W, int K, int N, bf16* WT, int mode, const float* kscale, float scale, LAS float* scr, int item, int lane) {
    const int nblk = N / 32, kb = item / nblk, nb = item - kb * nblk, k0 = 64 * kb, n0 = 32 * nb;
#pragma unroll
    for (int i = 0; i < 8; ++i) { const int kk = 8 * i + (lane >> 3), c4 = (lane & 7) * 4; f32x4 v = *(const GAS f32x4*)((const GAS float*)W + (size_t)(k0 + kk) * N + n0 + c4) * scale; if (kscale) v = v * kscale[k0 + kk];
        scr[kk * 33 + c4] = v[0]; scr[kk * 33 + c4 + 1] = v[1]; scr[kk * 33 + c4 + 2] = v[2]; scr[kk * 33 + c4 + 3] = v[3]; }
    LDS_WAIT(); asm volatile("" ::: "memory");
    const int c = lane & 7;
#pragma unroll
    for (int j = 0; j < 4; ++j) { const int n = (lane >> 3) + 8 * j; const LAS float* s = scr + (8 * c) * 33 + n;
        v4u o; o.x = pk2(s[0 * 33], s[1 * 33]); o.y = pk2(s[2 * 33], s[3 * 33]); o.z = pk2(s[4 * 33], s[5 * 33]); o.w = pk2(s[6 * 33], s[7 * 33]);
        int nn = n0 + n; if (mode == 1) { nn = nn < 1024 ? ((nn >> 7) * 256 + (nn & 127)) : ((((nn - 1024) >> 7) * 256) + 128 + ((nn - 1024) & 127)); }
        *(GAS v4u*)((GAS bf16*)WT + (size_t)nn * K + k0 + 8 * c) = o; }
    LDS_WAIT(); asm volatile("" ::: "memory");
}

__device__ __forceinline__ float silu_(float x) { return x / (1.f + expf(-x)); }

__device__ __forceinline__ void hy_filter_item(LAS unsigned char* L_, int tid_, const float* w1, const float* b1, const float* w2, const float* b2, const float* fr, const float* w3, int Ln, int blk, float* FILT, float* HP) {
    LAS float* zE = (LAS float*)L_;
    LAS float* h1 = zE + 32 * 36;
    LAS float* h2 = h1 + 32 * 64;
    const int tid = tid_, p0 = blk * 32;
    { const int p = tid >> 4, j = tid & 15; const int i = p0 + p;
      const float w = 6.283185307179586f * (float)i / (float)Ln; const float f = 1e-4f + (float)j * ((15.f - 1e-4f) / 15.f); const float ang = f * w;
      zE[p * 36 + 1 + j] = __cosf(ang); zE[p * 36 + 17 + j] = -__sinf(ang); if (j == 0) zE[p * 36] = (float)i / (float)(Ln - 1); }
    __syncthreads();
    { const int n = tid & 63; const float frn = fr[n], bn = b1[n];
#pragma unroll 1
      for (int q = 0; q < 4; ++q) { const int p = (tid >> 6) + 8 * q; float s = bn;
#pragma unroll 3
          for (int k = 0; k < 33; ++k) s += zE[p * 36 + k] * w1[k * 64 + n];
          h1[p * 64 + n] = __sinf(frn * s); } }
    __syncthreads();
    { const int n = tid & 63; const float frn = fr[n], bn = b2[n];
#pragma unroll 1
      for (int q = 0; q < 4; ++q) { const int p = (tid >> 6) + 8 * q; float s = bn;
#pragma unroll 4
          for (int k = 0; k < 64; ++k) s += h1[p * 64 + k] * w2[k * 64 + n];
          h2[p * 64 + n] = __sinf(frn * s); } }
    __syncthreads();
    { const int lane = tid & 63, wave_ = tid >> 6, r = lane & 31, hh = lane >> 5; const float d0 = -3.0701134573253945f, d1 = -15.350567286626972f;
      for (int cbk = wave_; cbk < 16; cbk += 8) { const int c = cbk * 32 + r; const float delta = fabsf(d0 + (float)c * ((d1 - d0) / 511.f));
          for (int o_ = 0; o_ < 2; ++o_) { float asum = 0.f;
              for (int dr = 0; dr < 2; ++dr) { const int j = (o_ * 2 + dr) * 512 + c; f32x16 acc;
#pragma unroll
                  for (int i = 0; i < 16; ++i) acc[i] = 0.f;
                  float bw[32];
#pragma unroll
                  for (int st = 0; st < 32; ++st) bw[st] = w3[(size_t)(2 * st + hh) * 2048 + j];
#pragma unroll
                  for (int st = 0; st < 32; ++st) acc = __builtin_amdgcn_mfma_f32_32x32x2f32(h2[r * 64 + 2 * st + hh], bw[st], acc, 0, 0, 0);
                  float* dst = FILT + ((size_t)j * Ln + p0);
#pragma unroll
                  for (int g = 0; g < 4; ++g) { f32x4 o;
#pragma unroll
                      for (int i = 0; i < 4; ++i) { const int p = 8 * g + 4 * hh + i; const float v = acc[4 * g + i] * __builtin_amdgcn_exp2f(-zE[p * 36] * delta * 1.4426950408889634f); o[i] = v; asum += fabsf(v); }
                      *(f32x4*)(dst + 8 * g + 4 * hh) = o; } }
              asum += __shfl_xor(asum, 32);
              if (hh == 0) HP[((size_t)blk * 2 + o_) * 512 + c] = asum; } } }
    __syncthreads();
}

__device__ __forceinline__ void ln_mod_row(const float* xrow, const float* sh, const float* sc, bf16* orow, int lane) {
    const f32x4* xr = (const f32x4*)xrow + lane; f32x4 v[4]; float s = 0.f;
#pragma unroll
    for (int j = 0; j < 4; ++j) { v[j] = xr[64 * j]; s += (v[j].x + v[j].y) + (v[j].z + v[j].w); }
    const float mean = wave_sum(s) * (1.f / D); float s2 = 0.f;
#pragma unroll
    for (int j = 0; j < 4; ++j) { v[j] = v[j] - mean; s2 += (v[j].x * v[j].x + v[j].y * v[j].y) + (v[j].z * v[j].z + v[j].w * v[j].w); }
    const float rstd = 1.f / sqrtf(wave_sum(s2) * (1.f / D) + LN_EPS);
    v2u* o8 = (v2u*)orow + lane;
#pragma unroll
    for (int j = 0; j < 4; ++j) { const f32x4 a = ((const f32x4*)sc)[lane + 64 * j], b = ((const f32x4*)sh)[lane + 64 * j]; const f32x4 y = v[j] * rstd * (a + 1.f) + b;
        v2u w; w.x = pk2(y.x, y.y); w.y = pk2(y.z, y.w); o8[64 * j] = w; }
}

__device__ __forceinline__ f32x2 cmul(f32x2 a, f32x2 b) { const f32x2 axx = __builtin_shufflevector(a, a, 0, 0), ayy = __builtin_shufflevector(a, a, 1, 1); f32x2 bs = __builtin_shufflevector(b, b, 1, 0); bs.x = -bs.x;
    return __builtin_elementwise_fma(ayy, bs, axx * b); }
__device__ __forceinline__ f32x2 cmulc(f32x2 a, f32x2 b) {
    const f32x2 bxx = __builtin_shufflevector(b, b, 0, 0), byy = __builtin_shufflevector(b, b, 1, 1); f32x2 as = __builtin_shufflevector(a, a, 1, 0); as.y = -as.y;
    return __builtin_elementwise_fma(as, byy, a * bxx); }
__device__ __forceinline__ f32x4 cswn(f32x4 w) { f32x4 r = __builtin_shufflevector(w, w, 1, 0, 3, 2); r.x = -r.x; r.z = -r.z; return r; }
__device__ __forceinline__ f32x4 cmul4(f32x4 x, f32x4 w, f32x4 wsn) { return __builtin_elementwise_fma(__builtin_shufflevector(x, x, 1, 1, 3, 3), wsn, __builtin_shufflevector(x, x, 0, 0, 2, 2) * w); }
__device__ __forceinline__ f32x4 cmulc4(f32x4 x, f32x4 w, f32x4 wsn) { return __builtin_shufflevector(x, x, 0, 0, 2, 2) * w - __builtin_shufflevector(x, x, 1, 1, 3, 3) * wsn; }
__device__ __forceinline__ int fpad(int i) { return i + 2 * (i >> 4); }
constexpr int FFT_LDS_ELEMS = FFTN + FFTN / 8;
__device__ __forceinline__ void fft16_dif(f32x2 (&x)[16]) {
    constexpr float wr[8] = {1.000000000e+00f, 9.238795325e-01f, 7.071067812e-01f, 3.826834324e-01f, 6.123233996e-17f, -3.826834324e-01f, -7.071067812e-01f, -9.238795325e-01f}, wi[8] = {-0.000000000e+00f, -3.826834324e-01f, -7.071067812e-01f, -9.238795325e-01f, -1.000000000e+00f, -9.238795325e-01f, -7.071067812e-01f, -3.826834324e-01f};
#pragma unroll
    for (int m = 16; m >= 2; m >>= 1) {
#pragma unroll
        for (int base = 0; base < 16; base += m)
#pragma unroll
            for (int j = 0; j < m / 2; ++j) { const f32x2 a = x[base + j], b = x[base + j + m / 2]; const f32x2 d = a - b; x[base + j] = a + b;
                const float cr = wr[j * (16 / m)], ci = wi[j * (16 / m)]; f32x2 t; t.x = d.x * cr - d.y * ci; t.y = d.x * ci + d.y * cr; x[base + j + m / 2] = t; }
    }
}
__device__ __forceinline__ void fft16_dit_inv(f32x2 (&x)[16]) {
    constexpr float wr[8] = {1.000000000e+00f, 9.238795325e-01f, 7.071067812e-01f, 3.826834324e-01f, 6.123233996e-17f, -3.826834324e-01f, -7.071067812e-01f, -9.238795325e-01f}, wi[8] = {-0.000000000e+00f, -3.826834324e-01f, -7.071067812e-01f, -9.238795325e-01f, -1.000000000e+00f, -9.238795325e-01f, -7.071067812e-01f, -3.826834324e-01f};
#pragma unroll
    for (int m = 2; m <= 16; m <<= 1) {
#pragma unroll
        for (int base = 0; base < 16; base += m)
#pragma unroll
            for (int j = 0; j < m / 2; ++j) { const f32x2 a = x[base + j], b = x[base + j + m / 2]; const float cr = wr[j * (16 / m)], ci = -wi[j * (16 / m)];
                f32x2 t; t.x = b.x * cr - b.y * ci; t.y = b.x * ci + b.y * cr; x[base + j] = a + t; x[base + j + m / 2] = a - t; }
    }
}
template <bool INV, int M> __device__ __forceinline__ void fft_r16_pass(LAS f32x2* X, const GAS f32x2* TW, int tid) {
    constexpr int Q = M / 16, PQ = Q + 2 * (Q / 16);
#pragma unroll 2
    for (int g = tid; g < FFTN / 16; g += 512) {
        const int j = g & (Q - 1), i0 = (g / Q) * M + j; LAS f32x2* p = X + fpad(i0);
        f32x2 x[16], pw[16];
#pragma unroll
        for (int k = 0; k < 16; ++k) x[k] = p[k * PQ];
        const f32x2 t = TW[j * (FFTN / M)];
        pw[1] = t; pw[2] = cmul(t, t); pw[3] = cmul(pw[2], t); pw[4] = cmul(pw[2], pw[2]); pw[5] = cmul(pw[4], t); pw[6] = cmul(pw[4], pw[2]); pw[7] = cmul(pw[4], pw[3]); pw[8] = cmul(pw[4], pw[4]);
#pragma unroll
        for (int k = 1; k < 8; ++k) pw[8 + k] = cmul(pw[8], pw[k]);
        if (!INV) { fft16_dif(x);
#pragma unroll
            for (int k = 1; k < 16; ++k) { constexpr int dummy = 0; (void)dummy; const int f = ((k & 1) << 3) | ((k & 2) << 1) | ((k & 4) >> 1) | ((k & 8) >> 3); x[k] = cmul(x[k], pw[f]); } }
        else {
#pragma unroll
            for (int k = 1; k < 16; ++k) { const int f = ((k & 1) << 3) | ((k & 2) << 1) | ((k & 4) >> 1) | ((k & 8) >> 3); x[k] = cmulc(x[k], pw[f]); }
            fft16_dit_inv(x); }
#pragma unroll
        for (int k = 0; k < 16; ++k) p[k * PQ] = x[k];
    }
    __syncthreads();
}
__device__ __forceinline__ f32x2 twl(const LAS f32x2* TL, int idx) { return cmul(TL[idx & 63], TL[64 + (idx >> 6)]); }
__device__ __forceinline__ void fft_fwd(LAS f32x2* X, const GAS f32x2* TL, int tid) {
    { const int m = FFTN;
        const int q = m >> 2, lq = 31 - __builtin_clz(q), ts = FFTN / m;
#pragma unroll 2
        for (int g = tid; g < FFTN / 8; g += 512) {
            const int j = (g & (q / 2 - 1)) * 2, i0 = (g >> (lq - 1)) * m + j;
            LAS f32x4* P0 = (LAS f32x4*)(X + fpad(i0)); LAS f32x4* P1 = (LAS f32x4*)(X + fpad(i0 + q)); LAS f32x4* P2 = (LAS f32x4*)(X + fpad(i0 + 2 * q)); LAS f32x4* P3 = (LAS f32x4*)(X + fpad(i0 + 3 * q));
            const f32x4 x0 = *P0, x1 = *P1, x2 = *P2, x3 = *P3;
            const f32x2 w1a = TL[j * ts], w1b = TL[(j + 1) * ts];
            const f32x4 w1 = __builtin_shufflevector(w1a, w1b, 0, 1, 2, 3), w1s = cswn(w1), w2 = cmul4(w1, w1, w1s), w2s = cswn(w2);
            const f32x4 a0 = x0 + x2, d02 = x0 - x2, a1 = x1 + x3, t = x1 - x3;
            f32x4 tr = __builtin_shufflevector(t, t, 1, 0, 3, 2); tr.y = -tr.y; tr.w = -tr.w;
            const f32x4 a2 = cmul4(d02, w1, w1s), a3 = cmul4(tr, w1, w1s);
            const f32x4 o0 = a0 + a1, o1 = cmul4(a0 - a1, w2, w2s), o2 = a2 + a3, o3 = cmul4(a2 - a3, w2, w2s);
            *P0 = o0; *P1 = o1; *P2 = o2; *P3 = o3;
        }
        __syncthreads();
    }
    fft_r16_pass<false, 4096>(X, TL, tid);
    fft_r16_pass<false, 256>(X, TL, tid);
#pragma unroll 2
    for (int blk = tid; blk < FFTN / 16; blk += 512) { LAS f32x4* p = (LAS f32x4*)(X + blk * 18); f32x2 x[16];
#pragma unroll
        for (int i = 0; i < 8; ++i) { const f32x4 v = p[i]; x[2 * i].x = v[0]; x[2 * i].y = v[1]; x[2 * i + 1].x = v[2]; x[2 * i + 1].y = v[3]; }
        fft16_dif(x);
#pragma unroll
        for (int i = 0; i < 8; ++i) { f32x4 v; v[0] = x[2 * i].x; v[1] = x[2 * i].y; v[2] = x[2 * i + 1].x; v[3] = x[2 * i + 1].y; p[i] = v; } }
    __syncthreads();
}
__device__ __forceinline__ void fft_inv(LAS f32x2* X, const GAS f32x2* TL, int tid) {
#pragma unroll 2
    for (int blk = tid; blk < FFTN / 16; blk += 512) { LAS f32x4* p = (LAS f32x4*)(X + blk * 18); f32x2 x[16];
#pragma unroll
        for (int i = 0; i < 8; ++i) { const f32x4 v = p[i]; x[2 * i].x = v[0]; x[2 * i].y = v[1]; x[2 * i + 1].x = v[2]; x[2 * i + 1].y = v[3]; }
        fft16_dit_inv(x);
#pragma unroll
        for (int i = 0; i < 8; ++i) { f32x4 v; v[0] = x[2 * i].x; v[1] = x[2 * i].y; v[2] = x[2 * i + 1].x; v[3] = x[2 * i + 1].y; p[i] = v; } }
    __syncthreads();
    fft_r16_pass<true, 256>(X, TL, tid);
    fft_r16_pass<true, 4096>(X, TL, tid);
    { const int m = FFTN / 2;
        const int hm = m >> 1, lh = 31 - __builtin_clz(hm), ts1 = FFTN / m, ts2 = FFTN / (2 * m);
#pragma unroll 2
        for (int g = tid; g < FFTN / 8; g += 512) {
            const int j = (g & (hm / 2 - 1)) * 2, i0 = (g >> (lh - 1)) * 2 * m + j;
            LAS f32x4* P0 = (LAS f32x4*)(X + fpad(i0)); LAS f32x4* P1 = (LAS f32x4*)(X + fpad(i0 + hm)); LAS f32x4* P2 = (LAS f32x4*)(X + fpad(i0 + m)); LAS f32x4* P3 = (LAS f32x4*)(X + fpad(i0 + m + hm));
            const f32x4 x0 = *P0, x1 = *P1, x2 = *P2, x3 = *P3;
            const f32x2 w2a = TL[j * ts2], w2b = TL[(j + 1) * ts2];
            f32x4 w2 = __builtin_shufflevector(w2a, w2b, 0, 1, 2, 3); w2.y = -w2.y; w2.w = -w2.w;
            const f32x4 w2s = cswn(w2), w = cmul4(w2, w2, w2s), ws = cswn(w);
            const f32x4 t1 = cmul4(x1, w, ws), t3 = cmul4(x3, w, ws);
            const f32x4 a0 = x0 + t1, a1 = x0 - t1, a2 = x2 + t3, a3 = x2 - t3;
            const f32x4 u2 = cmul4(a2, w2, w2s), u3 = cmul4(a3, w2, w2s);
            f32x4 iu3 = __builtin_shufflevector(u3, u3, 1, 0, 3, 2); iu3.x = -iu3.x; iu3.z = -iu3.z;
            const f32x4 o0 = a0 + u2, o1 = a1 + iu3, o2 = a0 - u2, o3 = a1 - iu3;
            *P0 = o0; *P1 = o1; *P2 = o2; *P3 = o3;
        }
        __syncthreads();
    }
}
__device__ __forceinline__ void fft_table(LAS f32x2* TL, const GAS f32x2* TW, int tid) { if (tid < 320) TL[tid] = tid < 64 ? TW[tid] : TW[(tid - 64) * 64]; }
__device__ __forceinline__ int brev14(int p) { return (int)(__builtin_bitreverse32((unsigned)p) >> 18); }

__device__ __forceinline__ void kspec_item(const Fr& F, const unsigned char* ws, int c) {
    LAS f32x2* X = (LAS f32x2*)F.L; LAS float* red = (LAS float*)(F.L + LDS_TAB);
    const GAS float* HP = (const GAS float*)(ws + WS_HPART); const GAS float* FILT = (const GAS float*)(ws + WS_FILT); const GAS f32x2* TW = (const GAS f32x2*)(ws + WS_TW);
    const int tid = F.tid; const GAS f32x2* TL = TW;
    if (tid < 256) { const float v0 = wave_sum(HP[((size_t)tid * 2 + 0) * 512 + c]), v1 = wave_sum(HP[((size_t)tid * 2 + 1) * 512 + c]); if (F.lane == 0) { red[F.wave * 2] = v0; red[F.wave * 2 + 1] = v1; } }
    __syncthreads();
    const float inv0 = 1.f / (((red[0] + red[2]) + red[4]) + red[6]), inv1 = 1.f / (((red[1] + red[3]) + red[5]) + red[7]);
    const GAS float* f0 = FILT + ((size_t)0 * 512 + c) * 8192; const GAS float* b0 = FILT + ((size_t)1 * 512 + c) * 8192; const GAS float* f1 = FILT + ((size_t)2 * 512 + c) * 8192; const GAS float* b1 = FILT + ((size_t)3 * 512 + c) * 8192;
    for (int s = tid; s < 8192; s += 512) { f32x2 v; v.x = f0[s] * inv0; v.y = f1[s] * inv1; X[fpad(s)] = v;
        f32x2 w; if (s == 0) { w.x = 0.f; w.y = 0.f; } else { w.x = b0[8192 - s] * inv0; w.y = b1[8192 - s] * inv1; } X[fpad(8192 + s)] = w; }
    __syncthreads();
    fft_fwd(X, TL, tid);
    GAS f32x2* K0 = (GAS f32x2*)(ws + WS_K0S) + (size_t)c * FFTN; GAS f32x2* K1 = (GAS f32x2*)(ws + WS_K1S) + (size_t)c * FFTN;
    const float sc = 0.5f / (float)FFTN;
    for (int p = tid; p < FFTN; p += 512) { const int f = brev14(p), p2 = brev14((FFTN - f) & (FFTN - 1)); const f32x2 A = X[fpad(p)], B = X[fpad(p2)];
        f32x2 k0, k1; k0.x = (A.x + B.x) * sc; k0.y = (A.y - B.y) * sc; k1.x = (A.y + B.y) * sc; k1.y = (B.x - A.x) * sc; K0[p] = k0; K1[p] = k1; }
    __syncthreads();
}

__device__ __forceinline__ void hyconv_item(const Fr& F, const Args& a, const unsigned char* ws, int l, int c) {
    LAS f32x2* X = (LAS f32x2*)F.L; const GAS f32x2* TW = (const GAS f32x2*)(ws + WS_TW); const int tid = F.tid;
    const GAS bf16* vT = (const GAS bf16*)(ws + WS_HYT) + (size_t)c * NLAT; const GAS bf16* x1T = vT + (size_t)512 * NLAT; const GAS bf16* x2T = vT + (size_t)1024 * NLAT;
    const GAS f32x2* K0 = (const GAS f32x2*)(ws + WS_K0S) + (size_t)c * FFTN; const GAS f32x2* K1 = (const GAS f32x2*)(ws + WS_K1S) + (size_t)c * FFTN;
    const float bias0 = INP(a, I_HBIAS)[(size_t)l * 1024 + c], bias1 = INP(a, I_HBIAS)[(size_t)l * 1024 + 512 + c];
    f32x2 zero; zero.x = 0.f; zero.y = 0.f; const GAS f32x2* TL = TW;
#pragma unroll
    for (int i = 0; i < 16; ++i) { const int s = tid + 512 * i; f32x2 v; v.x = bf2f(vT[s]); v.y = bf2f(vT[8192 + s]); X[fpad(s)] = v; X[fpad(8192 + s)] = zero; }
    __syncthreads();
    fft_fwd(X, TL, tid);
    for (int p = tid; p < FFTN; p += 512) X[fpad(p)] = cmul(X[fpad(p)], K0[p]);
    __syncthreads();
    fft_inv(X, TL, tid);
    float z0[16], z1[16];
#pragma unroll
    for (int i = 0; i < 16; ++i) { const int s = tid + 512 * i; const f32x2 y = X[fpad(s)];
        z0[i] = bf2f(x1T[s]) * (y.x + bias0 * bf2f(vT[s])); z1[i] = bf2f(x1T[8192 + s]) * (y.y + bias0 * bf2f(vT[8192 + s]));
        f32x2 v; v.x = z0[i]; v.y = z1[i]; X[fpad(s)] = v; X[fpad(8192 + s)] = zero; }
    __syncthreads();
    fft_fwd(X, TL, tid);
    for (int p = tid; p < FFTN; p += 512) X[fpad(p)] = cmul(X[fpad(p)], K1[p]);
    __syncthreads();
    fft_inv(X, TL, tid);
    GAS bf16* o = (GAS bf16*)(ws + WS_OHYT) + (size_t)c * NLAT;
#pragma unroll
    for (int i = 0; i < 16; ++i) { const int s = tid + 512 * i; const f32x2 y = X[fpad(s)];
        o[s] = (bf16)f2bf(bf2f(x2T[s]) * (y.x + bias1 * z0[i])); o[8192 + s] = (bf16)f2bf(bf2f(x2T[8192 + s]) * (y.y + bias1 * z1[i])); }
    __syncthreads();
}

__device__ __forceinline__ void hyctx_item(const Fr& F, const Args& a, const unsigned char* ws, int l, int c) {
    LAS float* fl = (LAS float*)F.L;
    LAS float* vv = fl + 1024;
    LAS float* zz = vv + 512;
    LAS float* red = zz + 512;
    const float* HP = (const float*)(ws + WS_HPARTC); const float* FC = (const float*)(ws + WS_FILTC); const int tid = F.tid;
    if (tid < 16) red[tid] = HP[((size_t)(tid >> 1) * 2 + (tid & 1)) * 512 + c];
    __syncthreads();
    float s0 = 0.f, s1 = 0.f;
#pragma unroll
    for (int k = 0; k < 8; ++k) { s0 += red[2 * k]; s1 += red[2 * k + 1]; }
    const float inv0 = 1.f / s0, inv1 = 1.f / s1;
    const bf16* T = (const bf16*)(ws + WS_HYTC);
    for (int i = tid; i < 1024; i += 512) { const int q = i >> 8, s = i & 255; fl[i] = FC[((size_t)q * 512 + c) * 256 + s] * (q < 2 ? inv0 : inv1); }
    const int b = tid >> 8, t = tid & 255;
    const float v = bf2f(T[((size_t)c * 2 + b) * 256 + t]), x1 = bf2f(T[((size_t)(512 + c) * 2 + b) * 256 + t]), x2 = bf2f(T[((size_t)(1024 + c) * 2 + b) * 256 + t]);
    vv[tid] = v;
    __syncthreads();
    const float bias0 = INP(a, I_HBIAS)[(size_t)l * 1024 + c], bias1 = INP(a, I_HBIAS)[(size_t)l * 1024 + 512 + c];
    float y = 0.f;
    for (int s = 0; s <= t; ++s) y += fl[t - s] * vv[b * 256 + s];
    for (int s = t + 1; s < 256; ++s) y += fl[256 + s - t] * vv[b * 256 + s];
    const float z = x1 * (y + bias0 * v);
    zz[tid] = z;
    __syncthreads();
    float y2 = 0.f;
    for (int s = 0; s <= t; ++s) y2 += fl[512 + t - s] * zz[b * 256 + s];
    for (int s = t + 1; s < 256; ++s) y2 += fl[768 + s - t] * zz[b * 256 + s];
    bf16* OBR2 = (bf16*)(ws + WS_OBR) + (size_t)2 * MALL * 512;
    OBR2[(size_t)(NLAT + b * 256 + t) * 512 + c] = (bf16)f2bf(x2 * (y2 + bias1 * z));
    __syncthreads();
}

__device__ __forceinline__ void conv3_item(const Fr& F, const Args& a, const GAS bf16* Prows  , int Ls, GAS bf16* HT  , int l, int t0, int c0) {
    LAS float* T = (LAS float*)F.L;
    const int tid = F.tid;
    for (int idx = tid; idx < 130 * 8; idx += 512) { const int r = idx >> 3, c8 = (idx & 7) * 8; const int t = t0 - 1 + r;
        v4u v = (v4u){0u, 0u, 0u, 0u}; if (t >= 0 && t < Ls) v = *(const GAS v4u*)(Prows + (size_t)t * INPAD + O_HY + c0 + c8);
        LAS float* d = T + r * 65 + c8; d[0] = bflo(v.x); d[1] = bfhi(v.x); d[2] = bflo(v.y); d[3] = bfhi(v.y); d[4] = bflo(v.z); d[5] = bfhi(v.z); d[6] = bflo(v.w); d[7] = bfhi(v.w); }
    __syncthreads();
    const int cc = tid >> 3, tq = tid & 7; const int c3 = c0 + cc;
    const GAS float* cw = (const GAS float*)INP(a, I_HCW) + (size_t)l * 3 * 1536; const float w0 = cw[c3], w1 = cw[1536 + c3], w2 = cw[3072 + c3], bb = ((const GAS float*)INP(a, I_HCB))[(size_t)l * 1536 + c3];
#pragma unroll
    for (int hh = 0; hh < 2; ++hh) { float y[8];
#pragma unroll
        for (int j = 0; j < 8; ++j) { const int t = hh * 64 + tq * 8 + j; y[j] = T[t * 65 + cc] * w0 + T[(t + 1) * 65 + cc] * w1 + T[(t + 2) * 65 + cc] * w2 + bb; }
        v4u o; o.x = pk2(y[0], y[1]); o.y = pk2(y[2], y[3]); o.z = pk2(y[4], y[5]); o.w = pk2(y[6], y[7]);
        *(GAS v4u*)(HT + (size_t)c3 * (2 * Ls) + t0 + hh * 64 + tq * 8) = o; }
    __syncthreads();
}

__device__ __forceinline__ void post_row(const Fr& F, const Args& a, unsigned char* ws, int l, int row, const LAS float* wa  ) {
    const int lane = F.lane; const bf16* pr = (const bf16*)(ws + WS_P) + (size_t)row * INPAD;
    { float v[6]; float ss = 0.f;
#pragma unroll
      for (int j = 0; j < 3; ++j) { const unsigned w = *(const unsigned*)(pr + O_MQA + 2 * lane + 128 * j); v[2 * j] = bflo(w); v[2 * j + 1] = bfhi(w); ss += v[2 * j] * v[2 * j] + v[2 * j + 1] * v[2 * j + 1]; }
      const float r = 1.f / sqrtf(wave_sum(ss) * (1.f / 384.f) + RMS_EPS); bf16* o = (bf16*)(ws + WS_NQ) + (size_t)row * 384;
#pragma unroll
      for (int j = 0; j < 3; ++j) *(unsigned*)(o + 2 * lane + 128 * j) = pk2(v[2 * j] * r, v[2 * j + 1] * r); }
    { float v[4]; float ss = 0.f;
#pragma unroll
      for (int j = 0; j < 2; ++j) { const unsigned w = *(const unsigned*)(pr + O_MKVA + 2 * lane + 128 * j); v[2 * j] = bflo(w); v[2 * j + 1] = bfhi(w); ss += v[2 * j] * v[2 * j] + v[2 * j + 1] * v[2 * j + 1]; }
      const float r = 1.f / sqrtf(wave_sum(ss) * (1.f / 256.f) + RMS_EPS); bf16* o = (bf16*)(ws + WS_NKV) + (size_t)row * 256;
#pragma unroll
      for (int j = 0; j < 2; ++j) *(unsigned*)(o + 2 * lane + 128 * j) = pk2(v[2 * j] * r, v[2 * j + 1] * r); }
    { const float pa = bf2f(pr[O_GAF + (lane & 31)]);
      const float* baf = INP(a, I_BAF) + l * 256; const float* bab = INP(a, I_BAB) + l * 256;
      float xf[4], xb[4];
#pragma unroll
      for (int j = 0; j < 4; ++j) { xf[j] = baf[lane + 64 * j]; xb[j] = bab[lane + 64 * j]; }
#pragma unroll
      for (int r = 0; r < 16; ++r) { const float pf = __shfl(pa, r), pb = __shfl(pa, 16 + r);
#pragma unroll
          for (int j = 0; j < 4; ++j) { xf[j] += pf * wa[r * 256 + lane + 64 * j]; xb[j] += pb * wa[4096 + r * 256 + lane + 64 * j]; } }
      float* AFp = (float*)(ws + WS_AF) + (size_t)row * 256; float* ABp = (float*)(ws + WS_AB) + (size_t)row * 256;
#pragma unroll
      for (int j = 0; j < 4; ++j) {
          const float lf = fminf(xf[j], 0.f) - __logf(1.f + __expf(-fabsf(xf[j]))), lb = fminf(xb[j], 0.f) - __logf(1.f + __expf(-fabsf(xb[j])));
          AFp[lane + 64 * j] = lf * (1.f / 16.f); ABp[lane + 64 * j] = lb * (1.f / 16.f); } }
    if (lane < 16) { float x1 = bf2f(pr[O_MKR + lane]), x2 = bf2f(pr[O_MKR + 16 + lane]); int b, key;
        if (row < NLAT) { const int t = row & 8191; b = row >> 13; key = CTXL + t; const float* cs = (const float*)(ws + WS_ROPE) + ((size_t)t * 16 + lane) * 2; const float cc = cs[0], sn = cs[1];
            const float o1 = x1 * cc - x2 * sn, o2 = x2 * cc + x1 * sn; x1 = o1; x2 = o2; }
        else { const int r2 = row - NLAT; b = r2 >> 8; key = r2 & 255; }
        const bf16 h1 = (bf16)f2bf(x1), h2 = (bf16)f2bf(x2); bf16* kb = (bf16*)(ws + WS_KB) + ((size_t)(b * 8) * KEYS + key) * 96 + 64 + lane;
#pragma unroll
        for (int h = 0; h < 8; ++h) { kb[(size_t)h * KEYS * 96] = h1; kb[(size_t)h * KEYS * 96 + 16] = h2; } }
}

__device__ __forceinline__ float max3f(float a, float b, float c) { float r; asm("v_max3_f32 %0, %1, %2, %3" : "=v"(r) : "v"(a), "v"(b), "v"(c)); return r; }
__device__ __forceinline__ int kap(int r) { return (r & 0x13) | ((r & 4) << 1) | ((r & 8) >> 1); }
__device__ __forceinline__ unsigned pkbf2(float lo, float hi) { unsigned r; asm volatile("v_cvt_pk_bf16_f32 %0, %1, %2" : "=v"(r) : "v"(lo), "v"(hi)); return r; }
__device__ __forceinline__ void attn_unit(const int VAR, const Fr& F, const GAS bf16* QB, const GAS bf16* KBh, const GAS bf16* VTh, GAS bf16* O, int qrow0, int head, int ntiles, const GAS float* rope) {
    constexpr int KROW = 208, VROW = 144, KBYTES = 64 * KROW, BUF = KBYTES + 64 * VROW;
    const int tid = F.tid, lane = F.lane, wave = F.wave, r = lane & 31, hh = lane >> 5;
    LAS unsigned char* L = F.L;
    bf16x8 qf[6];
    { const GAS bf16* qp = QB + (size_t)(qrow0 + wave * 32 + r) * 768 + head * 96 + 8 * hh;
#pragma unroll
      for (int ks = 0; ks < 6; ++ks) qf[ks] = *(const GAS bf16x8*)(qp + 16 * ks);
      if (qrow0 < NLAT) {
          const GAS float* cs = rope + ((size_t)((qrow0 + wave * 32 + r) & 8191) * 16 + 8 * hh) * 2;
          v4u a = __builtin_bit_cast(v4u, qf[4]), b = __builtin_bit_cast(v4u, qf[5]);
#pragma unroll
          for (int i = 0; i < 4; ++i) { const f32x4 c4 = *(const GAS f32x4*)(cs + 4 * i);
              const float x1l = bflo(a[i]), x1h = bfhi(a[i]), x2l = bflo(b[i]), x2h = bfhi(b[i]);
              a[i] = pk2(x1l * c4[0] - x2l * c4[1], x1h * c4[2] - x2h * c4[3]); b[i] = pk2(x2l * c4[0] + x1l * c4[1], x2h * c4[2] + x1h * c4[3]); }
          qf[4] = __builtin_bit_cast(bf16x8, a); qf[5] = __builtin_bit_cast(bf16x8, b); } }
    const int kq0 = tid, kq1 = 512 + tid;
    const int kl0 = (kq0 / 12) * KROW + (kq0 % 12) * 16, kl1 = (kq1 / 12) * KROW + (kq1 % 12) * 16;
    const int vrow = tid >> 3, vch = tid & 7; const int vl = KBYTES + vrow * VROW + vch * 16;
    const GAS bf16* vsrc = VTh + (size_t)vrow * KEYS + vch * 8;
    v4u k0r, k1r, vr; k1r = (v4u){0u, 0u, 0u, 0u};
#define AT_LOAD(K0_, K1_, V_, t_) do { if (VAR == 4) break; const GAS unsigned char* kt_ = (const GAS unsigned char*)KBh + (size_t)(t_) * (64 * 192); K0_ = *(const GAS v4u*)(kt_ + (size_t)kq0 * 16); if (tid < 256) K1_ = *(const GAS v4u*)(kt_ + (size_t)kq1 * 16); \
        V_ = *(const GAS v4u*)(vsrc + (size_t)(t_) * 64); } while (0)
#define AT_WRITE(K0_, K1_, V_, bo_) do { if (VAR == 4) break; LAS unsigned char* Bn_ = L + (bo_); *(LAS v4u*)(Bn_ + kl0) = K0_; if (tid < 256) *(LAS v4u*)(Bn_ + kl1) = K1_; *(LAS v4u*)(Bn_ + vl) = V_; } while (0)
#define AT_SOFT(S_, PB_, RS_, MX_) do { f32x2 pp_[8]; \
        _Pragma("unroll") for (int i_ = 0; i_ < 8; ++i_) { pp_[i_].x = __builtin_amdgcn_exp2f(S_[2 * i_]); pp_[i_].y = __builtin_amdgcn_exp2f(S_[2 * i_ + 1]); } \
        _Pragma("unroll") for (int s2_ = 0; s2_ < 2; ++s2_) { v4u w_; w_.x = pkbf2(pp_[4 * s2_].x, pp_[4 * s2_].y); w_.y = pkbf2(pp_[4 * s2_ + 1].x, pp_[4 * s2_ + 1].y); w_.z = pkbf2(pp_[4 * s2_ + 2].x, pp_[4 * s2_ + 2].y); w_.w = pkbf2(pp_[4 * s2_ + 3].x, pp_[4 * s2_ + 3].y); \
            PB_[s2_] = __builtin_bit_cast(bf16x8, w_); } \
        MX_ = 0.f; \
        pp_[0] += pp_[4]; pp_[1] += pp_[5]; pp_[2] += pp_[6]; pp_[3] += pp_[7]; pp_[0] += pp_[2]; pp_[1] += pp_[3]; RS_ = pp_[0] + pp_[1]; } while (0)
#define AT_TILE(bo_) do { const LAS unsigned char* B_ = L + (bo_); bf16x8 ka_[12], va_[8], pb0_[2], pb1_[2]; f32x2 rs0_, rs1_; float mx0_, mx1_; \
        _Pragma("unroll") for (int ks_ = 0; ks_ < 6; ++ks_) { ka_[2 * ks_] = *(const LAS bf16x8*)(B_ + koff + ks_ * 32); ka_[2 * ks_ + 1] = *(const LAS bf16x8*)(B_ + koff + 32 * KROW + ks_ * 32); } \
        _Pragma("unroll") for (int kb_ = 0; kb_ < 2; ++kb_) _Pragma("unroll") for (int s2_ = 0; s2_ < 2; ++s2_) { \
            va_[(kb_ * 2 + s2_) * 2] = *(const LAS bf16x8*)(B_ + voff + (32 * kb_ + 16 * s2_) * 2); va_[(kb_ * 2 + s2_) * 2 + 1] = *(const LAS bf16x8*)(B_ + voff + 32 * VROW + (32 * kb_ + 16 * s2_) * 2); } \
        asm volatile("s_waitcnt lgkmcnt(8)" ::: "memory"); __builtin_amdgcn_sched_barrier(0); \
        _Pragma("unroll") for (int ks_ = 0; ks_ < 6; ++ks_) sA0 = __builtin_amdgcn_mfma_f32_32x32x16_bf16(ka_[2 * ks_], qf[ks_], sA0, 0, 0, 0); \
        __builtin_amdgcn_sched_barrier(0); \
        _Pragma("unroll") for (int ks_ = 0; ks_ < 6; ++ks_) sA1 = __builtin_amdgcn_mfma_f32_32x32x16_bf16(ka_[2 * ks_ + 1], qf[ks_], sA1, 0, 0, 0); \
        AT_SOFT(sA0, pb0_, rs0_, mx0_); \
        _Pragma("unroll") for (int g_ = 0; g_ < 6; ++g_) { __builtin_amdgcn_sched_group_barrier(0x008, 1, 0); __builtin_amdgcn_sched_group_barrier(0x402, 10, 0); } \
        asm volatile("s_waitcnt lgkmcnt(0)" ::: "memory"); __builtin_amdgcn_sched_barrier(0); \
        _Pragma("unroll") for (int s2_ = 0; s2_ < 2; ++s2_) { o0 = __builtin_amdgcn_mfma_f32_32x32x16_bf16(va_[s2_ * 2], pb0_[s2_], o0, 0, 0, 0); o1 = __builtin_amdgcn_mfma_f32_32x32x16_bf16(va_[s2_ * 2 + 1], pb0_[s2_], o1, 0, 0, 0); } \
        AT_SOFT(sA1, pb1_, rs1_, mx1_); \
        _Pragma("unroll") for (int g_ = 0; g_ < 4; ++g_) { __builtin_amdgcn_sched_group_barrier(0x008, 1, 0); __builtin_amdgcn_sched_group_barrier(0x402, 14, 0); } \
        __builtin_amdgcn_sched_barrier(0); \
        _Pragma("unroll") for (int s2_ = 0; s2_ < 2; ++s2_) { o0 = __builtin_amdgcn_mfma_f32_32x32x16_bf16(va_[4 + s2_ * 2], pb1_[s2_], o0, 0, 0, 0); o1 = __builtin_amdgcn_mfma_f32_32x32x16_bf16(va_[4 + s2_ * 2 + 1], pb1_[s2_], o1, 0, 0, 0); } \
        float pm_; { const f32x2 rs_ = rs0_ + rs1_; const float rsum_ = rs_.x + rs_.y; l_run += rsum_; pm_ = rsum_ + __shfl_xor(rsum_, 32); (void)mx0_; (void)mx1_; \
          const float nm_ = -m_run; _Pragma("unroll") for (int i_ = 0; i_ < 16; ++i_) { sA0[i_] = nm_; sA1[i_] = nm_; } }        \
        _Pragma("unroll") for (int g_ = 0; g_ < 4; ++g_) { __builtin_amdgcn_sched_group_barrier(0x008, 1, 0); __builtin_amdgcn_sched_group_barrier(0x402, 10, 0); } \
        __builtin_amdgcn_sched_barrier(0); \
        if (__any(pm_ > 2048.f)) { const float dl_ = fmaxf(__builtin_amdgcn_logf(pm_) - 5.f, 0.f), al_ = __builtin_amdgcn_exp2f(-dl_); m_run += dl_; l_run *= al_; const float nm_ = -m_run; \
            _Pragma("unroll") for (int i_ = 0; i_ < 16; ++i_) { o0[i_] *= al_; o1[i_] *= al_; sA0[i_] = nm_; sA1[i_] = nm_; } } \
        __builtin_amdgcn_sched_barrier(0); } while (0)
#define AT_QK0(S0_, S1_, bo_) do { const LAS unsigned char* B_ = L + (bo_); _Pragma("unroll") for (int i_ = 0; i_ < 16; ++i_) { S0_[i_] = 0.f; S1_[i_] = 0.f; } \
        _Pragma("unroll") for (int ks_ = 0; ks_ < 6; ++ks_) { const bf16x8 a0_ = *(const LAS bf16x8*)(B_ + koff + ks_ * 32), a1_ = *(const LAS bf16x8*)(B_ + koff + 32 * KROW + ks_ * 32); \
            S0_ = __builtin_amdgcn_mfma_f32_32x32x16_bf16(a0_, qf[ks_], S0_, 0, 0, 0); S1_ = __builtin_amdgcn_mfma_f32_32x32x16_bf16(a1_, qf[ks_], S1_, 0, 0, 0); } } while (0)
    f32x16 o0, o1, sA0, sA1;
    const bool late = wave >= 4;
#pragma unroll
    for (int i = 0; i < 16; ++i) { o0[i] = 0.f; o1[i] = 0.f; }
    float m_run = -100.f, l_run = 0.f;
    const int koff = kap(r) * KROW + 16 * hh, voff = KBYTES + r * VROW + 16 * hh;
    v4u k0y, k1y, vy; k1y = (v4u){0u, 0u, 0u, 0u};
    AT_LOAD(k0r, k1r, vr, 0); AT_WRITE(k0r, k1r, vr, 0); AT_LOAD(k0r, k1r, vr, 1); AT_WRITE(k0r, k1r, vr, BUF);
    if (ntiles > 2) { AT_LOAD(k0r, k1r, vr, 2); AT_LOAD(k0y, k1y, vy, 3); }
    __syncthreads();
    AT_QK0(sA0, sA1, 0);
    { float mx = fmaxf(sA0[0], sA1[0]);
#pragma unroll
      for (int i = 1; i < 16; ++i) mx = fmaxf(mx, fmaxf(sA0[i], sA1[i]));
      m_run = fmaxf(mx, __shfl_xor(mx, 32)); }
    { const float nm = -m_run;
#pragma unroll
      for (int i = 0; i < 16; ++i) { sA0[i] = nm; sA1[i] = nm; } }
    int B0 = 0, B1 = 2 * BUF;
    for (int t = 0; t < ntiles; t += 2) {
        AT_TILE(B0);
        if (t + 2 < ntiles) AT_WRITE(k0r, k1r, vr, B1);
        if (t + 4 < ntiles) AT_LOAD(k0r, k1r, vr, t + 4);
        AT_TILE(B0 + BUF);
        if (t + 3 < ntiles) AT_WRITE(k0y, k1y, vy, B1 + BUF);
        if (t + 5 < ntiles) AT_LOAD(k0y, k1y, vy, t + 5);
        __syncthreads();
        { const int n0 = B1; B1 = B0; B0 = n0; }
    }
#undef AT_LOAD
#undef AT_WRITE
#undef AT_TILE
#undef AT_SOFT
#undef AT_QK0
    const float inv = 1.f / (l_run + __shfl_xor(l_run, 32));
    GAS bf16* op = O + (size_t)(qrow0 + wave * 32 + r) * 512 + head * 64 + 4 * hh;
#pragma unroll
    for (int g = 0; g < 4; ++g) { v2u w; w.x = pk2(o0[4 * g] * inv, o0[4 * g + 1] * inv); w.y = pk2(o0[4 * g + 2] * inv, o0[4 * g + 3] * inv); *(GAS v2u*)(op + 8 * g) = w;
        v2u w2; w2.x = pk2(o1[4 * g] * inv, o1[4 * g + 1] * inv); w2.y = pk2(o1[4 * g + 2] * inv, o1[4 * g + 3] * inv); *(GAS v2u*)(op + 32 + 8 * g) = w2; }
}


constexpr int GR = 72;
__device__ __forceinline__ int gla_mb(int c) { return c < 4 ? 3 - c : 4 + (131 - c); }
__device__ __forceinline__ int gla_row0(int b, int c) { return c < 4 ? NLAT + b * CTXL + 64 * c : b * SEQ + 64 * (c - 4); }
constexpr int GL_BF = 0, GL_BB = GL_BF + 64 * 65 * 4, GL_A0 = GL_BB + 64 * 65 * 4;
__device__ __forceinline__ void gla_cumsum(const Fr& F, const unsigned char* ws, int row0, int h) {
    LAS float* BF = (LAS float*)(F.L + GL_BF); LAS float* BB = (LAS float*)(F.L + GL_BB); const int tid = F.tid;
    { const int t = tid >> 3, d8 = (tid & 7) * 8; const GAS float* gf = (const GAS float*)(ws + WS_AF) + (size_t)(row0 + t) * 256 + h * 64 + d8; const GAS float* gb = (const GAS float*)(ws + WS_AB) + (size_t)(row0 + t) * 256 + h * 64 + d8;
      const f32x4 f0 = *(const f32x4*)gf, f1 = *(const GAS f32x4*)(gf + 4), b0 = *(const f32x4*)gb, b1 = *(const GAS f32x4*)(gb + 4);
#pragma unroll
      for (int i = 0; i < 4; ++i) { BF[t * 65 + d8 + i] = f0[i]; BF[t * 65 + d8 + 4 + i] = f1[i]; BB[t * 65 + d8 + i] = b0[i]; BB[t * 65 + d8 + 4 + i] = b1[i]; } }
    __syncthreads();
    if (tid < 64) { float s = 0.f;
#pragma unroll 8
        for (int t = 0; t < 64; ++t) { s += BF[t * 65 + tid]; BF[t * 65 + tid] = s; } }
    else if (tid < 128) { const int d = tid - 64; float s = 0.f;
#pragma unroll 8
        for (int t = 63; t >= 0; --t) { s += BB[t * 65 + d]; BB[t * 65 + d] = s; } }
    __syncthreads();
}

__device__ __forceinline__ void gla_a_item(const Fr& F, unsigned char* ws, int item) {
    const int c = item % 132, bh = item / 132, h = bh & 3, b = bh >> 2; const int row0 = gla_row0(b, c); const int tid = F.tid, lane = F.lane, wave = F.wave;
    gla_cumsum(F, ws, row0, h);
    LAS float* BF = (LAS float*)(F.L + GL_BF); LAS float* BB = (LAS float*)(F.L + GL_BB);
    LAS bf16* KTF = (LAS bf16*)(F.L + GL_A0);
    LAS bf16* KTB = KTF + 64 * GR;
    LAS bf16* VT = KTB + 64 * GR;
    const GAS bf16* P = (const GAS bf16*)(ws + WS_P);
    { const int t = tid >> 3, d8 = (tid & 7) * 8; const v4u kr = *(const GAS v4u*)(P + (size_t)(row0 + t) * INPAD + O_GK + h * 64 + d8);
#pragma unroll
      for (int i = 0; i < 8; ++i) { const int d = d8 + i; const float k = (i & 1) ? bfhi(kr[i >> 1]) : bflo(kr[i >> 1]);
          KTF[d * GR + t] = (bf16)f2bf(k * __expf(BF[63 * 65 + d] - BF[t * 65 + d])); KTB[d * GR + t] = (bf16)f2bf(k * __expf(BB[d] - BB[t * 65 + d])); }
#pragma unroll
      for (int q = 0; q < 2; ++q) { const int e8 = ((tid & 7) + 8 * q) * 8; const v4u vr = *(const GAS v4u*)(P + (size_t)(row0 + t) * INPAD + O_GV + h * 128 + e8);
#pragma unroll
          for (int i = 0; i < 8; ++i) VT[(e8 + i) * GR + t] = (bf16)((i & 1) ? (vr[i >> 1] >> 16) : (vr[i >> 1] & 0xffffu)); } }
    __syncthreads();
    const int r = lane & 31, hh = lane >> 5, eb = wave & 3, db = wave >> 2;
#pragma unroll
    for (int dir = 0; dir < 2; ++dir) { const LAS bf16* KT = dir ? KTB : KTF; f32x16 acc;
#pragma unroll
        for (int i = 0; i < 16; ++i) acc[i] = 0.f;
#pragma unroll
        for (int s = 0; s < 4; ++s) { const bf16x8 av = *(const LAS bf16x8*)(VT + (32 * eb + r) * GR + 16 * s + 8 * hh), bk = *(const LAS bf16x8*)(KT + (32 * db + r) * GR + 16 * s + 8 * hh);
            acc = __builtin_amdgcn_mfma_f32_32x32x16_bf16(av, bk, acc, 0, 0, 0); }
        const int chain = bh * 2 + dir, m = dir ? gla_mb(c) : c; GAS float* dst = (GAS float*)(ws + WS_GST) + ((size_t)chain * 132 + m) * 8192;
#pragma unroll
        for (int g = 0; g < 16; ++g) { const int e = 32 * eb + (g & 3) + 8 * (g >> 2) + 4 * hh; dst[e * 64 + 32 * db + r] = acc[g]; }
        if (wave == 0 && dir == 0) ((GAS float*)(ws + WS_GDEC))[((size_t)chain * 132 + m) * 64 + lane] = __expf(BF[63 * 65 + lane]);
        if (wave == 1 && dir == 1) ((GAS float*)(ws + WS_GDEC))[((size_t)chain * 132 + m) * 64 + lane] = __expf(BB[lane]); }
    __syncthreads();
}

__device__ __forceinline__ void gla_scan_q(const Fr& F, unsigned char* ws, int item) {
    const int chain = item >> 4, part = item & 15; const int idx = part * 512 + F.tid;
    GAS float* st = (GAS float*)(ws + WS_GST) + (size_t)chain * 132 * 8192 + idx; const GAS float* dec = (const GAS float*)(ws + WS_GDEC) + (size_t)chain * 132 * 64 + (idx & 63);
    float s = 0.f; float dn[6], an[6];
#pragma unroll
    for (int k = 0; k < 6; ++k) { dn[k] = st[(size_t)k * 8192]; an[k] = dec[k * 64]; }
    for (int m = 0; m < 132; m += 6) {
        float d2[6], a2[6];
#pragma unroll
        for (int k = 0; k < 6; ++k) { d2[k] = dn[k]; a2[k] = an[k]; }
        if (m + 6 < 132) {
#pragma unroll
            for (int k = 0; k < 6; ++k) { dn[k] = st[(size_t)(m + 6 + k) * 8192]; an[k] = dec[(m + 6 + k) * 64]; } }
#pragma unroll
        for (int k = 0; k < 6; ++k) { st[(size_t)(m + k) * 8192] = s; s = a2[k] * s + d2[k]; }
    }
}

__device__ __forceinline__ void gla_c_item(const Fr& F, const Args& a, unsigned char* ws, int l, int item) {
    const int c = item % 132, bh = item / 132, h = bh & 3, b = bh >> 2; const int row0 = gla_row0(b, c); const int tid = F.tid, lane = F.lane, wave = F.wave;
    gla_cumsum(F, ws, row0, h);
    LAS float* BF = (LAS float*)(F.L + GL_BF); LAS float* BB = (LAS float*)(F.L + GL_BB);
    LAS bf16* QF = (LAS bf16*)(F.L + GL_A0);
    LAS bf16* KF = QF + 64 * GR;
    LAS bf16* QBk = KF + 64 * GR;
    LAS bf16* KBk = QBk + 64 * GR;
    LAS bf16* VT = KBk + 64 * GR;
    LAS bf16* SF = VT + 128 * GR;
    LAS bf16* SB = SF + 128 * GR;
    LAS float* red = (LAS float*)(SB + 128 * GR);
    const GAS bf16* P = (const GAS bf16*)(ws + WS_P);
    { const int t = tid >> 3, d8 = (tid & 7) * 8; const GAS bf16* pr = P + (size_t)(row0 + t) * INPAD; const v4u qr = *(const GAS v4u*)(pr + O_GQ + h * 64 + d8), kr = *(const GAS v4u*)(pr + O_GK + h * 64 + d8);
      v4u qf, kf, qb, kb;
#pragma unroll
      for (int i = 0; i < 4; ++i) { const float q0 = bflo(qr[i]) * 0.125f, q1 = bfhi(qr[i]) * 0.125f, k0 = bflo(kr[i]), k1 = bfhi(kr[i]);
          const float f0 = BF[t * 65 + d8 + 2 * i], f1 = BF[t * 65 + d8 + 2 * i + 1], g0 = BB[t * 65 + d8 + 2 * i], g1 = BB[t * 65 + d8 + 2 * i + 1];
          qf[i] = pk2(q0 * __expf(f0), q1 * __expf(f1)); kf[i] = pk2(k0 * __expf(-f0), k1 * __expf(-f1)); qb[i] = pk2(q0 * __expf(g0), q1 * __expf(g1)); kb[i] = pk2(k0 * __expf(-g0), k1 * __expf(-g1)); }
      *(LAS v4u*)(QF + t * GR + d8) = qf; *(LAS v4u*)(KF + t * GR + d8) = kf; *(LAS v4u*)(QBk + t * GR + d8) = qb; *(LAS v4u*)(KBk + t * GR + d8) = kb;
#pragma unroll
      for (int q = 0; q < 2; ++q) { const int e8 = ((tid & 7) + 8 * q) * 8; const v4u vr = *(const GAS v4u*)(pr + O_GV + h * 128 + e8);
#pragma unroll
          for (int i = 0; i < 8; ++i) VT[(e8 + i) * GR + t] = (bf16)((i & 1) ? (vr[i >> 1] >> 16) : (vr[i >> 1] & 0xffffu)); } }
    { const GAS float* sf = (const GAS float*)(ws + WS_GST) + ((size_t)(bh * 2) * 132 + c) * 8192; const GAS float* sb = (const GAS float*)(ws + WS_GST) + ((size_t)(bh * 2 + 1) * 132 + gla_mb(c)) * 8192;
#pragma unroll
      for (int q = 0; q < 2; ++q) { const int idx = (tid + 512 * q) * 8, e = idx >> 6, d = idx & 63;
          const f32x4 x0 = *(const GAS f32x4*)(sf + idx), x1 = *(const GAS f32x4*)(sf + idx + 4), y0 = *(const GAS f32x4*)(sb + idx), y1 = *(const GAS f32x4*)(sb + idx + 4);
          v4u w; w.x = pk2(x0[0], x0[1]); w.y = pk2(x0[2], x0[3]); w.z = pk2(x1[0], x1[1]); w.w = pk2(x1[2], x1[3]); *(LAS v4u*)(SF + e * GR + d) = w;
          v4u z; z.x = pk2(y0[0], y0[1]); z.y = pk2(y0[2], y0[3]); z.z = pk2(y1[0], y1[1]); z.w = pk2(y1[2], y1[3]); *(LAS v4u*)(SB + e * GR + d) = z; } }
    __syncthreads();
    const int r = lane & 31, hh = lane >> 5, eb = wave & 3, ib = wave >> 2;
    f32x16 O;
#pragma unroll
    for (int i = 0; i < 16; ++i) O[i] = 0.f;
#pragma unroll
    for (int dir = 0; dir < 2; ++dir) { const LAS bf16* Qd = dir ? QBk : QF; const LAS bf16* Kd = dir ? KBk : KF; const LAS bf16* Sd = dir ? SB : SF;
        bf16x8 qfr[4];
#pragma unroll
        for (int s = 0; s < 4; ++s) qfr[s] = *(const LAS bf16x8*)(Qd + (32 * ib + r) * GR + 16 * s + 8 * hh);
#pragma unroll
        for (int jb = 0; jb < 2; ++jb) { f32x16 pt;
#pragma unroll
            for (int i = 0; i < 16; ++i) pt[i] = 0.f;
#pragma unroll
            for (int s = 0; s < 4; ++s) { const bf16x8 ka = *(const LAS bf16x8*)(Kd + (32 * jb + kap(r)) * GR + 16 * s + 8 * hh); pt = __builtin_amdgcn_mfma_f32_32x32x16_bf16(ka, qfr[s], pt, 0, 0, 0); }
            const int ti = 32 * ib + r;
#pragma unroll
            for (int g = 0; g < 16; ++g) { const int tj = 32 * jb + kap((g & 3) + 8 * (g >> 2) + 4 * hh); const bool keep = dir ? (tj >= ti) : (tj <= ti); pt[g] = keep ? pt[g] : 0.f; }
#pragma unroll
            for (int s2 = 0; s2 < 2; ++s2) { v4u w; w.x = pkbf2(pt[8 * s2 + 0], pt[8 * s2 + 1]); w.y = pkbf2(pt[8 * s2 + 2], pt[8 * s2 + 3]); w.z = pkbf2(pt[8 * s2 + 4], pt[8 * s2 + 5]); w.w = pkbf2(pt[8 * s2 + 6], pt[8 * s2 + 7]);
                const bf16x8 va = *(const LAS bf16x8*)(VT + (32 * eb + r) * GR + 32 * jb + 16 * s2 + 8 * hh);
                O = __builtin_amdgcn_mfma_f32_32x32x16_bf16(va, __builtin_bit_cast(bf16x8, w), O, 0, 0, 0); } }
#pragma unroll
        for (int s = 0; s < 4; ++s) { const bf16x8 sa = *(const LAS bf16x8*)(Sd + (32 * eb + r) * GR + 16 * s + 8 * hh); O = __builtin_amdgcn_mfma_f32_32x32x16_bf16(sa, qfr[s], O, 0, 0, 0); } }
    { float ss = 0.f;
#pragma unroll
      for (int g = 0; g < 16; ++g) ss += O[g] * O[g];
      ss += __shfl_xor(ss, 32);
      if (hh == 0) red[eb * 64 + 32 * ib + r] = ss; }
    __syncthreads();
    { const int ti = 32 * ib + r; const float tot = (red[ti] + red[64 + ti]) + (red[128 + ti] + red[192 + ti]); const float rs = 1.f / sqrtf(tot * (1.f / 128.f) + RMS_EPS);
      const GAS float* gn = (const GAS float*)INP(a, I_GNORM) + l * 128; const GAS bf16* pr = P + (size_t)(row0 + ti) * INPAD + O_GR + h * 128; GAS bf16* o = (GAS bf16*)(ws + WS_OBR) + (size_t)(row0 + ti) * 512 + h * 128;
#pragma unroll
      for (int g4 = 0; g4 < 4; ++g4) { const int e = 32 * eb + 8 * g4 + 4 * hh; const f32x4 gv = *(const GAS f32x4*)(gn + e); const v2u rw = *(const GAS v2u*)(pr + e);
          const float r0 = bflo(rw.x), r1 = bfhi(rw.x), r2 = bflo(rw.y), r3 = bfhi(rw.y);
          const float y0 = O[4 * g4] * rs * gv[0] * (r0 / (1.f + __expf(-r0))), y1 = O[4 * g4 + 1] * rs * gv[1] * (r1 / (1.f + __expf(-r1)));
          const float y2 = O[4 * g4 + 2] * rs * gv[2] * (r2 / (1.f + __expf(-r2))), y3 = O[4 * g4 + 3] * rs * gv[3] * (r3 / (1.f + __expf(-r3)));
          v2u w; w.x = pk2(y0, y1); w.y = pk2(y2, y3); *(GAS v2u*)(o + e) = w; } }
    __syncthreads();
}

__device__ __forceinline__ void gate_row(const Fr& F, unsigned char* ws, int row) {
    const int lane = F.lane; const GAS bf16* pg = (const GAS bf16*)(ws + WS_P) + (size_t)row * INPAD + O_GATE; const GAS bf16* pu = (const GAS bf16*)(ws + WS_U) + (size_t)row * 3072; GAS bf16* po = (GAS bf16*)(ws + WS_YMB) + (size_t)row * 1024;
#pragma unroll
    for (int j = 0; j < 2; ++j) { const int c = 8 * lane + 512 * j; float y[8];
#pragma unroll
        for (int i = 0; i < 8; ++i) y[i] = 0.f;
#pragma unroll
        for (int br = 0; br < 3; ++br) { const v4u g = *(const GAS v4u*)(pg + br * 1024 + c), u = *(const GAS v4u*)(pu + br * 1024 + c);
#pragma unroll
            for (int i = 0; i < 4; ++i) { y[2 * i] += bflo(u[i]) * __builtin_amdgcn_rcpf(1.f + __expf(-bflo(g[i]))); y[2 * i + 1] += bfhi(u[i]) * __builtin_amdgcn_rcpf(1.f + __expf(-bfhi(g[i]))); } }
        v4u o; o.x = pk2(y[0], y[1]); o.y = pk2(y[2], y[3]); o.z = pk2(y[4], y[5]); o.w = pk2(y[6], y[7]); *(GAS v4u*)(po + c) = o; }
}
__device__ __forceinline__ void hy_tr_item(const Fr& F, unsigned char* ws, int item) {
    LAS bf16* T = (LAS bf16*)F.L;
    const int tid = F.tid; const int cb = item & 7, sb = (item >> 3) & 127, b = item >> 10; const int c0 = cb * 64, s0 = sb * 64;
    { const int cc = tid >> 3, sq = tid & 7; const v4u v = *(const v4u*)((const bf16*)(ws + WS_OHYT) + ((size_t)(c0 + cc) * 2 + b) * 8192 + s0 + sq * 8);
      *(LAS v4u*)(T + cc * 72 + sq * 8) = v; }
    __syncthreads();
    { const int ss = tid >> 3, cq = tid & 7; unsigned short e[8];
#pragma unroll
      for (int j = 0; j < 8; ++j) e[j] = T[(cq * 8 + j) * 72 + ss];
      v4u o; o.x = e[0] | ((unsigned)e[1] << 16); o.y = e[2] | ((unsigned)e[3] << 16); o.z = e[4] | ((unsigned)e[5] << 16); o.w = e[6] | ((unsigned)e[7] << 16);
      *(v4u*)((bf16*)(ws + WS_OBR) + (size_t)2 * MALL * 512 + (size_t)(b * 8192 + s0 + ss) * 512 + c0 + cq * 8) = o; }
    __syncthreads();
}

__device__ __forceinline__ void ln1_mod2(const GAS float* xp, GAS float* xs, GAS bf16* hb, const GAS float* g1, const GAS float* b1, const GAS float* sh2, const GAS float* sc2, float (&x)[16], int lane) {
    float s = 0.f;
#pragma unroll
    for (int i = 0; i < 16; ++i) { x[i] = xp[lane + 64 * i]; s += x[i]; }
    float mean = wave_sum(s) * (1.f / 1024.f); float q = 0.f;
#pragma unroll
    for (int i = 0; i < 16; ++i) { x[i] -= mean; q += x[i] * x[i]; }
    float rstd = 1.f / sqrtf(wave_sum(q) * (1.f / 1024.f) + LN_EPS);
    s = 0.f;
#pragma unroll
    for (int i = 0; i < 16; ++i) { x[i] = x[i] * rstd * g1[lane + 64 * i] + b1[lane + 64 * i]; xs[lane + 64 * i] = x[i]; s += x[i]; }
    mean = wave_sum(s) * (1.f / 1024.f); q = 0.f;
#pragma unroll
    for (int i = 0; i < 16; ++i) { x[i] -= mean; q += x[i] * x[i]; }
    rstd = 1.f / sqrtf(wave_sum(q) * (1.f / 1024.f) + LN_EPS);
#pragma unroll
    for (int i = 0; i < 16; ++i) { x[i] = x[i] * rstd * (1.f + sc2[lane + 64 * i]) + sh2[lane + 64 * i]; hb[lane + 64 * i] = (bf16)f2bf(x[i]); }
}
__device__ __forceinline__ float reduce32(float (&p)[32], int lane) {
    float a[16], b[8], c[4], d[2];
    { const bool up = (lane & 32) != 0;
#pragma unroll
      for (int e = 0; e < 16; ++e) { const float send = up ? p[e] : p[e + 16], keep = up ? p[e + 16] : p[e]; a[e] = keep + __shfl_xor(send, 32); } }
    { const bool up = (lane & 16) != 0;
#pragma unroll
      for (int e = 0; e < 8; ++e) { const float send = up ? a[e] : a[e + 8], keep = up ? a[e + 8] : a[e]; b[e] = keep + __shfl_xor(send, 16); } }
    { const bool up = (lane & 8) != 0;
#pragma unroll
      for (int e = 0; e < 4; ++e) { const float send = up ? b[e] : b[e + 4], keep = up ? b[e + 4] : b[e]; c[e] = keep + __shfl_xor(send, 8); } }
    { const bool up = (lane & 4) != 0;
#pragma unroll
      for (int e = 0; e < 2; ++e) { const float send = up ? c[e] : c[e + 2], keep = up ? c[e + 2] : c[e]; d[e] = keep + __shfl_xor(send, 4); } }
    float r;
    { const bool up = (lane & 2) != 0; const float send = up ? d[0] : d[1], keep = up ? d[1] : d[0]; r = keep + __shfl_xor(send, 2); }
    return r + __shfl_xor(r, 1);
}
__device__ __forceinline__ void route_row(unsigned char* ws, int l, int row, float tot, const GAS float* rb, int lane, bool dry, LAS unsigned* lcnt) {
    float mylogit = (lane & 1) ? -3.0e38f : tot + rb[lane >> 1];
    float tv[4]; int ti[4];
#pragma unroll
    for (int k = 0; k < 4; ++k) { const float mx = wave_max(mylogit); const unsigned long long bal = __ballot(mylogit == mx); const int idx = __builtin_ctzll(bal); tv[k] = mx; ti[k] = idx >> 1; if (lane == idx) mylogit = -3.0e38f; }
    const float e1 = expf(tv[1] - tv[0]), e2 = expf(tv[2] - tv[0]), e3 = expf(tv[3] - tv[0]); const float inv = 1.f / (1.f + e1 + e2 + e3);
    if (lane < 4 && !dry) { const int e = lane == 0 ? ti[0] : lane == 1 ? ti[1] : lane == 2 ? ti[2] : ti[3]; const float g = (lane == 0 ? 1.f : lane == 1 ? e1 : lane == 2 ? e2 : e3) * inv;
        const unsigned pos = __hip_atomic_fetch_add(lcnt + e, 1u, __ATOMIC_RELAXED, __HIP_MEMORY_SCOPE_WORKGROUP);
        ((GAS int*)(ws + WS_TOPE))[row * 4 + lane] = e; ((GAS float*)(ws + WS_TOPG))[row * 4 + lane] = g; ((GAS int*)(ws + WS_SPOS))[row * 4 + lane] = (int)pos; }
}
__device__ __forceinline__ void ln1_router_row2(const Fr& F, const Args& a, unsigned char* ws, int l, int row0, const LAS float* wT  , bool dry, LAS unsigned* lcnt) {
    const int lane = F.lane; const GAS float* g1 = (const GAS float*)INP(a, I_LN1G) + l * 1024; const GAS float* b1 = (const GAS float*)INP(a, I_LN1B) + l * 1024;
    const int mi = row0 < NLAT ? (row0 >> 13) : 2; const GAS float* mod = (const GAS float*)(ws + WS_MOD) + ((size_t)l * 3 + mi) * 6144;
    float x0[16], x1[16];
    ln1_mod2((const GAS float*)(ws + WS_XPRE) + (size_t)row0 * 1024, (GAS float*)(ws + WS_XS) + (size_t)row0 * 1024, (GAS bf16*)(ws + WS_HBF) + (size_t)row0 * 1024, g1, b1, mod + 3072, mod + 4096, x0, lane);
    ln1_mod2((const GAS float*)(ws + WS_XPRE) + (size_t)(row0 + 1) * 1024, (GAS float*)(ws + WS_XS) + (size_t)(row0 + 1) * 1024, (GAS bf16*)(ws + WS_HBF) + (size_t)(row0 + 1) * 1024, g1, b1, mod + 3072, mod + 4096, x1, lane);
    float p0[32], p1[32];
#pragma unroll
    for (int e = 0; e < 32; ++e) { float s0 = 0.f, s1 = 0.f;
#pragma unroll
        for (int i = 0; i < 16; ++i) { const float w = wT[e * 1025 + lane + 64 * i]; s0 += x0[i] * w; s1 += x1[i] * w; }
        p0[e] = s0; p1[e] = s1; }
    const float t0 = reduce32(p0, lane), t1 = reduce32(p1, lane);
    const GAS float* rb = (const GAS float*)INP(a, I_RB) + l * 32;
    route_row(ws, l, row0, t0, rb, lane, dry, lcnt); route_row(ws, l, row0 + 1, t1, rb, lane, dry, lcnt);
}

__device__ __forceinline__ int moe_table(const Fr& F, unsigned char* ws, int l, LAS int* pst, LAS int* cntl, LAS int* ptab) {
    if (F.tid < 64) { const int e = F.tid & 31; const GAS unsigned* cnt = (const GAS unsigned*)(ws + WS_CTL) + CW_CNT + l * 32 * 64;
        const int c = (int)__hip_atomic_load(cnt + e * 64, __ATOMIC_RELAXED, __HIP_MEMORY_SCOPE_AGENT); const int np = (c + 255) >> 8;
        int incl = np;
#pragma unroll
        for (int o = 1; o < 32; o <<= 1) { const int v = __shfl_up(incl, o, 32); if (e >= o) incl += v; }
        const int first = incl - np;
        if (F.tid < 32) { cntl[e] = c; pst[e] = first << 8; if (e == 31) pst[32] = incl << 8;
#pragma unroll 1
            for (int j = 0; j < np; ++j) ptab[first + j] = e; } }
    __syncthreads();
    return __builtin_amdgcn_readfirstlane(pst[32] >> 8);
}

__device__ __forceinline__ void combine_row(const Fr& F, const Args& a, unsigned char* ws, int l, int row, GAS float* xso) {
    const int lane = F.lane; const GAS bf16* ys = (const GAS bf16*)(ws + WS_YSLOT) + (size_t)row * 4 * 1024; GAS float* xs = (GAS float*)(ws + WS_XS) + (size_t)row * 1024;
    const int mi = row < NLAT ? (row >> 13) : 2; const GAS float* mod = (const GAS float*)(ws + WS_MOD) + ((size_t)l * 3 + mi) * 6144; const GAS float* g2 = mod + 5120;
    const GAS float* lg = (const GAS float*)INP(a, I_LN2G) + l * 1024; const GAS float* lb = (const GAS float*)INP(a, I_LN2B) + l * 1024;
    f32x4 v[4]; float s = 0.f;
#pragma unroll
    for (int j = 0; j < 4; ++j) { const int k = 4 * lane + 256 * j; f32x4 f; f.x = 0.f; f.y = 0.f; f.z = 0.f; f.w = 0.f;
#pragma unroll
        for (int kk = 0; kk < 4; ++kk) { const v2u w = *(const GAS v2u*)(ys + (size_t)kk * 1024 + k); f.x += bflo(w.x); f.y += bfhi(w.x); f.z += bflo(w.y); f.w += bfhi(w.y); }
        v[j] = *(const GAS f32x4*)(xs + k) * DN_ALPHA + *(const GAS f32x4*)(g2 + k) * f; s += (v[j].x + v[j].y) + (v[j].z + v[j].w); }
    const float mean = wave_sum(s) * (1.f / 1024.f); float q = 0.f;
#pragma unroll
    for (int j = 0; j < 4; ++j) { v[j] = v[j] - mean; q += (v[j].x * v[j].x + v[j].y * v[j].y) + (v[j].z * v[j].z + v[j].w * v[j].w); }
    const float rstd = 1.f / sqrtf(wave_sum(q) * (1.f / 1024.f) + LN_EPS);
#pragma unroll
    for (int j = 0; j < 4; ++j) { const int k = 4 * lane + 256 * j; v[j] = v[j] * rstd * *(const GAS f32x4*)(lg + k) + *(const GAS f32x4*)(lb + k); if (l == 0) *(GAS f32x4*)(xso + (size_t)row * 1024 + k) = v[j]; }
    if (l == 1) {
#pragma unroll
        for (int j = 0; j < 4; ++j) *(GAS f32x4*)((GAS float*)a.out + (size_t)row * 1024 + 4 * lane + 256 * j) = v[j];
    }
}

constexpr int NPH_PRO = 3, NPH_LAYER = 12, NPH = NPH_PRO + 2 * NPH_LAYER;
constexpr float QSCALE = 0.10206207261596575f * 1.4426950408889634f;

__global__ void __launch_bounds__(512, 2) fwd(Args args) {
    extern __shared__ __attribute__((aligned(16))) unsigned char lds[];
    Fr F; F.L = (LAS unsigned char*)lds; F.tid = threadIdx.x; F.lane = F.tid & 63; F.wave = __builtin_amdgcn_readfirstlane(F.tid >> 6); F.G = gridDim.x; F.bid = blockIdx.x;
    volatile LAS unsigned* MISC = (volatile LAS unsigned*)(F.L + LDS_MISC);
    unsigned char* wsraw = args.ws; unsigned char* ws = (unsigned char*)(GAS unsigned char*)wsraw;
#define ctl ((unsigned*)(ws + WS_CTL))
    for (int u = F.tid; u < (LDS_BYTES - LDS_MISC) / 4; u += 512) ((LAS unsigned*)(F.L + LDS_MISC))[u] = 0u;
    __syncthreads();
#if !MK_PER_PHASE
    XcdBarrier bar = xcd_barrier_post(ctl + CW_BAR, MISC + 8);
#define SEAM() xcd_barrier(bar)
#else
#define SEAM() do {} while (0)
#endif
#define HYF(l_, Ln_, blk_, FILT_, HP_) hy_filter_item(F.L, F.tid, INP(args, I_HW1) + (size_t)(l_) * 33 * 64, INP(args, I_HB1) + (l_) * 64, INP(args, I_HW2) + (size_t)(l_) * 64 * 64, INP(args, I_HB2) + (l_) * 64, INP(args, I_HFREQ) + (l_) * 64, INP(args, I_HW3) + (size_t)(l_) * 64 * 2048, Ln_, blk_, FILT_, HP_)
#define PHASE_BEGIN() do { asm volatile("" : "+v"(F.tid)); F.lane = F.tid & 63; asm volatile("" : "+s"(wsraw)); ws = (unsigned char*)(GAS unsigned char*)wsraw; gw = F.bid * 8 + F.wave; gt = F.bid * 512 + F.tid; } while (0)
    const int lo = args.ph_lo, hi = args.ph_hi;
#ifndef MK_ATTVAR
#define MK_ATTVAR 0
#endif
#ifndef MK_DUP
#define MK_DUP 0
#endif
#ifndef MK_DUPN
#define MK_DUPN 1
#endif
#define TIMES(k) (1 + ((MK_DUP >> (k)) & 1) * MK_DUPN)
#ifndef MK_SUB
#define MK_SUB 0xffff
#endif
#define SUB(k) ((MK_SUB >> (k)) & 1)
#ifndef MK_MASK
#define MK_MASK 0x7fff
#endif
#define IN(k) (((MK_MASK >> (k)) & 1) && lo <= (k) && (k) < hi)
#define INL(j) (((MK_MASK >> (3 + (j))) & 1) && lo <= (pb + (j)) && (pb + (j)) < hi)
    int gw = F.bid * 8 + F.wave, gt = F.bid * 512 + F.tid; const int NGW = F.G * 8, NGT = F.G * 512;

    if (IN(0)) for (int r_ = 0; r_ < 1 + (args.dupk == 0); ++r_) {
        PHASE_BEGIN();
        for (int rep_ = 0; rep_ < TIMES(0); ++rep_) {
        __syncthreads();
        for (int step_ = 0; step_ < 2; ++step_) { const bool do_filt = (step_ == 0) == ((F.bid & 1) != 0); __syncthreads();
        if (!do_filt) {
        { LAS float* scr = (LAS float*)(F.L + F.wave * 8448);
          constexpr int I_IN = 16 * 214, I_UQ = 6 * 24, I_UKV = 4 * 32, I_BR = 8 * 32, I_OUT = 16 * 32, I_M1 = 32 * 16 * 64, I_M2 = 32 * 16 * 32, PER_LAYER = I_IN + I_UQ + I_UKV + 3 * I_BR + I_OUT + I_M1 + I_M2;
          for (int it = gw; it < 2 * PER_LAYER; it += NGW) {
              const int l = it / PER_LAYER; int r = it - l * PER_LAYER; unsigned char* wbl = ws + WS_W + (size_t)l * WB_LAYER;
              if (r < I_IN) { tr_item(INP(args, I_WIN) + (size_t)l * 1024 * INTOT, 1024, INTOT, (bf16*)(wbl + WB_IN), 0, nullptr, 1.f, scr, r, F.lane); continue; } r -= I_IN;
              if (r < I_UQ) { tr_item(INP(args, I_WUQ) + (size_t)l * 384 * 768, 384, 768, (bf16*)(wbl + WB_UQ), 0, INP(args, I_QNORM) + l * 384, QSCALE, scr, r, F.lane); continue; } r -= I_UQ;
              if (r < I_UKV) { tr_item(INP(args, I_WUKV) + (size_t)l * 256 * 1024, 256, 1024, (bf16*)(wbl + WB_UKV), 0, INP(args, I_KVNORM) + l * 256, 1.f, scr, r, F.lane); continue; } r -= I_UKV;
              if (r < 3 * I_BR) { const int br = r / I_BR; tr_item(INP(args, I_WBG + br) + (size_t)l * 512 * 1024, 512, 1024, (bf16*)(wbl + WB_BR) + (size_t)br * 1024 * 512, 0, nullptr, 1.f, scr, r - br * I_BR, F.lane); continue; } r -= 3 * I_BR;
              if (r < I_OUT) { tr_item(INP(args, I_WOUT) + (size_t)l * 1024 * 1024, 1024, 1024, (bf16*)(wbl + WB_OUT), 0, nullptr, 1.f, scr, r, F.lane); continue; } r -= I_OUT;
              if (r < I_M1) { const int e = r >> 10; tr_item(INP(args, I_MW1) + ((size_t)l * 32 + e) * 1024 * 2048, 1024, 2048, (bf16*)(wbl + WB_M1) + (size_t)e * 2048 * 1024, 1, nullptr, 1.f, scr, r & 1023, F.lane); continue; } r -= I_M1;
              { const int e = r >> 9; tr_item(INP(args, I_MW2) + ((size_t)l * 32 + e) * 1024 * 1024, 1024, 1024, (bf16*)(wbl + WB_M2) + (size_t)e * 1024 * 1024, 0, nullptr, 1.f, scr, r & 511, F.lane); }
          }
          for (int i = gt; i < 2 * 64 * 1024 / 8; i += NGT) { const int l = i >> 13, j = i & 8191; *(v4u*)((bf16*)(ws + WS_W + (size_t)l * WB_LAYER + WB_IN) + (size_t)INTOT * 1024 + (size_t)j * 8) = (v4u){0u, 0u, 0u, 0u}; }
        }
        if (F.bid < 192) { LAS float* act = (LAS float*)(F.L + 98304);
            __syncthreads();
            for (int i = F.tid; i < 3072; i += 512) { const float x = i < 2048 ? INP(args, I_C)[i] : INP(args, I_CCTX)[i - 2048]; act[i] = silu_(x); }
            __syncthreads();
            for (int it = F.bid; it < 192; it += F.G) { const int l = it / 96, r = it - l * 96, kb = r / 12, nb = r - kb * 12, n = nb * 512 + F.tid;
                const float* W = INP(args, I_ADAW) + (size_t)l * 1024 * 6144; float a0 = 0.f, a1 = 0.f, a2 = 0.f;
#pragma unroll 8
                for (int k = kb * 128; k < kb * 128 + 128; ++k) { const float w = W[(size_t)k * 6144 + n]; a0 += act[k] * w; a1 += act[1024 + k] * w; a2 += act[2048 + k] * w; }
                float* mp = (float*)(ws + WS_MODP) + (((size_t)kb * 2 + l) * 3) * 6144 + n; mp[0] = a0; mp[6144] = a1; mp[2 * 6144] = a2; } }
        for (int i = gt; i < 8192 * 16; i += NGT) { const int t = i >> 4, j = i & 15; const float pos = (float)((j < 8) ? (t >> 6) : (t & 63)); const float inv = powf(10000.f, -(float)(j & 7) / 8.f); const float ang = pos * inv;
            float* rp = (float*)(ws + WS_ROPE) + (size_t)i * 2; rp[0] = cosf(ang); rp[1] = sinf(ang); }
        for (int i = gt; i < FFTN; i += NGT) { float sn, cs; sincospif((float)i / 8192.f, &sn, &cs); f32x2 w; w.x = cs; w.y = -sn; ((f32x2*)(ws + WS_TW))[i] = w; }
        } else {
        __syncthreads();
        for (int it = F.bid; it < 264; it += F.G) { if (it < 256) HYF(0, 8192, it, (float*)(ws + WS_FILT), (float*)(ws + WS_HPART)); else HYF(0, 256, it - 256, (float*)(ws + WS_FILTC), (float*)(ws + WS_HPARTC)); }
        } }
        }
        SEAM();
    }
#ifdef MK_XBAR
    for (int k_ = 0; k_ < MK_XBAR; ++k_) SEAM();
#endif
    if (IN(1)) {
        PHASE_BEGIN();
        for (int i = gt; i < 2 * 3 * 6144; i += NGT) { const int l = i / 18432, n = i % 6144; float s = INP(args, I_ADAB)[l * 6144 + n];
#pragma unroll
            for (int kb = 0; kb < 8; ++kb) s += ((const float*)(ws + WS_MODP))[(size_t)kb * 2 * 18432 + i];
            ((float*)(ws + WS_MOD))[i] = s; }
        SEAM();
    }
    if (IN(2)) for (int r_ = 0; r_ < 1 + (args.dupk == 2); ++r_) {
        PHASE_BEGIN();
        for (int row = gw; row < MALL; row += NGW) { const int mi = row < NLAT ? (row >> 13) : 2; const float* mod = (const float*)(ws + WS_MOD) + (size_t)mi * 6144;
            ln_mod_row(row < NLAT ? INP(args, I_X) + (size_t)row * 1024 : INP(args, I_CTX) + (size_t)(row - NLAT) * 1024, mod, mod + 1024, (bf16*)(ws + WS_HBF) + (size_t)row * 1024, F.lane); }
        SEAM();
    }

    for (int l = 0; l < 2; ++l) {
        const int pb = NPH_PRO + l * NPH_LAYER;
#define wb (ws + WS_W + (size_t)l * WB_LAYER)
        const int nrows = l == 1 ? NLAT : MALL, nPM = nrows / 256;
        if (INL(0)) for (int r_ = 0; r_ < 1 + (args.dupk == 3); ++r_) {
            PHASE_BEGIN();
            if (SUB(0)) { pg8::Gemm g{(const bf16*)(ws + WS_HBF), (const bf16*)(wb + WB_IN), MALL, INPAD, 1024}; pg8::StaticOrder S; S.init(MALL, INPAD, F.G, F.bid);
              pg8::EpiP E{(GAS bf16*)(ws + WS_P), INPAD};
              pg8::gemm_phase<pg8::EpiP, pg8::StaticOrder, true, true>(F.L, g, S, E, F.tid); }
            if (TIMES(2) > 1) { PHASE_BEGIN(); pg8::Gemm g{(const bf16*)(ws + WS_HBF), (const bf16*)(wb + WB_IN), MALL, INPAD, 1024}; pg8::StaticOrder S; S.init(MALL, INPAD, F.G, F.bid);
#ifdef MK_NULLEPI
              pg8::EpiNull E{}; pg8::gemm_phase<pg8::EpiNull, pg8::StaticOrder, true, true>(F.L, g, S, E, F.tid);
#else
              pg8::EpiP E{(GAS bf16*)(ws + WS_P), INPAD}; pg8::gemm_phase<pg8::EpiP, pg8::StaticOrder, true, true>(F.L, g, S, E, F.tid);
#endif
            }
            PHASE_BEGIN();
            for (int rep_ = 0; rep_ < TIMES(3); ++rep_) if (SUB(1)) for (int c = F.bid; c < 512; c += F.G) kspec_item(F, ws, c);
            SEAM();
        }
        if (INL(1)) for (int r_ = 0; r_ < 1 + (args.dupk == 4); ++r_) {
            PHASE_BEGIN();
            for (int rep_ = 0; rep_ < TIMES(4); ++rep_) {
            __syncthreads();
            const int nconv = 2 * 64 * 24 + (l == 0 ? 2 * 2 * 24 : 0);
            for (int it = F.bid; it < nconv; it += F.G) {
                if (it < 2 * 64 * 24) { const int cb = it % 24, tb = (it / 24) & 63, b = it / (24 * 64);
                    conv3_item(F, args, (const GAS bf16*)(ws + WS_P) + (size_t)b * SEQ * INPAD, SEQ, (GAS bf16*)(ws + WS_HYT) + (size_t)b * SEQ, l, tb * 128, cb * 64); }
                else { const int i2 = it - 2 * 64 * 24; const int cb = i2 % 24, tb = (i2 / 24) & 1, b = i2 / (24 * 2);
                    conv3_item(F, args, (const GAS bf16*)(ws + WS_P) + (size_t)(NLAT + b * CTXL) * INPAD, CTXL, (GAS bf16*)(ws + WS_HYTC) + (size_t)b * CTXL, l, tb * 128, cb * 64); }
            }
            LAS float* wa = (LAS float*)(F.L + 65536);
            for (int i = F.tid; i < 8192; i += 512) wa[i] = i < 4096 ? INP(args, I_WA2F)[(size_t)l * 4096 + i] : INP(args, I_WA2B)[(size_t)l * 4096 + i - 4096];
            __syncthreads();
            for (int row = gw; row < MALL; row += NGW) post_row(F, args, ws, l, row, wa);
            }
            SEAM();
        }
        if (INL(2)) for (int r_ = 0; r_ < 1 + (args.dupk == 5); ++r_) {
            PHASE_BEGIN();
            for (int rep_ = 0; rep_ < TIMES(5); ++rep_) if (SUB(2)) { pg8::Gemm g{(const bf16*)(ws + WS_NQ), (const bf16*)(wb + WB_UQ), nrows, 768, 384}; pg8::StaticOrder S; S.init(nrows, 768, F.G, F.bid);
              pg8::EpiP E{(GAS bf16*)(ws + WS_QB), 768};
              pg8::gemm_phase<pg8::EpiP, pg8::StaticOrder, true, true>(F.L, g, S, E, F.tid); }
            PHASE_BEGIN();
            for (int rep_ = 0; rep_ < TIMES(5); ++rep_) if (SUB(3)) { pg8::Gemm g{(const bf16*)(ws + WS_NKV), (const bf16*)(wb + WB_UKV), MALL, 1024, 256}; pg8::StaticOrder S; S.init(MALL, 1024, F.G, (F.bid + F.G - 230 % F.G) % F.G);
              pg8::EpiKV E{(GAS bf16*)(ws + WS_KB), (GAS bf16*)(ws + WS_VT), NLAT, KEYS, CTXL};
              pg8::gemm_phase<pg8::EpiKV, pg8::StaticOrder, true, true>(F.L, g, S, E, F.tid); }
            PHASE_BEGIN();
            for (int rep_ = 0; rep_ < TIMES(7); ++rep_) for (int it = (F.bid + F.G - 198 % F.G) % F.G; it < 1056; it += F.G) gla_a_item(F, ws, it);
            PHASE_BEGIN();
            for (int rep_ = 0; rep_ < TIMES(6); ++rep_) if (SUB(4)) for (int c = F.bid; c < 512; c += F.G) hyconv_item(F, args, ws, l, c);
            PHASE_BEGIN();
            for (int rep_ = 0; rep_ < TIMES(15); ++rep_) if (SUB(5) && l == 0) for (int c = F.bid; c < 512; c += F.G) hyctx_item(F, args, ws, l, c);
            SEAM();
        }
        if (INL(3)) {
            PHASE_BEGIN();
            const int nunits = 512 + (l == 0 ? 16 : 0);
            for (int it = F.bid; it < 256; it += F.G) gla_scan_q(F, ws, it);
            for (int rep_ = 0; rep_ < TIMES(8); ++rep_) { unsigned* qh = ctl + CW_QCTR + (l * 4 + rep_) * 64;
            for (;;) {
                if (F.tid == 0) MISC[0] = __hip_atomic_fetch_add(qh, 1u, __ATOMIC_RELAXED, __HIP_MEMORY_SCOPE_AGENT);
                __syncthreads();
                int u = __builtin_amdgcn_readfirstlane((int)MISC[0]);
                __syncthreads();
                if (u >= nunits) break;
                int bh, qrow0, nt;
                if (u < 512) { bh = u >> 5; qrow0 = (bh >> 3) * SEQ + (u & 31) * 256; nt = KEYS / 64; } else { bh = u - 512; qrow0 = NLAT + (bh >> 3) * CTXL; nt = CTXL / 64; }
                attn_unit(rep_ == 0 ? 0 : MK_ATTVAR, F, (const GAS bf16*)(ws + WS_QB), (const GAS bf16*)(ws + WS_KB) + (size_t)bh * KEYS * 96, (const GAS bf16*)(ws + WS_VT) + (size_t)bh * 64 * KEYS, rep_ == 0 ? (GAS bf16*)(ws + WS_OBR) + (size_t)MALL * 512 : (GAS bf16*)(ws + WS_XPRE), qrow0, bh & 7, nt, (const GAS float*)(ws + WS_ROPE));
            }
            }
            SEAM();
        }
        if (INL(4)) for (int r_ = 0; r_ < 1 + (args.dupk == 7); ++r_) {
            PHASE_BEGIN();
            for (int rep_ = 0; rep_ < TIMES(9); ++rep_) {
            for (int it = F.bid; it < 1056; it += F.G) { if (l == 1 && (it % 132) < 4) continue; gla_c_item(F, args, ws, l, it); }
            for (int it = F.bid; it < 2048; it += F.G) hy_tr_item(F, ws, it);
            }
            SEAM();
        }
        if (INL(5)) for (int r_ = 0; r_ < 1 + (args.dupk == 8); ++r_) {
            PHASE_BEGIN();
            pg8::Gemm g{(const bf16*)(ws + WS_OBR), (const bf16*)(wb + WB_BR), MALL, 1024, 512}; pg8::MergeOrder S{nPM, MALL / 256, F.G, F.bid};
            pg8::EpiU E{(GAS bf16*)(ws + WS_U), MALL / 256};
            pg8::gemm_phase<pg8::EpiU, pg8::MergeOrder, true, true>(F.L, g, S, E, F.tid);
            if (TIMES(10) > 1) { PHASE_BEGIN(); pg8::gemm_phase<pg8::EpiU, pg8::MergeOrder, true, true>(F.L, g, S, E, F.tid); }
            SEAM();
            PHASE_BEGIN();
            for (int rep_ = 0; rep_ < TIMES(17); ++rep_) for (int row = gw; row < nrows; row += NGW) gate_row(F, ws, row);
            SEAM();
        }
        if (INL(6)) for (int r_ = 0; r_ < 1 + (args.dupk == 9); ++r_) {
            PHASE_BEGIN();
            pg8::Gemm g{(const bf16*)(ws + WS_YMB), (const bf16*)(wb + WB_OUT), nrows, 1024, 1024}; pg8::StaticOrder S; S.init(nrows, 1024, F.G, F.bid);
            pg8::EpiOut E{l == 0 ? (const GAS float*)INP(args, I_X) : (const GAS float*)(ws + WS_XS), l == 0 ? (const GAS float*)INP(args, I_CTX) - (size_t)NLAT * 1024 : (const GAS float*)(ws + WS_XS), (GAS float*)(ws + WS_XPRE), (const GAS float*)(ws + WS_MOD) + (size_t)l * 18432, NLAT, DN_ALPHA};
            pg8::gemm_phase<pg8::EpiOut, pg8::StaticOrder, true, true>(F.L, g, S, E, F.tid);
            if (TIMES(11) > 1) { PHASE_BEGIN(); pg8::gemm_phase<pg8::EpiOut, pg8::StaticOrder, true, true>(F.L, g, S, E, F.tid); }
            SEAM();
        }
        if (INL(7)) {
            PHASE_BEGIN();
            LAS float* wT = (LAS float*)F.L; const float* rw = INP(args, I_RW) + (size_t)l * 1024 * 32;
            LAS unsigned* lcnt = (LAS unsigned*)(F.L + LDS_TAB + 512); LAS unsigned* lbase = lcnt + 32;
#pragma unroll 8
            for (int i = F.tid; i < 32768; i += 512) wT[(i & 31) * 1025 + (i >> 5)] = rw[i];
            if (F.tid < 32) lcnt[F.tid] = 0u;
            __syncthreads();
            for (int rep_ = TIMES(1) - 1; rep_ >= 0; --rep_) for (int rp = gw; rp < nrows / 2; rp += NGW) ln1_router_row2(F, args, ws, l, 2 * rp, wT, rep_ > 0, lcnt);
            __syncthreads();
            if (F.tid < 32) lbase[F.tid] = __hip_atomic_fetch_add(ctl + CW_CNT + (l * 32 + F.tid) * 64, lcnt[F.tid], __ATOMIC_RELAXED, __HIP_MEMORY_SCOPE_AGENT);
            __syncthreads();
            if (F.lane < 8) { int* tope = (int*)(ws + WS_TOPE); int* spos = (int*)(ws + WS_SPOS);
                for (int rp = gw; rp < nrows / 2; rp += NGW) { const int s_ = rp * 8 + F.lane; spos[s_] += (int)lbase[tope[s_]]; } }
            SEAM();
        }
        LAS int* pst = (LAS int*)(F.L + LDS_TAB); LAS int* cntl = pst + 64; LAS int* ptab = pst + 128;
        if (INL(8)) for (int r_ = 0; r_ < 1 + (args.dupk == 11); ++r_) {
            PHASE_BEGIN();
            moe_table(F, ws, l, pst, cntl, ptab);
            for (int rep_ = 0; rep_ < TIMES(12); ++rep_) {
            const int nslot = nrows * 4; const int* tope = (const int*)(ws + WS_TOPE); const int* spos = (const int*)(ws + WS_SPOS); int* rslot = (int*)(ws + WS_RSLOT);
            for (int s = gt; s < nslot; s += NGT) rslot[pst[tope[s]] + spos[s]] = s;
            for (int i = gt; i < 32 * 256; i += NGT) { const int e = i >> 8, r = pst[e] + cntl[e] + (i & 255); if (r < pst[e + 1]) rslot[r] = -1; }
            }
            SEAM();
        }
        if (INL(9)) for (int r_ = 0; r_ < 1 + (args.dupk == 12); ++r_) {
            PHASE_BEGIN();
            const int npanel = moe_table(F, ws, l, pst, cntl, ptab);
            pg8::Gemm g{(const bf16*)(ws + WS_HBF), (const bf16*)(wb + WB_M1), XG_ROWS, 2048, 1024}; pg8::MoeOrder<8> S{(const LAS int*)ptab, npanel, F.G, F.bid};
            pg8::EpiMoe1 E{(GAS bf16*)(ws + WS_ACT), (const GAS float*)INP(args, I_MB1) + (size_t)l * 32 * 2048};
            pg8::gemm_phase_g<pg8::EpiMoe1, pg8::MoeOrder<8>, true, true>(F.L, g, S, E, F.tid, (const GAS int*)(ws + WS_RSLOT));
            if (TIMES(13) > 1) { PHASE_BEGIN(); pg8::gemm_phase_g<pg8::EpiMoe1, pg8::MoeOrder<8>, true, true>(F.L, g, S, E, F.tid, (const GAS int*)(ws + WS_RSLOT)); }
            SEAM();
        }
        if (INL(10)) for (int r_ = 0; r_ < 1 + (args.dupk == 13); ++r_) {
            PHASE_BEGIN();
            const int npanel = moe_table(F, ws, l, pst, cntl, ptab);
            pg8::Gemm g{(const bf16*)(ws + WS_ACT), (const bf16*)(wb + WB_M2), XG_ROWS, 1024, 1024}; pg8::MoeOrder<4> S{(const LAS int*)ptab, npanel, F.G, F.bid};
            pg8::EpiMoe2 E{(GAS bf16*)(ws + WS_YSLOT), (const GAS float*)INP(args, I_MB2) + (size_t)l * 32 * 1024, (const GAS int*)(ws + WS_RSLOT), (const GAS float*)(ws + WS_TOPG)};
            pg8::gemm_phase<pg8::EpiMoe2, pg8::MoeOrder<4>, true, true>(F.L, g, S, E, F.tid);
            if (TIMES(14) > 1) { PHASE_BEGIN(); pg8::gemm_phase<pg8::EpiMoe2, pg8::MoeOrder<4>, true, true>(F.L, g, S, E, F.tid); }
            if (l == 0) { PHASE_BEGIN(); __syncthreads();
                for (int it = (F.G - 1 - F.bid); it < 256; it += F.G) HYF(1, 8192, it, (float*)(ws + WS_FILT), (float*)(ws + WS_HPART)); }
            SEAM();
        }
        if (INL(11)) {
            PHASE_BEGIN();
            for (int rep_ = TIMES(16) - 1; rep_ >= 0; --rep_) for (int row = gw; row < nrows; row += NGW) { combine_row(F, args, ws, l, row, rep_ > 0 ? (GAS float*)(ws + WS_XPRE) : (GAS float*)(ws + WS_XS));
                if (l == 0) { const int mi = row < NLAT ? (row >> 13) : 2; const float* mod = (const float*)(ws + WS_MOD) + (size_t)(3 + mi) * 6144;
                    ln_mod_row((const float*)(ws + WS_XS) + (size_t)row * 1024, mod, mod + 1024, (bf16*)(ws + WS_HBF) + (size_t)row * 1024, F.lane); } }
            if (l == 0) SEAM();
        }
    }
#undef wb
#undef ctl
#undef IN
#undef INL
}

extern "C" void kernel_launch(void* const* d_in, const int* in_sizes, int n_in, void* d_out, int out_size, void* d_ws, size_t ws_size, hipStream_t stream) {
    static int grid = 0;
    if (grid == 0) {
        if (n_in != 39 || out_size != NLAT * D || ws_size < WS_END) { fprintf(stderr, "kernel_launch: expected 39 inputs, %d outputs, >= %zu B workspace; got %d, %d, %zu\n", NLAT * D, (size_t)WS_END, n_in, out_size, ws_size); grid = -1; return; }
        int dev = 0, cus = 0, per_cu = 0;
        if (hipGetDevice(&dev) != hipSuccess || hipDeviceGetAttribute(&cus, hipDeviceAttributeMultiprocessorCount, dev) != hipSuccess) { grid = -1; return; }
        if (hipFuncSetAttribute((const void*)fwd, hipFuncAttributeMaxDynamicSharedMemorySize, LDS_BYTES) != hipSuccess) { fprintf(stderr, "kernel_launch: hipFuncSetAttribute failed\n"); grid = -1; return; }
        if (hipOccupancyMaxActiveBlocksPerMultiprocessor(&per_cu, (const void*)fwd, 512, LDS_BYTES) != hipSuccess || per_cu < 1) fprintf(stderr, "kernel_launch: occupancy query says %d\n", per_cu);
        (void)hipGetLastError();
        grid = cus;
    }
    if (grid < 0) return;
    (void)hipMemsetAsync((char*)d_ws + WS_CTL, 0, (size_t)CW_DBG * 4, stream);
    Args a{};
    for (int i = 0; i < 39; ++i) a.in[i] = (const float*)d_in[i];
    a.out = (float*)d_out; a.ws = (unsigned char*)d_ws;
#ifdef MK_DUPPH
    a.dupk = MK_DUPPH;
#else
    a.dupk = -1;
#endif
#if MK_PER_PHASE
    for (int ph = 0; ph < NPH; ++ph) { a.ph_lo = ph; a.ph_hi = ph + 1; hipLaunchKernelGGL(fwd, dim3(grid), dim3(512), LDS_BYTES, stream, a); }
#else
    a.ph_lo = 0; a.ph_hi = NPH;
    hipLaunchKernelGGL(fwd, dim3(grid), dim3(512), LDS_BYTES, stream, a);
#endif
}
```

```cpp
#include <hip/hip_runtime.h>
#include <cstdio>
#include <cstdint>

#ifndef MK_PER_PHASE
#define MK_PER_PHASE 0
#endif

constexpr int D = 1024, NB = 2, SEQ = 8192, CTXL = 256, NLAT = NB * SEQ, NCTX = NB * CTXL, MALL = NLAT + NCTX;
constexpr int KEYS = CTXL + SEQ;
constexpr int INTOT = 6848, INPAD = 6912;
constexpr int O_GK = 0, O_GV = 256, O_GAF = 768, O_GAB = 784, O_MKVA = 800, O_MKR = 1056, O_GQ = 1088, O_GR = 1344, O_MQA = 1856, O_HY = 2240, O_GATE = 3776;
constexpr int NEXP = 32, TOPK = 4, NSLOT = MALL * TOPK;
constexpr int XG_ROWS = 75776;
constexpr int NPANEL_MAX = XG_ROWS / 256;
constexpr float LN_EPS = 1e-5f, RMS_EPS = 1e-6f, DN_ALPHA = 1.41421356237f;
constexpr int FFTN = 16384;

constexpr size_t al256(size_t x) { return (x + 255) & ~(size_t)255; }
constexpr size_t WS_CTL = 0, CTL_ZERO_BYTES = 1u << 20;
constexpr size_t WS_MODP = CTL_ZERO_BYTES;
constexpr size_t WS_MOD = WS_MODP + al256((size_t)8 * 2 * 3 * 6144 * 4);
constexpr size_t WS_ROPE = WS_MOD + al256((size_t)2 * 3 * 6144 * 4);
constexpr size_t WS_TW = WS_ROPE + al256((size_t)8192 * 16 * 2 * 4);
constexpr size_t WS_HPART = WS_TW + al256((size_t)FFTN * 8);
constexpr size_t WS_HPARTC = WS_HPART + al256((size_t)256 * 1024 * 4);
constexpr size_t WS_TOPE = WS_HPARTC + al256((size_t)8 * 1024 * 4);
constexpr size_t WS_TOPG = WS_TOPE + al256((size_t)NSLOT * 4);
constexpr size_t WS_SPOS = WS_TOPG + al256((size_t)NSLOT * 4);
constexpr size_t WS_RSLOT = WS_SPOS + al256((size_t)NSLOT * 4);
constexpr size_t WS_GDEC = WS_RSLOT + al256((size_t)XG_ROWS * 4);
constexpr size_t WB_IN = 0, WB_UQ = WB_IN + (size_t)INPAD * 1024 * 2, WB_UKV = WB_UQ + (size_t)768 * 384 * 2, WB_BR = WB_UKV + (size_t)1024 * 256 * 2,
                 WB_OUT = WB_BR + (size_t)3 * 1024 * 512 * 2, WB_M1 = WB_OUT + (size_t)1024 * 1024 * 2, WB_M2 = WB_M1 + (size_t)32 * 2048 * 1024 * 2,
                 WB_LAYER = WB_M2 + (size_t)32 * 1024 * 1024 * 2;
constexpr size_t WS_W = WS_GDEC + al256((size_t)16 * 132 * 64 * 4);
constexpr size_t WS_XS = WS_W + 2 * WB_LAYER;
constexpr size_t WS_XPRE = WS_XS + (size_t)MALL * D * 4;
constexpr size_t WS_HBF = WS_XPRE + (size_t)MALL * D * 4;
constexpr size_t WS_P = WS_HBF + (size_t)MALL * D * 2;
constexpr size_t WS_XG = WS_P;
constexpr size_t WS_NQ = WS_P + (size_t)MALL * INPAD * 2;
constexpr size_t WS_NKV = WS_NQ + (size_t)MALL * 384 * 2;
constexpr size_t WS_QB = WS_NKV + (size_t)MALL * 256 * 2;
constexpr size_t WS_KB = WS_QB + (size_t)MALL * 768 * 2;
constexpr size_t WS_VT = WS_KB + (size_t)16 * KEYS * 96 * 2;
constexpr size_t WS_AF = WS_VT + (size_t)16 * 64 * KEYS * 2;
constexpr size_t WS_AB = WS_AF + (size_t)MALL * 256 * 4;
constexpr size_t WS_YM = WS_AB + (size_t)MALL * 256 * 4;
constexpr size_t WS_YMB = WS_YM + (size_t)MALL * D * 4;
constexpr size_t WS_U = WS_YMB + (size_t)MALL * D * 2;
constexpr size_t WS_R1 = WS_U + (size_t)MALL * 3072 * 2;
constexpr size_t WS_OF = WS_R1;
constexpr size_t WS_GST = WS_R1;
constexpr size_t WS_OB = WS_OF + (size_t)MALL * 512 * 4;
constexpr size_t WS_HYT = WS_OB + (size_t)MALL * 512 * 4;
constexpr size_t WS_HYTC = WS_HYT + (size_t)1536 * NLAT * 2;
constexpr size_t WS_OHYT = WS_HYTC + (size_t)1536 * NCTX * 2;
constexpr size_t WS_OBR = WS_OHYT + (size_t)512 * NLAT * 2;
constexpr size_t WS_R1_END = WS_OBR + (size_t)3 * MALL * 512 * 2;
constexpr size_t WS_YSLOT = WS_R1;
static_assert(WS_YSLOT + (size_t)NSLOT * D * 2 <= WS_R1_END, "YSLOT overlay");
static_assert(WS_GST + (size_t)16 * 132 * 8192 * 4 <= WS_HYT, "GST overlay");
constexpr size_t WS_FILT = WS_R1_END;
constexpr size_t WS_FILTC = WS_FILT + (size_t)4 * 512 * 8192 * 4;
constexpr size_t WS_R2 = WS_FILTC + (size_t)4 * 512 * 256 * 4;
constexpr size_t WS_K0S = WS_R2;
constexpr size_t WS_K1S = WS_K0S + (size_t)512 * FFTN * 8;
constexpr size_t WS_R2_END = WS_R2 + (size_t)XG_ROWS * D * 2;
constexpr size_t WS_ACT = WS_R2;
static_assert(WS_ACT + (size_t)XG_ROWS * D * 2 <= WS_R2_END && WS_K1S + (size_t)512 * FFTN * 8 <= WS_R2_END, "ACT overlay");
static_assert((size_t)XG_ROWS * D * 2 <= (size_t)MALL * INPAD * 2, "XG overlay");
constexpr size_t WS_END = WS_R2_END;

constexpr int CW_BAR = 4096;
constexpr int CW_CNT = 8192;
constexpr int CW_QCTR = 8192 + 2 * 32 * 64;
constexpr int CW_DBG = 16384;
static_assert(CW_QCTR + 8 * 64 <= CW_DBG, "ctl map");

constexpr int LDS_STAGE = 147456;
constexpr int LDS_TAB = LDS_STAGE;
constexpr int LDS_MISC = LDS_STAGE + 4096;
constexpr int LDS_BYTES = 155648;

#define GAS __attribute__((address_space(1)))
#define LAS __attribute__((address_space(3)))
typedef unsigned short bf16;
typedef unsigned v4u __attribute__((ext_vector_type(4)));
typedef unsigned v2u __attribute__((ext_vector_type(2)));
typedef float f32x2 __attribute__((ext_vector_type(2)));
typedef float f32x4 __attribute__((ext_vector_type(4)));
typedef float f32x16 __attribute__((ext_vector_type(16)));
typedef short bf16x8 __attribute__((ext_vector_type(8)));
#define LDS_WAIT() asm volatile("s_waitcnt lgkmcnt(0)" ::: "memory")
#define VM_WAIT() asm volatile("s_waitcnt vmcnt(0)" ::: "memory")
__device__ __forceinline__ unsigned f2bf(float f) { unsigned u = __builtin_bit_cast(unsigned, f); return (u + 0x7fffu + ((u >> 16) & 1u)) >> 16; }
__device__ __forceinline__ unsigned pk2(float lo, float hi) { return f2bf(lo) | (f2bf(hi) << 16); }
__device__ __forceinline__ float bf2f(unsigned h) { return __builtin_bit_cast(float, h << 16); }
__device__ __forceinline__ float bflo(unsigned w) { return __builtin_bit_cast(float, w << 16); }
__device__ __forceinline__ float bfhi(unsigned w) { return __builtin_bit_cast(float, w & 0xffff0000u); }
__device__ __forceinline__ float wave_sum(float v) {
#pragma unroll
    for (int o = 1; o < 64; o <<= 1) v += __shfl_xor(v, o);
    return v;
}
__device__ __forceinline__ float wave_max(float v) {
#pragma unroll
    for (int o = 1; o < 64; o <<= 1) v = fmaxf(v, __shfl_xor(v, o));
    return v;
}
__device__ __forceinline__ float sigmoidf_(float x) { return 1.f / (1.f + __expf(-x)); }

namespace pg8 {
#define PG8_LAS __attribute__((address_space(3)))
typedef unsigned short bf16_t;
typedef short bf16x8 __attribute__((ext_vector_type(8)));
typedef float f32x4 __attribute__((ext_vector_type(4)));
typedef unsigned u32x4 __attribute__((ext_vector_type(4)));
constexpr int BM = 256, BK = 64, HALF = 128, HTB = HALF * BK * 2  , STAGE_BYTES = 8 * HTB, NXCD = 8, WGM = 8;

__host__ __device__ __forceinline__ int lds_byte(int r, int c) { const int st = (r >> 4) * 2 + (c >> 5), rr = r & 15, cc = c & 31, ob = rr * 64 + cc * 2; return st * 1024 + (ob ^ (((ob >> 9) & 1) << 5)); }
__host__ __device__ __forceinline__ void stage_rc(int b, int& R, int& C) { const int st = b / 1024, sb = b % 1024, swz = sb ^ (((sb >> 9) & 1) << 5); R = (st >> 1) * 16 + swz / 64; C = (st & 1) * 32 + (swz % 64) / 2; }
__host__ __device__ __forceinline__ int perm32(int rho) { const int n = rho >> 4, i = rho & 15; return 8 * (i >> 2) + 4 * n + (i & 3); }

struct Unit { int pm, pn; };
struct Gemm { const bf16_t* A; const bf16_t* Bt; int M, N, K; };

struct StaticOrder {
    int nM, nN, nwg, G, c;
    __host__ __device__ void init(int M, int N, int G_, int c_) { nM = M / BM; nN = N / BM; nwg = nM * nN; G = G_; c = c_; }
    __host__ __device__ bool next(int i, Unit& u) const {
        const long L = (long)i * G + c; if (L >= nwg) return false;
        int wgid = (int)L; { const int q = nwg / NXCD, r = nwg % NXCD, xcd = wgid % NXCD, off = wgid / NXCD; wgid = (xcd < r ? xcd * (q + 1) : r * (q + 1) + (xcd - r) * q) + off; }
        const int nig = WGM * nN, gid = wgid / nig, fm = gid * WGM, gsz = (nM - fm) < WGM ? (nM - fm) : WGM;
        u.pm = fm + ((wgid % nig) % gsz); u.pn = (wgid % nig) / gsz; return true;
    }
    __device__ __forceinline__ void a_ready(const Unit&) const {}
    __device__ __forceinline__ void done(const Unit&) const {}
};

__device__ __forceinline__ unsigned cvt_pk_bf16(float lo, float hi) { unsigned r; asm volatile("v_cvt_pk_bf16_f32 %0, %1, %2" : "=v"(r) : "v"(lo), "v"(hi)); return r; }
typedef float f32x2 __attribute__((ext_vector_type(2)));

typedef unsigned u32x2e __attribute__((ext_vector_type(2)));
__device__ __forceinline__ unsigned pkbf(float lo, float hi) { return cvt_pk_bf16(lo, hi); }

struct EpiP {
    static constexpr bool PERM = true, AFTER_DRAIN = false;
    __attribute__((address_space(1))) bf16_t* O; int ldc;
    __device__ __forceinline__ void operator()(const f32x4 (&acc)[2][2][4][2], const Unit& u, int wr, int wc, int fr, int fq) const {
        const int row0 = u.pm * BM + wr * 64 + fr, col0 = u.pn * BM + wc * 32 + 8 * fq;
#pragma unroll
        for (int ai = 0; ai < 2; ++ai)
#pragma unroll
            for (int m = 0; m < 4; ++m) { __attribute__((address_space(1))) bf16_t* rowp = O + (size_t)(row0 + ai * HALF + m * 16) * ldc + col0;
#pragma unroll
                for (int bj = 0; bj < 2; ++bj) { const f32x4 v0 = acc[ai][bj][m][0], v1 = acc[ai][bj][m][1];
                    u32x4 w; w.x = pkbf(v0[0], v0[1]); w.y = pkbf(v0[2], v0[3]); w.z = pkbf(v1[0], v1[1]); w.w = pkbf(v1[2], v1[3]);
                    *(__attribute__((address_space(1))) u32x4*)(rowp + bj * HALF) = w; } }
    }
};

struct EpiU {
    static constexpr bool PERM = true, AFTER_DRAIN = false;
    __attribute__((address_space(1))) bf16_t* O; int sPM;
    __device__ __forceinline__ void operator()(const f32x4 (&acc)[2][2][4][2], const Unit& u, int wr, int wc, int fr, int fq) const {
        const int pm = u.pm % sPM; const int row0 = pm * BM + wr * 64 + fr, col0 = u.pn * BM + wc * 32 + 8 * fq;
#pragma unroll
        for (int ai = 0; ai < 2; ++ai)
#pragma unroll
            for (int m = 0; m < 4; ++m) { __attribute__((address_space(1))) bf16_t* rowp = O + (size_t)(row0 + ai * HALF + m * 16) * 3072 + col0;
#pragma unroll
                for (int bj = 0; bj < 2; ++bj) { const f32x4 v0 = acc[ai][bj][m][0], v1 = acc[ai][bj][m][1];
                    u32x4 w; w.x = pkbf(v0[0], v0[1]); w.y = pkbf(v0[2], v0[3]); w.z = pkbf(v1[0], v1[1]); w.w = pkbf(v1[2], v1[3]);
                    *(__attribute__((address_space(1))) u32x4*)(rowp + bj * HALF) = w; } }
    }
};

struct EpiNull {
    static constexpr bool PERM = true, AFTER_DRAIN = false;
    __device__ __forceinline__ void operator()(const f32x4 (&acc)[2][2][4][2], const Unit& u, int wr, int wc, int fr, int fq) const {
#pragma unroll
        for (int ai = 0; ai < 2; ++ai)
#pragma unroll
            for (int bj = 0; bj < 2; ++bj)
#pragma unroll
                for (int m = 0; m < 4; ++m)
#pragma unroll
                    for (int n = 0; n < 2; ++n) asm volatile("" :: "v"(acc[ai][bj][m][n]));
    }
};

struct EpiQ {
    static constexpr bool PERM = false, AFTER_DRAIN = false;
    bf16_t* O; const float* rope; int nlat;
    __device__ __forceinline__ void operator()(const f32x4 (&acc)[2][2][4][2], const Unit& u, int wr, int wc, int fr, int fq) const {
        const int row0 = u.pm * BM + wr * 64 + fr;
#pragma unroll
        for (int bj = 0; bj < 2; ++bj) {
            const int g32 = u.pn * 8 + bj * 4 + wc; const bool isrope = (g32 % 3) == 2; const int colb = g32 * 32 + 4 * fq;
#pragma unroll
            for (int ai = 0; ai < 2; ++ai)
#pragma unroll
                for (int m = 0; m < 4; ++m) { const int row = row0 + ai * HALF + m * 16;
                    f32x4 v0 = acc[ai][bj][m][0], v1 = acc[ai][bj][m][1];
                    if (isrope && row < nlat) { const float* cs = rope + ((size_t)(row & 8191) * 16 + 4 * fq) * 2;
                        const f32x4 c01 = *(const f32x4*)cs, c23 = *(const f32x4*)(cs + 4);
                        const float c[4] = {c01[0], c01[2], c23[0], c23[2]}, s[4] = {c01[1], c01[3], c23[1], c23[3]};
                        f32x4 a, b;
#pragma unroll
                        for (int i = 0; i < 4; ++i) { a[i] = v0[i] * c[i] - v1[i] * s[i]; b[i] = v1[i] * c[i] + v0[i] * s[i]; }
                        v0 = a; v1 = b; }
                    bf16_t* p = O + (size_t)row * 768 + colb;
                    u32x2e w0, w1; w0.x = pkbf(v0[0], v0[1]); w0.y = pkbf(v0[2], v0[3]); w1.x = pkbf(v1[0], v1[1]); w1.y = pkbf(v1[2], v1[3]);
                    *(u32x2e*)p = w0; *(u32x2e*)(p + 16) = w1; }
        }
    }
};

struct EpiKV {
    static constexpr bool PERM = false, AFTER_DRAIN = false;
    __attribute__((address_space(1))) bf16_t* KB; __attribute__((address_space(1))) bf16_t* VT; int nlat, keys, ctxl;
    __device__ __forceinline__ void operator()(const f32x4 (&acc)[2][2][4][2], const Unit& u, int wr, int wc, int fr, int fq) const {
        const int row0 = u.pm * BM + wr * 64 + fr;
#pragma unroll
        for (int ai = 0; ai < 2; ++ai)
#pragma unroll
            for (int m = 0; m < 4; ++m) { const int row = row0 + ai * HALF + m * 16;
                int b, key; if (row < nlat) { b = row >> 13; key = ctxl + (row & 8191); } else { const int r2 = row - nlat; b = r2 >> 8; key = r2 & 255; }
#pragma unroll
                for (int bj = 0; bj < 2; ++bj) { const int head = u.pn * 2 + bj; const size_t bh = (size_t)(b * 8 + head);
#pragma unroll
                    for (int n = 0; n < 2; ++n) { const f32x4 v = acc[ai][bj][m][n]; const int cw = (wc & 1) * 32 + n * 16 + 4 * fq;
                        if (wc < 2) { u32x2e w; w.x = pkbf(v[0], v[1]); w.y = pkbf(v[2], v[3]); *(__attribute__((address_space(1))) u32x2e*)(KB + (bh * keys + key) * 96 + cw) = w; }
                        else { __attribute__((address_space(1))) bf16_t* p = VT + (bh * 64 + cw) * keys + key; const unsigned w0 = pkbf(v[0], v[1]), w1 = pkbf(v[2], v[3]);
                            p[0] = (bf16_t)(w0 & 0xffff); p[(size_t)keys] = (bf16_t)(w0 >> 16); p[(size_t)2 * keys] = (bf16_t)(w1 & 0xffff); p[(size_t)3 * keys] = (bf16_t)(w1 >> 16); } } }
                asm volatile("" ::: "memory"); }
    }
};

struct EpiMerge {
    static constexpr bool PERM = false, AFTER_DRAIN = false;
    const bf16_t* P; float* YM; bf16_t* YMB; int nPM, ldp, ogate;
    __device__ __forceinline__ void operator()(const f32x4 (&acc)[2][2][4][2], const Unit& u, int wr, int wc, int fr, int fq) const {
        const int br = u.pm / nPM, pm = u.pm - br * nPM, pn = u.pn & 3;
        const int row0 = pm * BM + wr * 64 + fr;
#pragma unroll
        for (int ai = 0; ai < 2; ++ai)
#pragma unroll
            for (int m = 0; m < 4; ++m) { const int row = row0 + ai * HALF + m * 16;
#pragma unroll
                for (int bj = 0; bj < 2; ++bj)
#pragma unroll
                    for (int n = 0; n < 2; ++n) { const int col = pn * BM + bj * HALF + wc * 32 + n * 16 + 4 * fq;
                        const u32x2e gw = *(const u32x2e*)(P + (size_t)row * ldp + ogate + br * 1024 + col);
                        const float g0 = __builtin_bit_cast(float, gw.x << 16), g1 = __builtin_bit_cast(float, gw.x & 0xffff0000u), g2 = __builtin_bit_cast(float, gw.y << 16), g3 = __builtin_bit_cast(float, gw.y & 0xffff0000u);
                        f32x4 v = acc[ai][bj][m][n];
                        v[0] *= 1.f / (1.f + __expf(-g0)); v[1] *= 1.f / (1.f + __expf(-g1)); v[2] *= 1.f / (1.f + __expf(-g2)); v[3] *= 1.f / (1.f + __expf(-g3));
                        float* yp = YM + (size_t)row * 1024 + col;
                        if (br == 0) *(f32x4*)yp = v;
                        else if (br == 1) { const f32x4 o = *(const f32x4*)yp; *(f32x4*)yp = o + v; }
                        else { const f32x4 o = *(const f32x4*)yp + v; u32x2e w; w.x = pkbf(o[0], o[1]); w.y = pkbf(o[2], o[3]); *(u32x2e*)(YMB + (size_t)row * 1024 + col) = w; } } }
    }
};

struct EpiOut {
    static constexpr bool PERM = false, AFTER_DRAIN = false;
    const __attribute__((address_space(1))) float* XL; const __attribute__((address_space(1))) float* XC; __attribute__((address_space(1))) float* XPRE; const __attribute__((address_space(1))) float* mod; int nlat; float alpha;
    __device__ __forceinline__ void operator()(const f32x4 (&acc)[2][2][4][2], const Unit& u, int wr, int wc, int fr, int fq) const {
        const int row0 = u.pm * BM + wr * 64 + fr;
#pragma unroll
        for (int ai = 0; ai < 2; ++ai)
#pragma unroll
            for (int m = 0; m < 4; ++m) { const int row = row0 + ai * HALF + m * 16; const int mi = row < nlat ? (row >> 13) : 2; const __attribute__((address_space(1))) float* xr = (row < nlat ? XL : XC) + (size_t)row * 1024;
#pragma unroll
                for (int bj = 0; bj < 2; ++bj)
#pragma unroll
                    for (int n = 0; n < 2; ++n) { const int col = u.pn * BM + bj * HALF + wc * 32 + n * 16 + 4 * fq;
                        const f32x4 g = *(const __attribute__((address_space(1))) f32x4*)(mod + mi * 6144 + 2048 + col), x = *(const __attribute__((address_space(1))) f32x4*)(xr + col);
                        *(__attribute__((address_space(1))) f32x4*)(XPRE + (size_t)row * 1024 + col) = x * alpha + g * acc[ai][bj][m][n]; } }
    }
};

struct EpiMoe1 {
    static constexpr bool PERM = false, AFTER_DRAIN = false;
    __attribute__((address_space(1))) bf16_t* ACT; const __attribute__((address_space(1))) float* b1;
    __device__ __forceinline__ void operator()(const f32x4 (&acc)[2][2][4][2], const Unit& u, int wr, int wc, int fr, int fq) const {
        const int e = u.pn >> 3, j = u.pn & 7; const int row0 = u.pm * BM + wr * 64 + fr; const __attribute__((address_space(1))) float* be = b1 + (size_t)e * 2048;
        const int colb = 128 * j + wc * 32 + 4 * fq;
        const f32x4 bg0 = *(const __attribute__((address_space(1))) f32x4*)(be + colb), bl0 = *(const __attribute__((address_space(1))) f32x4*)(be + 1024 + colb), bg1 = *(const __attribute__((address_space(1))) f32x4*)(be + colb + 16), bl1 = *(const __attribute__((address_space(1))) f32x4*)(be + 1024 + colb + 16);
#pragma unroll
        for (int ai = 0; ai < 2; ++ai)
#pragma unroll
            for (int m = 0; m < 4; ++m) { const int row = row0 + ai * HALF + m * 16; __attribute__((address_space(1))) bf16_t* op = ACT + (size_t)row * 1024 + colb;
#pragma unroll
                for (int n = 0; n < 2; ++n) { const f32x4 g = acc[ai][0][m][n] + (n ? bg1 : bg0), l = acc[ai][1][m][n] + (n ? bl1 : bl0); f32x4 o;
#pragma unroll
                    for (int i = 0; i < 4; ++i) { const float gg = fminf(g[i], 7.f), ll = fminf(fmaxf(l[i], -7.f), 7.f);
                        o[i] = gg * __builtin_amdgcn_rcpf(1.f + __builtin_amdgcn_exp2f(-1.702f * 1.4426950408889634f * gg)) * (ll + 1.f); }
                    u32x2e w; w.x = pkbf(o[0], o[1]); w.y = pkbf(o[2], o[3]); *(__attribute__((address_space(1))) u32x2e*)(op + n * 16) = w; }
                __builtin_amdgcn_sched_barrier(0); }
    }
};

struct EpiMoe2 {
    static constexpr bool PERM = false, AFTER_DRAIN = false;
    __attribute__((address_space(1))) bf16_t* YSLOT; const __attribute__((address_space(1))) float* b2; const __attribute__((address_space(1))) int* rslot; const __attribute__((address_space(1))) float* gate;
    __device__ __forceinline__ void operator()(const f32x4 (&acc)[2][2][4][2], const Unit& u, int wr, int wc, int fr, int fq) const {
        const int e = u.pn >> 2, j = u.pn & 3; const int row0 = u.pm * BM + wr * 64 + fr; const __attribute__((address_space(1))) float* be = b2 + (size_t)e * 1024;
#pragma unroll
        for (int ai = 0; ai < 2; ++ai)
#pragma unroll
            for (int m = 0; m < 4; ++m) { const int row = row0 + ai * HALF + m * 16; const int slot = rslot[row];
                if (slot >= 0) { const float gt = gate[slot];
#pragma unroll
                    for (int bj = 0; bj < 2; ++bj)
#pragma unroll
                        for (int n = 0; n < 2; ++n) { const int col = j * BM + bj * HALF + wc * 32 + n * 16 + 4 * fq;
                            const f32x4 o = (acc[ai][bj][m][n] + *(const __attribute__((address_space(1))) f32x4*)(be + col)) * gt;
                            u32x2e w; w.x = pkbf(o[0], o[1]); w.y = pkbf(o[2], o[3]); *(__attribute__((address_space(1))) u32x2e*)(YSLOT + (size_t)slot * 1024 + col) = w; } }
                __builtin_amdgcn_sched_barrier(0); }
    }
};

struct MergeOrder {
    int nPM, sPM, G, c;
    __device__ __forceinline__ bool next(int i, Unit& u) const {
        const int L = i * G + c; if (L >= nPM * 12) return false;
        const int t = L / 3, br = L - 3 * t, pm = t >> 2, pn = t & 3; u.pm = br * sPM + pm; u.pn = br * 4 + pn; return true;
    }
    __device__ __forceinline__ void a_ready(const Unit&) const {}
    __device__ __forceinline__ void done(const Unit&) const {}
};
template <int nN> struct MoeOrder {
    const PG8_LAS int* ptab; int npanel, G, c;
    __device__ __forceinline__ bool next(int i, Unit& u) const {
        constexpr int PB = 32 / nN; int pm, pn;
        if (G == 256) { const int x = c & 7, w = c >> 3, s = i * 8 + x; pm = s * PB + w / nN; pn = w % nN; }
        else { const int L = i * G + c; pm = L / nN; pn = L - pm * nN; }
        if (pm >= npanel) return false;
        const int e = __builtin_amdgcn_readfirstlane(ptab[pm]);
        u.pm = pm; u.pn = e * nN + pn; return true;
    }
    __device__ __forceinline__ void a_ready(const Unit&) const {}
    __device__ __forceinline__ void done(const Unit&) const {}
};
template <class Epi, class Sched, bool ALIGN_EPI = false, bool SP2 = false>
__device__ __forceinline__ void gemm_phase(PG8_LAS unsigned char* lds, const Gemm g, const Sched& S, const Epi& E, const int tid) {
    const int wid = __builtin_amdgcn_readfirstlane(tid >> 6), lane = tid & 63, wr = wid >> 2, wc = wid & 3, fr = lane & 15, fq = lane >> 4;
    const int K = g.K, nt = K / BK;
    unsigned voffA[2], voffB[2];
#pragma unroll
    for (int i = 0; i < 2; ++i) { int R, C; stage_rc(tid * 16 + i * 8192, R, C); const int Rb = Epi::PERM ? ((R & ~31) + perm32(R & 31)) : R;
        voffA[i] = (unsigned)(R * K + C) * 2u; voffB[i] = (unsigned)(Rb * K + C) * 2u; }
    const size_t kstep = (size_t)(BK * 2);
    const size_t hstep = (size_t)HALF * K * 2;
    const size_t tstep = 2 * hstep;
    const unsigned ldsw = (unsigned)wid * 1024u;
    const int aoff = lds_byte(wr * 64 + fr, fq * 8), boff = lds_byte(wc * 32 + fr, fq * 8);
#define PG8_SA(b, h) (((b) * 2 + (h)) * HTB)
#define PG8_SB(b, h) ((4 + (b) * 2 + (h)) * HTB)
#define PG8_STAGE(bufoff, gbase, voff) do { _Pragma("unroll") for (int _i = 0; _i < 2; ++_i) \
        __builtin_amdgcn_global_load_lds((const unsigned*)((const char*)(gbase) + (voff)[_i]), (PG8_LAS unsigned*)(lds + (bufoff) + ldsw + _i * 8192), 16, 0, 0); } while (0)
#define PG8_LDA(dst, b, h) do { _Pragma("unroll") for (int m = 0; m < 4; ++m) _Pragma("unroll") for (int k = 0; k < 2; ++k) dst[m][k] = *(const PG8_LAS bf16x8*)(lds + PG8_SA(b, h) + aoff + m * 2048 + k * 1024); } while (0)
#define PG8_LDB(dst, b, h) do { _Pragma("unroll") for (int n = 0; n < 2; ++n) _Pragma("unroll") for (int k = 0; k < 2; ++k) dst[n][k] = *(const PG8_LAS bf16x8*)(lds + PG8_SB(b, h) + boff + n * 2048 + k * 1024); } while (0)
#define PG8_MMA(ai, bj, At, Bt) do { __builtin_amdgcn_s_setprio(1); _Pragma("unroll") for (int m = 0; m < 4; ++m) _Pragma("unroll") for (int n = 0; n < 2; ++n) _Pragma("unroll") for (int k = 0; k < 2; ++k) \
        acc[ai][bj][m][n] = __builtin_amdgcn_mfma_f32_16x16x32_bf16(Bt[n][k], At[m][k], acc[ai][bj][m][n], 0, 0, 0); __builtin_amdgcn_s_setprio(0); } while (0)
#define PG8_WAIT_V(n) asm volatile("s_waitcnt vmcnt(" #n ")" ::: "memory")
#define PG8_WAIT_L(n) asm volatile("s_waitcnt lgkmcnt(" #n ")" ::: "memory")
#define PG8_BAR __builtin_amdgcn_s_barrier()
#define PG8_SCHED __builtin_amdgcn_sched_barrier(0)
    Unit cur, nxt; int ui = 0;
    if (!S.next(0, cur)) return;
    f32x4 acc[2][2][4][2];
#pragma unroll
    for (int a = 0; a < 2; ++a)
#pragma unroll
        for (int b = 0; b < 2; ++b)
#pragma unroll
            for (int m = 0; m < 4; ++m)
#pragma unroll
                for (int n = 0; n < 2; ++n) acc[a][b][m][n] = (f32x4){0.f, 0.f, 0.f, 0.f};
    bf16x8 At[4][2], B0[2][2], B1[2][2];
    const char* cA = (const char*)g.A + (size_t)cur.pm * tstep; const char* cB = (const char*)g.Bt + (size_t)cur.pn * tstep;
    S.a_ready(cur);
    if constexpr (SP2) {
        PG8_STAGE(PG8_SB(0, 0), cB, voffB); PG8_STAGE(PG8_SB(0, 1), cB + hstep, voffB); PG8_STAGE(PG8_SA(0, 0), cA, voffA); PG8_STAGE(PG8_SA(0, 1), cA + hstep, voffA);
        if (wr == 1) PG8_BAR;
        PG8_WAIT_V(2); PG8_BAR;
        PG8_STAGE(PG8_SB(1, 0), cB + kstep, voffB); PG8_STAGE(PG8_SA(1, 0), cA + kstep, voffA); PG8_STAGE(PG8_SB(1, 1), cB + hstep + kstep, voffB);
        PG8_WAIT_V(6); PG8_BAR;
    } else {
        PG8_STAGE(PG8_SB(0, 0), cB, voffB); PG8_STAGE(PG8_SA(0, 0), cA, voffA); PG8_STAGE(PG8_SB(0, 1), cB + hstep, voffB); PG8_STAGE(PG8_SA(0, 1), cA + hstep, voffA);
        if (wr == 1) PG8_BAR;
        PG8_WAIT_V(4); PG8_BAR;
        PG8_STAGE(PG8_SB(1, 0), cB + kstep, voffB); PG8_STAGE(PG8_SA(1, 0), cA + kstep, voffA); PG8_STAGE(PG8_SB(1, 1), cB + hstep + kstep, voffB);
        PG8_WAIT_V(6); PG8_BAR;
    }
    for (;;) {
        const bool has_next = S.next(ui + 1, nxt);
        const char* nA = has_next ? (const char*)g.A + (size_t)nxt.pm * tstep : cA; const char* nB = has_next ? (const char*)g.Bt + (size_t)nxt.pn * tstep : cB;
#pragma unroll 1
        for (int t = 0; t < nt; t += 2) {
            const bool last = (t == nt - 2);
            const char* a1 = cA + (size_t)(t + 1) * kstep;
            const char* a2 = last ? nA : cA + (size_t)(t + 2) * kstep; const char* b2 = last ? nB : cB + (size_t)(t + 2) * kstep;
            const char* a3 = a2 + kstep; const char* b3 = b2 + kstep;
            if (last && has_next) S.a_ready(nxt);
            if constexpr (SP2) {
            PG8_LDB(B0, 0, 0); PG8_LDB(B1, 0, 1); PG8_SCHED; PG8_LDA(At, 0, 0); PG8_STAGE(PG8_SA(1, 1), a1 + hstep, voffA);
            PG8_WAIT_V(8); PG8_WAIT_L(0); PG8_BAR; PG8_MMA(0, 0, At, B0); PG8_MMA(0, 1, At, B1); PG8_BAR; PG8_SCHED;
            PG8_LDA(At, 0, 1); PG8_STAGE(PG8_SB(0, 0), b2, voffB); PG8_STAGE(PG8_SB(0, 1), b2 + hstep, voffB); PG8_STAGE(PG8_SA(0, 0), a2, voffA);
            PG8_WAIT_V(8); PG8_WAIT_L(0); PG8_BAR; PG8_MMA(1, 0, At, B0); PG8_MMA(1, 1, At, B1); PG8_BAR; PG8_SCHED;
            PG8_LDB(B0, 1, 0); PG8_LDB(B1, 1, 1); PG8_SCHED; PG8_LDA(At, 1, 0); PG8_STAGE(PG8_SA(0, 1), a2 + hstep, voffA);
            PG8_WAIT_V(8); PG8_WAIT_L(0); PG8_BAR; PG8_MMA(0, 0, At, B0); PG8_MMA(0, 1, At, B1); PG8_BAR; PG8_SCHED;
            PG8_LDA(At, 1, 1); PG8_STAGE(PG8_SB(1, 0), b3, voffB); PG8_STAGE(PG8_SB(1, 1), b3 + hstep, voffB); PG8_STAGE(PG8_SA(1, 0), a3, voffA);
            PG8_WAIT_V(8); PG8_WAIT_L(0); PG8_BAR; PG8_MMA(1, 0, At, B0); PG8_MMA(1, 1, At, B1); PG8_BAR; PG8_SCHED;
            } else {
            PG8_LDB(B0, 0, 0); PG8_SCHED; PG8_LDA(At, 0, 0); PG8_STAGE(PG8_SA(1, 1), a1 + hstep, voffA);
            PG8_WAIT_L(8); PG8_BAR; PG8_WAIT_L(0); PG8_MMA(0, 0, At, B0); PG8_BAR; PG8_SCHED;
            PG8_LDB(B1, 0, 1); PG8_STAGE(PG8_SB(0, 0), b2, voffB);
            PG8_BAR; PG8_WAIT_L(0); PG8_MMA(0, 1, At, B1); PG8_BAR;
            PG8_LDA(At, 0, 1); PG8_STAGE(PG8_SA(0, 0), a2, voffA);
            PG8_BAR; PG8_WAIT_L(0); PG8_MMA(1, 0, At, B0); PG8_BAR; PG8_SCHED;
            PG8_STAGE(PG8_SB(0, 1), b2 + hstep, voffB);
            PG8_WAIT_V(6); PG8_BAR; PG8_MMA(1, 1, At, B1); PG8_BAR;
            PG8_LDB(B0, 1, 0); PG8_SCHED; PG8_LDA(At, 1, 0); PG8_STAGE(PG8_SA(0, 1), a2 + hstep, voffA);
            PG8_WAIT_L(8); PG8_BAR; PG8_WAIT_L(0); PG8_MMA(0, 0, At, B0); PG8_BAR; PG8_SCHED;
            PG8_LDB(B1, 1, 1); PG8_STAGE(PG8_SB(1, 0), b3, voffB);
            PG8_BAR; PG8_WAIT_L(0); PG8_MMA(0, 1, At, B1); PG8_BAR;
            PG8_LDA(At, 1, 1); PG8_STAGE(PG8_SA(1, 0), a3, voffA);
            PG8_BAR; PG8_WAIT_L(0); PG8_MMA(1, 0, At, B0); PG8_BAR; PG8_SCHED;
            PG8_STAGE(PG8_SB(1, 1), b3 + hstep, voffB);
            PG8_WAIT_V(6); PG8_BAR; PG8_MMA(1, 1, At, B1); PG8_BAR;
            }
        }
        if constexpr (ALIGN_EPI) { if (wr == 0) PG8_BAR; }
        if constexpr (!Epi::AFTER_DRAIN) { E(acc, cur, wr, wc, fr, fq); S.done(cur); }
        if (!has_next) break;
#pragma unroll
        for (int a = 0; a < 2; ++a)
#pragma unroll
            for (int b = 0; b < 2; ++b)
#pragma unroll
                for (int m = 0; m < 4; ++m)
#pragma unroll
                    for (int n = 0; n < 2; ++n) acc[a][b][m][n] = (f32x4){0.f, 0.f, 0.f, 0.f};
        cur = nxt; cA = nA; cB = nB; ++ui;
        if constexpr (ALIGN_EPI) { if (wr == 1) PG8_BAR; }
    }
    PG8_WAIT_V(0);
    if constexpr (!ALIGN_EPI) { if (wr == 0) PG8_BAR; }
    PG8_BAR;
    if constexpr (Epi::AFTER_DRAIN) { E.fused(acc, cur, wr, wc, fr, fq, lds, wid, lane); S.done(cur); }
#undef PG8_SA
#undef PG8_SB
#undef PG8_STAGE
#undef PG8_LDA
#undef PG8_LDB
#undef PG8_MMA
#undef PG8_WAIT_V
#undef PG8_WAIT_L
#undef PG8_BAR
#undef PG8_SCHED
}
template <class Epi, class Sched, bool ALIGN_EPI = false, bool SP2 = false>
__device__ __forceinline__ void gemm_phase_g(PG8_LAS unsigned char* lds, const Gemm g, const Sched& S, const Epi& E, const int tid, const __attribute__((address_space(1))) int* rsl) {
    static_assert(SP2, "gather variant: SP2 loop only");
    const int wid = __builtin_amdgcn_readfirstlane(tid >> 6), lane = tid & 63, wr = wid >> 2, wc = wid & 3, fr = lane & 15, fq = lane >> 4;
    const int K = g.K, nt = K / BK;
    unsigned voffA[2] = {0u, 0u}, voffB[2]; int srR[2], srC[2]; unsigned vAc[2][2], vAn[2][2];
#pragma unroll
    for (int i = 0; i < 2; ++i) { int R, C; stage_rc(tid * 16 + i * 8192, R, C); const int Rb = Epi::PERM ? ((R & ~31) + perm32(R & 31)) : R;
        srR[i] = R; srC[i] = C; voffB[i] = (unsigned)(Rb * K + C) * 2u; }
#define PG8_GCALC(dst, un) do { _Pragma("unroll") for (int h_ = 0; h_ < 2; ++h_) _Pragma("unroll") for (int i_ = 0; i_ < 2; ++i_) { const int rr_ = rsl[(un).pm * 256 + h_ * 128 + srR[i_]]; \
        dst[h_][i_] = (unsigned)(((rr_ < 0 ? 0 : (rr_ >> 2)) * K + srC[i_]) * 2); } } while (0)
    const size_t kstep = (size_t)(BK * 2);
    const size_t hstep = (size_t)HALF * K * 2;
    const size_t tstep = 2 * hstep;
    const unsigned ldsw = (unsigned)wid * 1024u;
    const int aoff = lds_byte(wr * 64 + fr, fq * 8), boff = lds_byte(wc * 32 + fr, fq * 8);
#define PG8_SA(b, h) (((b) * 2 + (h)) * HTB)
#define PG8_SB(b, h) ((4 + (b) * 2 + (h)) * HTB)
#define PG8_STAGE(bufoff, gbase, voff) do { _Pragma("unroll") for (int _i = 0; _i < 2; ++_i) \
        __builtin_amdgcn_global_load_lds((const unsigned*)((const char*)(gbase) + (voff)[_i]), (PG8_LAS unsigned*)(lds + (bufoff) + ldsw + _i * 8192), 16, 0, 0); } while (0)
#define PG8_LDA(dst, b, h) do { _Pragma("unroll") for (int m = 0; m < 4; ++m) _Pragma("unroll") for (int k = 0; k < 2; ++k) dst[m][k] = *(const PG8_LAS bf16x8*)(lds + PG8_SA(b, h) + aoff + m * 2048 + k * 1024); } while (0)
#define PG8_LDB(dst, b, h) do { _Pragma("unroll") for (int n = 0; n < 2; ++n) _Pragma("unroll") for (int k = 0; k < 2; ++k) dst[n][k] = *(const PG8_LAS bf16x8*)(lds + PG8_SB(b, h) + boff + n * 2048 + k * 1024); } while (0)
#define PG8_MMA(ai, bj, At, Bt) do { __builtin_amdgcn_s_setprio(1); _Pragma("unroll") for (int m = 0; m < 4; ++m) _Pragma("unroll") for (int n = 0; n < 2; ++n) _Pragma("unroll") for (int k = 0; k < 2; ++k) \
        acc[ai][bj][m][n] = __builtin_amdgcn_mfma_f32_16x16x32_bf16(Bt[n][k], At[m][k], acc[ai][bj][m][n], 0, 0, 0); __builtin_amdgcn_s_setprio(0); } while (0)
#define PG8_WAIT_V(n) asm volatile("s_waitcnt vmcnt(" #n ")" ::: "memory")
#define PG8_WAIT_L(n) asm volatile("s_waitcnt lgkmcnt(" #n ")" ::: "memory")
#define PG8_BAR __builtin_amdgcn_s_barrier()
#define PG8_SCHED __builtin_amdgcn_sched_barrier(0)
    Unit cur, nxt; int ui = 0;
    if (!S.next(0, cur)) return;
    f32x4 acc[2][2][4][2];
#pragma unroll
    for (int a = 0; a < 2; ++a)
#pragma unroll
        for (int b = 0; b < 2; ++b)
#pragma unroll
            for (int m = 0; m < 4; ++m)
#pragma unroll
                for (int n = 0; n < 2; ++n) acc[a][b][m][n] = (f32x4){0.f, 0.f, 0.f, 0.f};
    bf16x8 At[4][2], B0[2][2], B1[2][2];
    const char* cA = (const char*)g.A; PG8_GCALC(vAc, cur); const char* cB = (const char*)g.Bt + (size_t)cur.pn * tstep;
    S.a_ready(cur);
    if constexpr (SP2) {
        PG8_STAGE(PG8_SB(0, 0), cB, voffB); PG8_STAGE(PG8_SB(0, 1), cB + hstep, voffB); PG8_STAGE(PG8_SA(0, 0), cA, vAc[0]); PG8_STAGE(PG8_SA(0, 1), cA, vAc[1]);
        if (wr == 1) PG8_BAR;
        PG8_WAIT_V(2); PG8_BAR;
        PG8_STAGE(PG8_SB(1, 0), cB + kstep, voffB); PG8_STAGE(PG8_SA(1, 0), cA + kstep, vAc[0]); PG8_STAGE(PG8_SB(1, 1), cB + hstep + kstep, voffB);
        PG8_WAIT_V(6); PG8_BAR;
    } else {
        PG8_STAGE(PG8_SB(0, 0), cB, voffB); PG8_STAGE(PG8_SA(0, 0), cA, voffA); PG8_STAGE(PG8_SB(0, 1), cB + hstep, voffB); PG8_STAGE(PG8_SA(0, 1), cA + hstep, voffA);
        if (wr == 1) PG8_BAR;
        PG8_WAIT_V(4); PG8_BAR;
        PG8_STAGE(PG8_SB(1, 0), cB + kstep, voffB); PG8_STAGE(PG8_SA(1, 0), cA + kstep, voffA); PG8_STAGE(PG8_SB(1, 1), cB + hstep + kstep, voffB);
        PG8_WAIT_V(6); PG8_BAR;
    }
    for (;;) {
        const bool has_next = S.next(ui + 1, nxt);
        const char* nA = cA; if (has_next) PG8_GCALC(vAn, nxt); else { vAn[0][0] = vAc[0][0]; vAn[0][1] = vAc[0][1]; vAn[1][0] = vAc[1][0]; vAn[1][1] = vAc[1][1]; } const char* nB = has_next ? (const char*)g.Bt + (size_t)nxt.pn * tstep : cB;
#pragma unroll 1
        for (int t = 0; t < nt; t += 2) {
            const bool last = (t == nt - 2);
            const char* a1 = cA + (size_t)(t + 1) * kstep;
            const char* a2 = last ? nA : cA + (size_t)(t + 2) * kstep; const char* b2 = last ? nB : cB + (size_t)(t + 2) * kstep;
            const char* a3 = a2 + kstep; const char* b3 = b2 + kstep;
            if (last && has_next) S.a_ready(nxt);
            if constexpr (SP2) {
            PG8_LDB(B0, 0, 0); PG8_LDB(B1, 0, 1); PG8_SCHED; PG8_LDA(At, 0, 0); PG8_STAGE(PG8_SA(1, 1), a1, vAc[1]);
            PG8_WAIT_V(8); PG8_WAIT_L(0); PG8_BAR; PG8_MMA(0, 0, At, B0); PG8_MMA(0, 1, At, B1); PG8_BAR; PG8_SCHED;
            PG8_LDA(At, 0, 1); PG8_STAGE(PG8_SB(0, 0), b2, voffB); PG8_STAGE(PG8_SB(0, 1), b2 + hstep, voffB); PG8_STAGE(PG8_SA(0, 0), a2, (last ? vAn[0] : vAc[0]));
            PG8_WAIT_V(8); PG8_WAIT_L(0); PG8_BAR; PG8_MMA(1, 0, At, B0); PG8_MMA(1, 1, At, B1); PG8_BAR; PG8_SCHED;
            PG8_LDB(B0, 1, 0); PG8_LDB(B1, 1, 1); PG8_SCHED; PG8_LDA(At, 1, 0); PG8_STAGE(PG8_SA(0, 1), a2, (last ? vAn[1] : vAc[1]));
            PG8_WAIT_V(8); PG8_WAIT_L(0); PG8_BAR; PG8_MMA(0, 0, At, B0); PG8_MMA(0, 1, At, B1); PG8_BAR; PG8_SCHED;
            PG8_LDA(At, 1, 1); PG8_STAGE(PG8_SB(1, 0), b3, voffB); PG8_STAGE(PG8_SB(1, 1), b3 + hstep, voffB); PG8_STAGE(PG8_SA(1, 0), a3, (last ? vAn[0] : vAc[0]));
            PG8_WAIT_V(8); PG8_WAIT_L(0); PG8_BAR; PG8_MMA(1, 0, At, B0); PG8_MMA(1, 1, At, B1); PG8_BAR; PG8_SCHED;
            } else {
            PG8_LDB(B0, 0, 0); PG8_SCHED; PG8_LDA(At, 0, 0); PG8_STAGE(PG8_SA(1, 1), a1 + hstep, voffA);
            PG8_WAIT_L(8); PG8_BAR; PG8_WAIT_L(0); PG8_MMA(0, 0, At, B0); PG8_BAR; PG8_SCHED;
            PG8_LDB(B1, 0, 1); PG8_STAGE(PG8_SB(0, 0), b2, voffB);
            PG8_BAR; PG8_WAIT_L(0); PG8_MMA(0, 1, At, B1); PG8_BAR;
            PG8_LDA(At, 0, 1); PG8_STAGE(PG8_SA(0, 0), a2, voffA);
            PG8_BAR; PG8_WAIT_L(0); PG8_MMA(1, 0, At, B0); PG8_BAR; PG8_SCHED;
            PG8_STAGE(PG8_SB(0, 1), b2 + hstep, voffB);
            PG8_WAIT_V(6); PG8_BAR; PG8_MMA(1, 1, At, B1); PG8_BAR;
            PG8_LDB(B0, 1, 0); PG8_SCHED; PG8_LDA(At, 1, 0); PG8_STAGE(PG8_SA(0, 1), a2 + hstep, voffA);
            PG8_WAIT_L(8); PG8_BAR; PG8_WAIT_L(0); PG8_MMA(0, 0, At, B0); PG8_BAR; PG8_SCHED;
            PG8_LDB(B1, 1, 1); PG8_STAGE(PG8_SB(1, 0), b3, voffB);
            PG8_BAR; PG8_WAIT_L(0); PG8_MMA(0, 1, At, B1); PG8_BAR;
            PG8_LDA(At, 1, 1); PG8_STAGE(PG8_SA(1, 0), a3, voffA);
            PG8_BAR; PG8_WAIT_L(0); PG8_MMA(1, 0, At, B0); PG8_BAR; PG8_SCHED;
            PG8_STAGE(PG8_SB(1, 1), b3 + hstep, voffB);
            PG8_WAIT_V(6); PG8_BAR; PG8_MMA(1, 1, At, B1); PG8_BAR;
            }
        }
        if constexpr (ALIGN_EPI) { if (wr == 0) PG8_BAR; }
        if constexpr (!Epi::AFTER_DRAIN) { E(acc, cur, wr, wc, fr, fq); S.done(cur); }
        if (!has_next) break;
#pragma unroll
        for (int a = 0; a < 2; ++a)
#pragma unroll
            for (int b = 0; b < 2; ++b)
#pragma unroll
                for (int m = 0; m < 4; ++m)
#pragma unroll
                    for (int n = 0; n < 2; ++n) acc[a][b][m][n] = (f32x4){0.f, 0.f, 0.f, 0.f};
        cur = nxt; cA = nA; cB = nB; ++ui; vAc[0][0] = vAn[0][0]; vAc[0][1] = vAn[0][1]; vAc[1][0] = vAn[1][0]; vAc[1][1] = vAn[1][1];
        if constexpr (ALIGN_EPI) { if (wr == 1) PG8_BAR; }
    }
    PG8_WAIT_V(0);
    if constexpr (!ALIGN_EPI) { if (wr == 0) PG8_BAR; }
    PG8_BAR;
    if constexpr (Epi::AFTER_DRAIN) { E.fused(acc, cur, wr, wc, fr, fq, lds, wid, lane); S.done(cur); }
#undef PG8_GCALC
#undef PG8_SA
#undef PG8_SB
#undef PG8_STAGE
#undef PG8_LDA
#undef PG8_LDB
#undef PG8_MMA
#undef PG8_WAIT_V
#undef PG8_WAIT_L
#undef PG8_BAR
#undef PG8_SCHED
}
}

#define XB_TMO      128
#define XB_XCNT(j)  (256  + 64 * (j))
#define XB_XSUB(j)  (1280 + 64 * (j))
#define XB_XGEN(j)  (2304 + 64 * (j))
#define XB_TOP      3328
#define XB_TOPGEN   3392
#define XCD_BAR_WORDS 3456
#define XB_SPIN_CAP (1u << 18)

__device__ __forceinline__ unsigned xb_ld(unsigned* p)              { return __hip_atomic_load(p, __ATOMIC_RELAXED, __HIP_MEMORY_SCOPE_AGENT); }
__device__ __forceinline__ unsigned xb_add(unsigned* p, unsigned v) { return __hip_atomic_fetch_add(p, v, __ATOMIC_RELAXED, __HIP_MEMORY_SCOPE_AGENT); }
__device__ __forceinline__ unsigned xb_xcc_id() { return (unsigned)__builtin_amdgcn_s_getreg((3 << 11) | 20) & 0xFu; }
#define XB_SPIN(cond, bar) do { unsigned _sp = 0; while (cond) { __builtin_amdgcn_s_sleep(1); \
    if ((++_sp & 255u) == 0u) { if (xb_ld(&(bar)[XB_TMO])) break; if (_sp > XB_SPIN_CAP) { atomicAdd(&(bar)[XB_TMO], 1u); break; } } } } while (0)

struct XcdBarrier {
    unsigned* bar; unsigned x;
    volatile LAS unsigned* st;
};
__device__ __forceinline__ XcdBarrier xcd_barrier_post(unsigned* bar, volatile LAS unsigned* st) {
    XcdBarrier b; b.bar = bar; b.x = xb_xcc_id(); b.st = st;
    if (threadIdx.x == 0) (void)xb_add(&bar[XB_XCNT(b.x)], 1u);
    return b;
}
__device__ __forceinline__ void xcd_barrier_complete(unsigned* bar, unsigned x, unsigned& nloc, unsigned& nx) {
    const unsigned G = gridDim.x * gridDim.y * gridDim.z;
    unsigned sum, cnt, mine, sp = 0u;
    for (;;) {
        sum = 0u; cnt = 0u; mine = 0u;
#pragma unroll
        for (unsigned j = 0; j < 16; ++j) { const unsigned c = xb_ld(&bar[XB_XCNT(j)]); sum += c; cnt += (c > 0u) ? 1u : 0u; mine = (j == x) ? c : mine; }
        if (sum == G) break;
        __builtin_amdgcn_s_sleep(1);
        if ((++sp & 255u) == 0u) { if (xb_ld(&bar[XB_TMO])) break; if (sp > XB_SPIN_CAP) { atomicAdd(&bar[XB_TMO], 1u); break; } }
    }
    nloc = mine > 0u ? mine : 1u; nx = cnt > 0u ? cnt : 1u;
}
__device__ __forceinline__ void xcd_barrier(const XcdBarrier& b) {
    asm volatile("s_waitcnt vmcnt(0)" ::: "memory");
    __syncthreads();
    if (threadIdx.x == 0) {
        unsigned* bar = b.bar;
        __builtin_amdgcn_s_waitcnt(0);
        unsigned nloc = b.st[0], nx = b.st[1];
        if (nloc == 0u) { xcd_barrier_complete(bar, b.x, nloc, nx); b.st[0] = nloc; b.st[1] = nx; }
        const unsigned old = xb_add(&bar[XB_XSUB(b.x)], 1u);
        const unsigned gen = old / nloc;
        if (old + 1u == (gen + 1u) * nloc) {
            __builtin_amdgcn_fence(__ATOMIC_RELEASE, "agent");
            asm volatile("s_waitcnt vmcnt(0)" ::: "memory");
            const unsigned og = xb_add(&bar[XB_TOP], 1u);
            const unsigned tg = og / nx;
            if (og + 1u == (tg + 1u) * nx) xb_add(&bar[XB_TOPGEN], 1u);
            else XB_SPIN(xb_ld(&bar[XB_TOPGEN]) == tg, bar);
            __builtin_amdgcn_fence(__ATOMIC_ACQUIRE, "agent");
            xb_add(&bar[XB_XGEN(b.x)], 1u);
            asm volatile("s_waitcnt vmcnt(0)" ::: "memory");
        } else {
            XB_SPIN(xb_ld(&bar[XB_XGEN(b.x)]) == gen, bar);
            __builtin_amdgcn_fence(__ATOMIC_ACQUIRE, "agent");
            asm volatile("s_waitcnt vmcnt(0)" ::: "memory");
        }
    }
    __syncthreads();
}

struct Args { const float* in[39]; float* out; unsigned char* ws; int ph_lo, ph_hi, dupk, pad; };
enum { I_X = 0, I_C, I_CTX, I_CCTX, I_ADAW, I_ADAB, I_WIN, I_WA2F, I_BAF, I_WA2B, I_BAB, I_GNORM, I_QNORM, I_WUQ, I_KVNORM, I_WUKV, I_HCW, I_HCB, I_HW1, I_HB1, I_HW2, I_HB2, I_HW3, I_HFREQ,
       I_HBIAS, I_WBG, I_WBM, I_WBH, I_WOUT, I_LN1G, I_LN1B, I_LN2G, I_LN2B, I_RW, I_RB, I_MW1, I_MB1, I_MW2, I_MB2 };

__device__ __forceinline__ int opq(int i) { asm volatile("" : "+s"(i)); return i; }
#define INP(A, i) ((const float*)(const GAS float*)((A).in[opq(i)]))
struct Fr { LAS unsigned char* L; int tid, lane, wave, G, bid; };

__device__ __forceinline__ void tr_item(const float* W, int K, int N, bf16* WT, int mode, const float* kscale, float scale, LAS float* scr, int item, int lane) {
    const int nblk = N / 32, kb = item / nblk, nb = item - kb * nblk, k0 = 64 * kb, n0 = 32 * nb;
#pragma unroll
    for (int i = 0; i < 8; ++i) { const int kk = 8 * i + (lane >> 3), c4 = (lane & 7) * 4; f32x4 v = *(const GAS f32x4*)((const GAS float*)W + (size_t)(k0 + kk) * N + n0 + c4) * scale; if (kscale) v = v * kscale[k0 + kk];
        scr[kk * 33 + c4] = v[0]; scr[kk * 33 + c4 + 1] = v[1]; scr[kk * 33 + c4 + 2] = v[2]; scr[kk * 33 + c4 + 3] = v[3]; }
    LDS_WAIT(); asm volatile("" ::: "memory");
    const int c = lane & 7;
#pragma unroll
    for (int j = 0; j < 4; ++j) { const int n = (lane >> 3) + 8 * j; const LAS float* s = scr + (8 * c) * 33 + n;
        v4u o; o.x = pk2(s[0 * 33], s[1 * 33]); o.y = pk2(s[2 * 33], s[3 * 33]); o.z = pk2(s[4 * 33], s[5 * 33]); o.w = pk2(s[6 * 33], s[7 * 33]);
        int nn = n0 + n; if (mode == 1) { nn = nn < 1024 ? ((nn >> 7) * 256 + (nn & 127)) : ((((nn - 1024) >> 7) * 256) + 128 + ((nn - 1024) & 127)); }
        *(GAS v4u*)((GAS bf16*)WT + (size_t)nn * K + k0 + 8 * c) = o; }
    LDS_WAIT(); asm volatile("" ::: "memory");
}

__device__ __forceinline__ float silu_(float x) { return x / (1.f + expf(-x)); }

__device__ __forceinline__ void hy_filter_item(LAS unsigned char* L_, int tid_, const float* w1, const float* b1, const float* w2, const float* b2, const float* fr, const float* w3, int Ln, int blk, float* FILT, float* HP) {
    LAS float* zE = (LAS float*)L_;
    LAS float* h1 = zE + 32 * 36;
    LAS float* h2 = h1 + 32 * 64;
    const int tid = tid_, p0 = blk * 32;
    { const int p = tid >> 4, j = tid & 15; const int i = p0 + p;
      const float w = 6.283185307179586f * (float)i / (float)Ln; const float f = 1e-4f + (float)j * ((15.f - 1e-4f) / 15.f); const float ang = f * w;
      zE[p * 36 + 1 + j] = __cosf(ang); zE[p * 36 + 17 + j] = -__sinf(ang); if (j == 0) zE[p * 36] = (float)i / (float)(Ln - 1); }
    __syncthreads();
    { const int n = tid & 63; const float frn = fr[n], bn = b1[n];
#pragma unroll 1
      for (int q = 0; q < 4; ++q) { const int p = (tid >> 6) + 8 * q; float s = bn;
#pragma unroll 3
          for (int k = 0; k < 33; ++k) s += zE[p * 36 + k] * w1[k * 64 + n];
          h1[p * 64 + n] = __sinf(frn * s); } }
    __syncthreads();
    { const int n = tid & 63; const float frn = fr[n], bn = b2[n];
#pragma unroll 1
      for (int q = 0; q < 4; ++q) { const int p = (tid >> 6) + 8 * q; float s = bn;
#pragma unroll 4
          for (int k = 0; k < 64; ++k) s += h1[p * 64 + k] * w2[k * 64 + n];
          h2[p * 64 + n] = __sinf(frn * s); } }
    __syncthreads();
    { const int lane = tid & 63, wave_ = tid >> 6, r = lane & 31, hh = lane >> 5; const float d0 = -3.0701134573253945f, d1 = -15.350567286626972f;
      for (int cbk = wave_; cbk < 16; cbk += 8) { const int c = cbk * 32 + r; const float delta = fabsf(d0 + (float)c * ((d1 - d0) / 511.f));
          for (int o_ = 0; o_ < 2; ++o_) { float asum = 0.f;
              for (int dr = 0; dr < 2; ++dr) { const int j = (o_ * 2 + dr) * 512 + c; f32x16 acc;
#pragma unroll
                  for (int i = 0; i < 16; ++i) acc[i] = 0.f;
                  float bw[32];
#pragma unroll
                  for (int st = 0; st < 32; ++st) bw[st] = w3[(size_t)(2 * st + hh) * 2048 + j];
#pragma unroll
                  for (int st = 0; st < 32; ++st) acc = __builtin_amdgcn_mfma_f32_32x32x2f32(h2[r * 64 + 2 * st + hh], bw[st], acc, 0, 0, 0);
                  float* dst = FILT + ((size_t)j * Ln + p0);
#pragma unroll
                  for (int g = 0; g < 4; ++g) { f32x4 o;
#pragma unroll
                      for (int i = 0; i < 4; ++i) { const int p = 8 * g + 4 * hh + i; const float v = acc[4 * g + i] * __builtin_amdgcn_exp2f(-zE[p * 36] * delta * 1.4426950408889634f); o[i] = v; asum += fabsf(v); }
                      *(f32x4*)(dst + 8 * g + 4 * hh) = o; } }
              asum += __shfl_xor(asum, 32);
              if (hh == 0) HP[((size_t)blk * 2 + o_) * 512 + c] = asum; } } }
    __syncthreads();
}

__device__ __forceinline__ void ln_mod_row(const float* xrow, const float* sh, const float* sc, bf16* orow, int lane) {
    const f32x4* xr = (const f32x4*)xrow + lane; f32x4 v[4]; float s = 0.f;
#pragma unroll
    for (int j = 0; j < 4; ++j) { v[j] = xr[64 * j]; s += (v[j].x + v[j].y) + (v[j].z + v[j].w); }
    const float mean = wave_sum(s) * (1.f / D); float s2 = 0.f;
#pragma unroll
    for (int j = 0; j < 4; ++j) { v[j] = v[j] - mean; s2 += (v[j].x * v[j].x + v[j].y * v[j].y) + (v[j].z * v[j].z + v[j].w * v[j].w); }
    const float rstd = 1.f / sqrtf(wave_sum(s2) * (1.f / D) + LN_EPS);
    v2u* o8 = (v2u*)orow + lane;
#pragma unroll
    for (int j = 0; j < 4; ++j) { const f32x4 a = ((const f32x4*)sc)[lane + 64 * j], b = ((const f32x4*)sh)[lane + 64 * j]; const f32x4 y = v[j] * rstd * (a + 1.f) + b;
        v2u w; w.x = pk2(y.x, y.y); w.y = pk2(y.z, y.w); o8[64 * j] = w; }
}

__device__ __forceinline__ f32x2 cmul(f32x2 a, f32x2 b) { const f32x2 axx = __builtin_shufflevector(a, a, 0, 0), ayy = __builtin_shufflevector(a, a, 1, 1); f32x2 bs = __builtin_shufflevector(b, b, 1, 0); bs.x = -bs.x;
    return __builtin_elementwise_fma(ayy, bs, axx * b); }
__device__ __forceinline__ f32x2 cmulc(f32x2 a, f32x2 b) {
    const f32x2 bxx = __builtin_shufflevector(b, b, 0, 0), byy = __builtin_shufflevector(b, b, 1, 1); f32x2 as = __builtin_shufflevector(a, a, 1, 0); as.y = -as.y;
    return __builtin_elementwise_fma(as, byy, a * bxx); }
__device__ __forceinline__ f32x4 cswn(f32x4 w) { f32x4 r = __builtin_shufflevector(w, w, 1, 0, 3, 2); r.x = -r.x; r.z = -r.z; return r; }
__device__ __forceinline__ f32x4 cmul4(f32x4 x, f32x4 w, f32x4 wsn) { return __builtin_elementwise_fma(__builtin_shufflevector(x, x, 1, 1, 3, 3), wsn, __builtin_shufflevector(x, x, 0, 0, 2, 2) * w); }
__device__ __forceinline__ f32x4 cmulc4(f32x4 x, f32x4 w, f32x4 wsn) { return __builtin_shufflevector(x, x, 0, 0, 2, 2) * w - __builtin_shufflevector(x, x, 1, 1, 3, 3) * wsn; }
__device__ __forceinline__ int fpad(int i) { return i + 2 * (i >> 4); }
constexpr int FFT_LDS_ELEMS = FFTN + FFTN / 8;
__device__ __forceinline__ void fft16_dif(f32x2 (&x)[16]) {
    constexpr float wr[8] = {1.000000000e+00f, 9.238795325e-01f, 7.071067812e-01f, 3.826834324e-01f, 6.123233996e-17f, -3.826834324e-01f, -7.071067812e-01f, -9.238795325e-01f}, wi[8] = {-0.000000000e+00f, -3.826834324e-01f, -7.071067812e-01f, -9.238795325e-01f, -1.000000000e+00f, -9.238795325e-01f, -7.071067812e-01f, -3.826834324e-01f};
#pragma unroll
    for (int m = 16; m >= 2; m >>= 1) {
#pragma unroll
        for (int base = 0; base < 16; base += m)
#pragma unroll
            for (int j = 0; j < m / 2; ++j) { const f32x2 a = x[base + j], b = x[base + j + m / 2]; const f32x2 d = a - b; x[base + j] = a + b;
                const float cr = wr[j * (16 / m)], ci = wi[j * (16 / m)]; f32x2 t; t.x = d.x * cr - d.y * ci; t.y = d.x * ci + d.y * cr; x[base + j + m / 2] = t; }
    }
}
__device__ __forceinline__ void fft16_dit_inv(f32x2 (&x)[16]) {
    constexpr float wr[8] = {1.000000000e+00f, 9.238795325e-01f, 7.071067812e-01f, 3.826834324e-01f, 6.123233996e-17f, -3.826834324e-01f, -7.071067812e-01f, -9.238795325e-01f}, wi[8] = {-0.000000000e+00f, -3.826834324e-01f, -7.071067812e-01f, -9.238795325e-01f, -1.000000000e+00f, -9.238795325e-01f, -7.071067812e-01f, -3.826834324e-01f};
#pragma unroll
    for (int m = 2; m <= 16; m <<= 1) {
#pragma unroll
        for (int base = 0; base < 16; base += m)
#pragma unroll
            for (int j = 0; j < m / 2; ++j) { const f32x2 a = x[base + j], b = x[base + j + m / 2]; const float cr = wr[j * (16 / m)], ci = -wi[j * (16 / m)];
                f32x2 t; t.x = b.x * cr - b.y * ci; t.y = b.x * ci + b.y * cr; x[base + j] = a + t; x[base + j + m / 2] = a - t; }
    }
}
template <bool INV, int M> __device__ __forceinline__ void fft_r16_pass(LAS f32x2* X, const GAS f32x2* TW, int tid) {
    constexpr int Q = M / 16, PQ = Q + 2 * (Q / 16);
#pragma unroll 2
    for (int g = tid; g < FFTN / 16; g += 512) {
        const int j = g & (Q - 1), i0 = (g / Q) * M + j; LAS f32x2* p = X + fpad(i0);
        f32x2 x[16], pw[16];
#pragma unroll
        for (int k = 0; k < 16; ++k) x[k] = p[k * PQ];
        const f32x2 t = TW[j * (FFTN / M)];
        pw[1] = t; pw[2] = cmul(t, t); pw[3] = cmul(pw[2], t); pw[4] = cmul(pw[2], pw[2]); pw[5] = cmul(pw[4], t); pw[6] = cmul(pw[4], pw[2]); pw[7] = cmul(pw[4], pw[3]); pw[8] = cmul(pw[4], pw[4]);
#pragma unroll
        for (int k = 1; k < 8; ++k) pw[8 + k] = cmul(pw[8], pw[k]);
        if (!INV) { fft16_dif(x);
#pragma unroll
            for (int k = 1; k < 16; ++k) { constexpr int dummy = 0; (void)dummy; const int f = ((k & 1) << 3) | ((k & 2) << 1) | ((k & 4) >> 1) | ((k & 8) >> 3); x[k] = cmul(x[k], pw[f]); } }
        else {
#pragma unroll
            for (int k = 1; k < 16; ++k) { const int f = ((k & 1) << 3) | ((k & 2) << 1) | ((k & 4) >> 1) | ((k & 8) >> 3); x[k] = cmulc(x[k], pw[f]); }
            fft16_dit_inv(x); }
#pragma unroll
        for (int k = 0; k < 16; ++k) p[k * PQ] = x[k];
    }
    __syncthreads();
}
__device__ __forceinline__ f32x2 twl(const LAS f32x2* TL, int idx) { return cmul(TL[idx & 63], TL[64 + (idx >> 6)]); }
__device__ __forceinline__ void fft_fwd(LAS f32x2* X, const GAS f32x2* TL, int tid) {
    { const int m = FFTN;
        const int q = m >> 2, lq = 31 - __builtin_clz(q), ts = FFTN / m;
#pragma unroll 2
        for (int g = tid; g < FFTN / 8; g += 512) {
            const int j = (g & (q / 2 - 1)) * 2, i0 = (g >> (lq - 1)) * m + j;
            LAS f32x4* P0 = (LAS f32x4*)(X + fpad(i0)); LAS f32x4* P1 = (LAS f32x4*)(X + fpad(i0 + q)); LAS f32x4* P2 = (LAS f32x4*)(X + fpad(i0 + 2 * q)); LAS f32x4* P3 = (LAS f32x4*)(X + fpad(i0 + 3 * q));
            const f32x4 x0 = *P0, x1 = *P1, x2 = *P2, x3 = *P3;
            const f32x2 w1a = TL[j * ts], w1b = TL[(j + 1) * ts];
            const f32x4 w1 = __builtin_shufflevector(w1a, w1b, 0, 1, 2, 3), w1s = cswn(w1), w2 = cmul4(w1, w1, w1s), w2s = cswn(w2);
            const f32x4 a0 = x0 + x2, d02 = x0 - x2, a1 = x1 + x3, t = x1 - x3;
            f32x4 tr = __builtin_shufflevector(t, t, 1, 0, 3, 2); tr.y = -tr.y; tr.w = -tr.w;
            const f32x4 a2 = cmul4(d02, w1, w1s), a3 = cmul4(tr, w1, w1s);
            const f32x4 o0 = a0 + a1, o1 = cmul4(a0 - a1, w2, w2s), o2 = a2 + a3, o3 = cmul4(a2 - a3, w2, w2s);
            *P0 = o0; *P1 = o1; *P2 = o2; *P3 = o3;
        }
        __syncthreads();
    }
    fft_r16_pass<false, 4096>(X, TL, tid);
    fft_r16_pass<false, 256>(X, TL, tid);
#pragma unroll 2
    for (int blk = tid; blk < FFTN / 16; blk += 512) { LAS f32x4* p = (LAS f32x4*)(X + blk * 18); f32x2 x[16];
#pragma unroll
        for (int i = 0; i < 8; ++i) { const f32x4 v = p[i]; x[2 * i].x = v[0]; x[2 * i].y = v[1]; x[2 * i + 1].x = v[2]; x[2 * i + 1].y = v[3]; }
        fft16_dif(x);
#pragma unroll
        for (int i = 0; i < 8; ++i) { f32x4 v; v[0] = x[2 * i].x; v[1] = x[2 * i].y; v[2] = x[2 * i + 1].x; v[3] = x[2 * i + 1].y; p[i] = v; } }
    __syncthreads();
}
__device__ __forceinline__ void fft_inv(LAS f32x2* X, const GAS f32x2* TL, int tid) {
#pragma unroll 2
    for (int blk = tid; blk < FFTN / 16; blk += 512) { LAS f32x4* p = (LAS f32x4*)(X + blk * 18); f32x2 x[16];
#pragma unroll
        for (int i = 0; i < 8; ++i) { const f32x4 v = p[i]; x[2 * i].x = v[0]; x[2 * i].y = v[1]; x[2 * i + 1].x = v[2]; x[2 * i + 1].y = v[3]; }
        fft16_dit_inv(x);
#pragma unroll
        for (int i = 0; i < 8; ++i) { f32x4 v; v[0] = x[2 * i].x; v[1] = x[2 * i].y; v[2] = x[2 * i + 1].x; v[3] = x[2 * i + 1].y; p[i] = v; } }
    __syncthreads();
    fft_r16_pass<true, 256>(X, TL, tid);
    fft_r16_pass<true, 4096>(X, TL, tid);
    { const int m = FFTN / 2;
        const int hm = m >> 1, lh = 31 - __builtin_clz(hm), ts1 = FFTN / m, ts2 = FFTN / (2 * m);
#pragma unroll 2
        for (int g = tid; g < FFTN / 8; g += 512) {
            const int j = (g & (hm / 2 - 1)) * 2, i0 = (g >> (lh - 1)) * 2 * m + j;
            LAS f32x4* P0 = (LAS f32x4*)(X + fpad(i0)); LAS f32x4* P1 = (LAS f32x4*)(X + fpad(i0 + hm)); LAS f32x4* P2 = (LAS f32x4*)(X + fpad(i0 + m)); LAS f32x4* P3 = (LAS f32x4*)(X + fpad(i0 + m + hm));
            const f32x4 x0 = *P0, x1 = *P1, x2 = *P2, x3 = *P3;
            const f32x2 w2a = TL[j * ts2], w2b = TL[(j + 1) * ts2];
            f32x4 w2 = __builtin_shufflevector(w2a, w2b, 0, 1, 2, 3); w2.y = -w2.y; w2.w = -w2.w;
            const f32x4 w2s = cswn(w2), w = cmul4(w2, w2, w2s), ws = cswn(w);
            const f32x4 t1 = cmul4(x1, w, ws), t3 = cmul4(x3, w, ws);
            const f32x4 a0 = x0 + t1, a1 = x0 - t1, a2 = x2 + t3, a3 = x2 - t3;
            const f32x4 u2 = cmul4(a2, w2, w2s), u3 = cmul4(a3, w2, w2s);
            f32x4 iu3 = __builtin_shufflevector(u3, u3, 1, 0, 3, 2); iu3.x = -iu3.x; iu3.z = -iu3.z;
            const f32x4 o0 = a0 + u2, o1 = a1 + iu3, o2 = a0 - u2, o3 = a1 - iu3;
            *P0 = o0; *P1 = o1; *P2 = o2; *P3 = o3;
        }
        __syncthreads();
    }
}
__device__ __forceinline__ void fft_table(LAS f32x2* TL, const GAS f32x2* TW, int tid) { if (tid < 320) TL[tid] = tid < 64 ? TW[tid] : TW[(tid - 64) * 64]; }
__device__ __forceinline__ int brev14(int p) { return (int)(__builtin_bitreverse32((unsigned)p) >> 18); }

__device__ __forceinline__ void kspec_item(const Fr& F, const unsigned char* ws, int c) {
    LAS f32x2* X = (LAS f32x2*)F.L; LAS float* red = (LAS float*)(F.L + LDS_TAB);
    const GAS float* HP = (const GAS float*)(ws + WS_HPART); const GAS float* FILT = (const GAS float*)(ws + WS_FILT); const GAS f32x2* TW = (const GAS f32x2*)(ws + WS_TW);
    const int tid = F.tid; const GAS f32x2* TL = TW;
    if (tid < 256) { const float v0 = wave_sum(HP[((size_t)tid * 2 + 0) * 512 + c]), v1 = wave_sum(HP[((size_t)tid * 2 + 1) * 512 + c]); if (F.lane == 0) { red[F.wave * 2] = v0; red[F.wave * 2 + 1] = v1; } }
    __syncthreads();
    const float inv0 = 1.f / (((red[0] + red[2]) + red[4]) + red[6]), inv1 = 1.f / (((red[1] + red[3]) + red[5]) + red[7]);
    const GAS float* f0 = FILT + ((size_t)0 * 512 + c) * 8192; const GAS float* b0 = FILT + ((size_t)1 * 512 + c) * 8192; const GAS float* f1 = FILT + ((size_t)2 * 512 + c) * 8192; const GAS float* b1 = FILT + ((size_t)3 * 512 + c) * 8192;
    for (int s = tid; s < 8192; s += 512) { f32x2 v; v.x = f0[s] * inv0; v.y = f1[s] * inv1; X[fpad(s)] = v;
        f32x2 w; if (s == 0) { w.x = 0.f; w.y = 0.f; } else { w.x = b0[8192 - s] * inv0; w.y = b1[8192 - s] * inv1; } X[fpad(8192 + s)] = w; }
    __syncthreads();
    fft_fwd(X, TL, tid);
    GAS f32x2* K0 = (GAS f32x2*)(ws + WS_K0S) + (size_t)c * FFTN; GAS f32x2* K1 = (GAS f32x2*)(ws + WS_K1S) + (size_t)c * FFTN;
    const float sc = 0.5f / (float)FFTN;
    for (int p = tid; p < FFTN; p += 512) { const int f = brev14(p), p2 = brev14((FFTN - f) & (FFTN - 1)); const f32x2 A = X[fpad(p)], B = X[fpad(p2)];
        f32x2 k0, k1; k0.x = (A.x + B.x) * sc; k0.y = (A.y - B.y) * sc; k1.x = (A.y + B.y) * sc; k1.y = (B.x - A.x) * sc; K0[p] = k0; K1[p] = k1; }
    __syncthreads();
}

__device__ __forceinline__ void hyconv_item(const Fr& F, const Args& a, const unsigned char* ws, int l, int c) {
    LAS f32x2* X = (LAS f32x2*)F.L; const GAS f32x2* TW = (const GAS f32x2*)(ws + WS_TW); const int tid = F.tid;
    const GAS bf16* vT = (const GAS bf16*)(ws + WS_HYT) + (size_t)c * NLAT; const GAS bf16* x1T = vT + (size_t)512 * NLAT; const GAS bf16* x2T = vT + (size_t)1024 * NLAT;
    const GAS f32x2* K0 = (const GAS f32x2*)(ws + WS_K0S) + (size_t)c * FFTN; const GAS f32x2* K1 = (const GAS f32x2*)(ws + WS_K1S) + (size_t)c * FFTN;
    const float bias0 = INP(a, I_HBIAS)[(size_t)l * 1024 + c], bias1 = INP(a, I_HBIAS)[(size_t)l * 1024 + 512 + c];
    f32x2 zero; zero.x = 0.f; zero.y = 0.f; const GAS f32x2* TL = TW;
#pragma unroll
    for (int i = 0; i < 16; ++i) { const int s = tid + 512 * i; f32x2 v; v.x = bf2f(vT[s]); v.y = bf2f(vT[8192 + s]); X[fpad(s)] = v; X[fpad(8192 + s)] = zero; }
    __syncthreads();
    fft_fwd(X, TL, tid);
    for (int p = tid; p < FFTN; p += 512) X[fpad(p)] = cmul(X[fpad(p)], K0[p]);
    __syncthreads();
    fft_inv(X, TL, tid);
    float z0[16], z1[16];
#pragma unroll
    for (int i = 0; i < 16; ++i) { const int s = tid + 512 * i; const f32x2 y = X[fpad(s)];
        z0[i] = bf2f(x1T[s]) * (y.x + bias0 * bf2f(vT[s])); z1[i] = bf2f(x1T[8192 + s]) * (y.y + bias0 * bf2f(vT[8192 + s]));
        f32x2 v; v.x = z0[i]; v.y = z1[i]; X[fpad(s)] = v; X[fpad(8192 + s)] = zero; }
    __syncthreads();
    fft_fwd(X, TL, tid);
    for (int p = tid; p < FFTN; p += 512) X[fpad(p)] = cmul(X[fpad(p)], K1[p]);
    __syncthreads();
    fft_inv(X, TL, tid);
    GAS bf16* o = (GAS bf16*)(ws + WS_OHYT) + (size_t)c * NLAT;
#pragma unroll
    for (int i = 0; i < 16; ++i) { const int s = tid + 512 * i; const f32x2 y = X[fpad(s)];
        o[s] = (bf16)f2bf(bf2f(x2T[s]) * (y.x + bias1 * z0[i])); o[8192 + s] = (bf16)f2bf(bf2f(x2T[8192 + s]) * (y.y + bias1 * z1[i])); }
    __syncthreads();
}

__device__ __forceinline__ void hyctx_item(const Fr& F, const Args& a, const unsigned char* ws, int l, int c) {
    LAS float* fl = (LAS float*)F.L;
    LAS float* vv = fl + 1024;
    LAS float* zz = vv + 512;
    LAS float* red = zz + 512;
    const float* HP = (const float*)(ws + WS_HPARTC); const float* FC = (const float*)(ws + WS_FILTC); const int tid = F.tid;
    if (tid < 16) red[tid] = HP[((size_t)(tid >> 1) * 2 + (tid & 1)) * 512 + c];
    __syncthreads();
    float s0 = 0.f, s1 = 0.f;
#pragma unroll
    for (int k = 0; k < 8; ++k) { s0 += red[2 * k]; s1 += red[2 * k + 1]; }
    const float inv0 = 1.f / s0, inv1 = 1.f / s1;
    const bf16* T = (const bf16*)(ws + WS_HYTC);
    for (int i = tid; i < 1024; i += 512) { const int q = i >> 8, s = i & 255; fl[i] = FC[((size_t)q * 512 + c) * 256 + s] * (q < 2 ? inv0 : inv1); }
    const int b = tid >> 8, t = tid & 255;
    const float v = bf2f(T[((size_t)c * 2 + b) * 256 + t]), x1 = bf2f(T[((size_t)(512 + c) * 2 + b) * 256 + t]), x2 = bf2f(T[((size_t)(1024 + c) * 2 + b) * 256 + t]);
    vv[tid] = v;
    __syncthreads();
    const float bias0 = INP(a, I_HBIAS)[(size_t)l * 1024 + c], bias1 = INP(a, I_HBIAS)[(size_t)l * 1024 + 512 + c];
    float y = 0.f;
    for (int s = 0; s <= t; ++s) y += fl[t - s] * vv[b * 256 + s];
    for (int s = t + 1; s < 256; ++s) y += fl[256 + s - t] * vv[b * 256 + s];
    const float z = x1 * (y + bias0 * v);
    zz[tid] = z;
    __syncthreads();
    float y2 = 0.f;
    for (int s = 0; s <= t; ++s) y2 += fl[512 + t - s] * zz[b * 256 + s];
    for (int s = t + 1; s < 256; ++s) y2 += fl[768 + s - t] * zz[b * 256 + s];
    bf16* OBR2 = (bf16*)(ws + WS_OBR) + (size_t)2 * MALL * 512;
    OBR2[(size_t)(NLAT + b * 256 + t) * 512 + c] = (bf16)f2bf(x2 * (y2 + bias1 * z));
    __syncthreads();
}

__device__ __forceinline__ void conv3_item(const Fr& F, const Args& a, const GAS bf16* Prows  , int Ls, GAS bf16* HT  , int l, int t0, int c0) {
    LAS float* T = (LAS float*)F.L;
    const int tid = F.tid;
    for (int idx = tid; idx < 130 * 8; idx += 512) { const int r = idx >> 3, c8 = (idx & 7) * 8; const int t = t0 - 1 + r;
        v4u v = (v4u){0u, 0u, 0u, 0u}; if (t >= 0 && t < Ls) v = *(const GAS v4u*)(Prows + (size_t)t * INPAD + O_HY + c0 + c8);
        LAS float* d = T + r * 65 + c8; d[0] = bflo(v.x); d[1] = bfhi(v.x); d[2] = bflo(v.y); d[3] = bfhi(v.y); d[4] = bflo(v.z); d[5] = bfhi(v.z); d[6] = bflo(v.w); d[7] = bfhi(v.w); }
    __syncthreads();
    const int cc = tid >> 3, tq = tid & 7; const int c3 = c0 + cc;
    const GAS float* cw = (const GAS float*)INP(a, I_HCW) + (size_t)l * 3 * 1536; const float w0 = cw[c3], w1 = cw[1536 + c3], w2 = cw[3072 + c3], bb = ((const GAS float*)INP(a, I_HCB))[(size_t)l * 1536 + c3];
#pragma unroll
    for (int hh = 0; hh < 2; ++hh) { float y[8];
#pragma unroll
        for (int j = 0; j < 8; ++j) { const int t = hh * 64 + tq * 8 + j; y[j] = T[t * 65 + cc] * w0 + T[(t + 1) * 65 + cc] * w1 + T[(t + 2) * 65 + cc] * w2 + bb; }
        v4u o; o.x = pk2(y[0], y[1]); o.y = pk2(y[2], y[3]); o.z = pk2(y[4], y[5]); o.w = pk2(y[6], y[7]);
        *(GAS v4u*)(HT + (size_t)c3 * (2 * Ls) + t0 + hh * 64 + tq * 8) = o; }
    __syncthreads();
}

__device__ __forceinline__ void post_row(const Fr& F, const Args& a, unsigned char* ws, int l, int row, const LAS float* wa  ) {
    const int lane = F.lane; const bf16* pr = (const bf16*)(ws + WS_P) + (size_t)row * INPAD;
    { float v[6]; float ss = 0.f;
#pragma unroll
      for (int j = 0; j < 3; ++j) { const unsigned w = *(const unsigned*)(pr + O_MQA + 2 * lane + 128 * j); v[2 * j] = bflo(w); v[2 * j + 1] = bfhi(w); ss += v[2 * j] * v[2 * j] + v[2 * j + 1] * v[2 * j + 1]; }
      const float r = 1.f / sqrtf(wave_sum(ss) * (1.f / 384.f) + RMS_EPS); bf16* o = (bf16*)(ws + WS_NQ) + (size_t)row * 384;
#pragma unroll
      for (int j = 0; j < 3; ++j) *(unsigned*)(o + 2 * lane + 128 * j) = pk2(v[2 * j] * r, v[2 * j + 1] * r); }
    { float v[4]; float ss = 0.f;
#pragma unroll
      for (int j = 0; j < 2; ++j) { const unsigned w = *(const unsigned*)(pr + O_MKVA + 2 * lane + 128 * j); v[2 * j] = bflo(w); v[2 * j + 1] = bfhi(w); ss += v[2 * j] * v[2 * j] + v[2 * j + 1] * v[2 * j + 1]; }
      const float r = 1.f / sqrtf(wave_sum(ss) * (1.f / 256.f) + RMS_EPS); bf16* o = (bf16*)(ws + WS_NKV) + (size_t)row * 256;
#pragma unroll
      for (int j = 0; j < 2; ++j) *(unsigned*)(o + 2 * lane + 128 * j) = pk2(v[2 * j] * r, v[2 * j + 1] * r); }
    { const float pa = bf2f(pr[O_GAF + (lane & 31)]);
      const float* baf = INP(a, I_BAF) + l * 256; const float* bab = INP(a, I_BAB) + l * 256;
      float xf[4], xb[4];
#pragma unroll
      for (int j = 0; j < 4; ++j) { xf[j] = baf[lane + 64 * j]; xb[j] = bab[lane + 64 * j]; }
#pragma unroll
      for (int r = 0; r < 16; ++r) { const float pf = __shfl(pa, r), pb = __shfl(pa, 16 + r);
#pragma unroll
          for (int j = 0; j < 4; ++j) { xf[j] += pf * wa[r * 256 + lane + 64 * j]; xb[j] += pb * wa[4096 + r * 256 + lane + 64 * j]; } }
      float* AFp = (float*)(ws + WS_AF) + (size_t)row * 256; float* ABp = (float*)(ws + WS_AB) + (size_t)row * 256;
#pragma unroll
      for (int j = 0; j < 4; ++j) {
          const float lf = fminf(xf[j], 0.f) - __logf(1.f + __expf(-fabsf(xf[j]))), lb = fminf(xb[j], 0.f) - __logf(1.f + __expf(-fabsf(xb[j])));
          AFp[lane + 64 * j] = lf * (1.f / 16.f); ABp[lane + 64 * j] = lb * (1.f / 16.f); } }
    if (lane < 16) { float x1 = bf2f(pr[O_MKR + lane]), x2 = bf2f(pr[O_MKR + 16 + lane]); int b, key;
        if (row < NLAT) { const int t = row & 8191; b = row >> 13; key = CTXL + t; const float* cs = (const float*)(ws + WS_ROPE) + ((size_t)t * 16 + lane) * 2; const float cc = cs[0], sn = cs[1];
            const float o1 = x1 * cc - x2 * sn, o2 = x2 * cc + x1 * sn; x1 = o1; x2 = o2; }
        else { const int r2 = row - NLAT; b = r2 >> 8; key = r2 & 255; }
        const bf16 h1 = (bf16)f2bf(x1), h2 = (bf16)f2bf(x2); bf16* kb = (bf16*)(ws + WS_KB) + ((size_t)(b * 8) * KEYS + key) * 96 + 64 + lane;
#pragma unroll
        for (int h = 0; h < 8; ++h) { kb[(size_t)h * KEYS * 96] = h1; kb[(size_t)h * KEYS * 96 + 16] = h2; } }
}

__device__ __forceinline__ float max3f(float a, float b, float c) { float r; asm("v_max3_f32 %0, %1, %2, %3" : "=v"(r) : "v"(a), "v"(b), "v"(c)); return r; }
__device__ __forceinline__ int kap(int r) { return (r & 0x13) | ((r & 4) << 1) | ((r & 8) >> 1); }
__device__ __forceinline__ unsigned pkbf2(float lo, float hi) { unsigned r; asm volatile("v_cvt_pk_bf16_f32 %0, %1, %2" : "=v"(r) : "v"(lo), "v"(hi)); return r; }
__device__ __forceinline__ void attn_unit(const int VAR, const Fr& F, const GAS bf16* QB, const GAS bf16* KBh, const GAS bf16* VTh, GAS bf16* O, int qrow0, int head, int ntiles, const GAS float* rope) {
    constexpr int KROW = 208, VROW = 144, KBYTES = 64 * KROW, BUF = KBYTES + 64 * VROW;
    const int tid = F.tid, lane = F.lane, wave = F.wave, r = lane & 31, hh = lane >> 5;
    LAS unsigned char* L = F.L;
    bf16x8 qf[6];
    { const GAS bf16* qp = QB + (size_t)(qrow0 + wave * 32 + r) * 768 + head * 96 + 8 * hh;
#pragma unroll
      for (int ks = 0; ks < 6; ++ks) qf[ks] = *(const GAS bf16x8*)(qp + 16 * ks);
      if (qrow0 < NLAT) {
          const GAS float* cs = rope + ((size_t)((qrow0 + wave * 32 + r) & 8191) * 16 + 8 * hh) * 2;
          v4u a = __builtin_bit_cast(v4u, qf[4]), b = __builtin_bit_cast(v4u, qf[5]);
#pragma unroll
          for (int i = 0; i < 4; ++i) { const f32x4 c4 = *(const GAS f32x4*)(cs + 4 * i);
              const float x1l = bflo(a[i]), x1h = bfhi(a[i]), x2l = bflo(b[i]), x2h = bfhi(b[i]);
              a[i] = pk2(x1l * c4[0] - x2l * c4[1], x1h * c4[2] - x2h * c4[3]); b[i] = pk2(x2l * c4[0] + x1l * c4[1], x2h * c4[2] + x1h * c4[3]); }
          qf[4] = __builtin_bit_cast(bf16x8, a); qf[5] = __builtin_bit_cast(bf16x8, b); } }
    const int kq0 = tid, kq1 = 512 + tid;
    const int kl0 = (kq0 / 12) * KROW + (kq0 % 12) * 16, kl1 = (kq1 / 12) * KROW + (kq1 % 12) * 16;
    const int vrow = tid >> 3, vch = tid & 7; const int vl = KBYTES + vrow * VROW + vch * 16;
    const GAS bf16* vsrc = VTh + (size_t)vrow * KEYS + vch * 8;
    v4u k0r, k1r, vr; k1r = (v4u){0u, 0u, 0u, 0u};
#define AT_LOAD(K0_, K1_, V_, t_) do { if (VAR == 4) break; const GAS unsigned char* kt_ = (const GAS unsigned char*)KBh + (size_t)(t_) * (64 * 192); K0_ = *(const GAS v4u*)(kt_ + (size_t)kq0 * 16); if (tid < 256) K1_ = *(const GAS v4u*)(kt_ + (size_t)kq1 * 16); \
        V_ = *(const GAS v4u*)(vsrc + (size_t)(t_) * 64); } while (0)
#define AT_WRITE(K0_, K1_, V_, bo_) do { if (VAR == 4) break; LAS unsigned char* Bn_ = L + (bo_); *(LAS v4u*)(Bn_ + kl0) = K0_; if (tid < 256) *(LAS v4u*)(Bn_ + kl1) = K1_; *(LAS v4u*)(Bn_ + vl) = V_; } while (0)
#define AT_SOFT(S_, PB_, RS_, MX_) do { f32x2 pp_[8]; \
        _Pragma("unroll") for (int i_ = 0; i_ < 8; ++i_) { pp_[i_].x = __builtin_amdgcn_exp2f(S_[2 * i_]); pp_[i_].y = __builtin_amdgcn_exp2f(S_[2 * i_ + 1]); } \
        _Pragma("unroll") for (int s2_ = 0; s2_ < 2; ++s2_) { v4u w_; w_.x = pkbf2(pp_[4 * s2_].x, pp_[4 * s2_].y); w_.y = pkbf2(pp_[4 * s2_ + 1].x, pp_[4 * s2_ + 1].y); w_.z = pkbf2(pp_[4 * s2_ + 2].x, pp_[4 * s2_ + 2].y); w_.w = pkbf2(pp_[4 * s2_ + 3].x, pp_[4 * s2_ + 3].y); \
            PB_[s2_] = __builtin_bit_cast(bf16x8, w_); } \
        MX_ = 0.f; \
        pp_[0] += pp_[4]; pp_[1] += pp_[5]; pp_[2] += pp_[6]; pp_[3] += pp_[7]; pp_[0] += pp_[2]; pp_[1] += pp_[3]; RS_ = pp_[0] + pp_[1]; } while (0)
#define AT_TILE(bo_) do { const LAS unsigned char* B_ = L + (bo_); bf16x8 ka_[12], va_[8], pb0_[2], pb1_[2]; f32x2 rs0_, rs1_; float mx0_, mx1_; \
        _Pragma("unroll") for (int ks_ = 0; ks_ < 6; ++ks_) { ka_[2 * ks_] = *(const LAS bf16x8*)(B_ + koff + ks_ * 32); ka_[2 * ks_ + 1] = *(const LAS bf16x8*)(B_ + koff + 32 * KROW + ks_ * 32); } \
        _Pragma("unroll") for (int kb_ = 0; kb_ < 2; ++kb_) _Pragma("unroll") for (int s2_ = 0; s2_ < 2; ++s2_) { \
            va_[(kb_ * 2 + s2_) * 2] = *(const LAS bf16x8*)(B_ + voff + (32 * kb_ + 16 * s2_) * 2); va_[(kb_ * 2 + s2_) * 2 + 1] = *(const LAS bf16x8*)(B_ + voff + 32 * VROW + (32 * kb_ + 16 * s2_) * 2); } \
        asm volatile("s_waitcnt lgkmcnt(8)" ::: "memory"); __builtin_amdgcn_sched_barrier(0); \
        _Pragma("unroll") for (int ks_ = 0; ks_ < 6; ++ks_) sA0 = __builtin_amdgcn_mfma_f32_32x32x16_bf16(ka_[2 * ks_], qf[ks_], sA0, 0, 0, 0); \
        __builtin_amdgcn_sched_barrier(0); \
        _Pragma("unroll") for (int ks_ = 0; ks_ < 6; ++ks_) sA1 = __builtin_amdgcn_mfma_f32_32x32x16_bf16(ka_[2 * ks_ + 1], qf[ks_], sA1, 0, 0, 0); \
        AT_SOFT(sA0, pb0_, rs0_, mx0_); \
        _Pragma("unroll") for (int g_ = 0; g_ < 6; ++g_) { __builtin_amdgcn_sched_group_barrier(0x008, 1, 0); __builtin_amdgcn_sched_group_barrier(0x402, 10, 0); } \
        asm volatile("s_waitcnt lgkmcnt(0)" ::: "memory"); __builtin_amdgcn_sched_barrier(0); \
        _Pragma("unroll") for (int s2_ = 0; s2_ < 2; ++s2_) { o0 = __builtin_amdgcn_mfma_f32_32x32x16_bf16(va_[s2_ * 2], pb0_[s2_], o0, 0, 0, 0); o1 = __builtin_amdgcn_mfma_f32_32x32x16_bf16(va_[s2_ * 2 + 1], pb0_[s2_], o1, 0, 0, 0); } \
        AT_SOFT(sA1, pb1_, rs1_, mx1_); \
        _Pragma("unroll") for (int g_ = 0; g_ < 4; ++g_) { __builtin_amdgcn_sched_group_barrier(0x008, 1, 0); __builtin_amdgcn_sched_group_barrier(0x402, 14, 0); } \
        __builtin_amdgcn_sched_barrier(0); \
        _Pragma("unroll") for (int s2_ = 0; s2_ < 2; ++s2_) { o0 = __builtin_amdgcn_mfma_f32_32x32x16_bf16(va_[4 + s2_ * 2], pb1_[s2_], o0, 0, 0, 0); o1 = __builtin_amdgcn_mfma_f32_32x32x16_bf16(va_[4 + s2_ * 2 + 1], pb1_[s2_], o1, 0, 0, 0); } \
        float pm_; { const f32x2 rs_ = rs0_ + rs1_; const float rsum_ = rs_.x + rs_.y; l_run += rsum_; pm_ = rsum_ + __shfl_xor(rsum_, 32); (void)mx0_; (void)mx1_; \
          const float nm_ = -m_run; _Pragma("unroll") for (int i_ = 0; i_ < 16; ++i_) { sA0[i_] = nm_; sA1[i_] = nm_; } }        \
        _Pragma("unroll") for (int g_ = 0; g_ < 4; ++g_) { __builtin_amdgcn_sched_group_barrier(0x008, 1, 0); __builtin_amdgcn_sched_group_barrier(0x402, 10, 0); } \
        __builtin_amdgcn_sched_barrier(0); \
        if (__any(pm_ > 2048.f)) { const float dl_ = fmaxf(__builtin_amdgcn_logf(pm_) - 5.f, 0.f), al_ = __builtin_amdgcn_exp2f(-dl_); m_run += dl_; l_run *= al_; const float nm_ = -m_run; \
            _Pragma("unroll") for (int i_ = 0; i_ < 16; ++i_) { o0[i_] *= al_; o1[i_] *= al_; sA0[i_] = nm_; sA1[i_] = nm_; } } \
        __builtin_amdgcn_sched_barrier(0); } while (0)
#define AT_QK0(S0_, S1_, bo_) do { const LAS unsigned char* B_ = L + (bo_); _Pragma("unroll") for (int i_ = 0; i_ < 16; ++i_) { S0_[i_] = 0.f; S1_[i_] = 0.f; } \
        _Pragma("unroll") for (int ks_ = 0; ks_ < 6; ++ks_) { const bf16x8 a0_ = *(const LAS bf16x8*)(B_ + koff + ks_ * 32), a1_ = *(const LAS bf16x8*)(B_ + koff + 32 * KROW + ks_ * 32); \
            S0_ = __builtin_amdgcn_mfma_f32_32x32x16_bf16(a0_, qf[ks_], S0_, 0, 0, 0); S1_ = __builtin_amdgcn_mfma_f32_32x32x16_bf16(a1_, qf[ks_], S1_, 0, 0, 0); } } while (0)
    f32x16 o0, o1, sA0, sA1;
    const bool late = wave >= 4;
#pragma unroll
    for (int i = 0; i < 16; ++i) { o0[i] = 0.f; o1[i] = 0.f; }
    float m_run = -100.f, l_run = 0.f;
    const int koff = kap(r) * KROW + 16 * hh, voff = KBYTES + r * VROW + 16 * hh;
    v4u k0y, k1y, vy; k1y = (v4u){0u, 0u, 0u, 0u};
    AT_LOAD(k0r, k1r, vr, 0); AT_WRITE(k0r, k1r, vr, 0); AT_LOAD(k0r, k1r, vr, 1); AT_WRITE(k0r, k1r, vr, BUF);
    if (ntiles > 2) { AT_LOAD(k0r, k1r, vr, 2); AT_LOAD(k0y, k1y, vy, 3); }
    __syncthreads();
    AT_QK0(sA0, sA1, 0);
    { float mx = fmaxf(sA0[0], sA1[0]);
#pragma unroll
      for (int i = 1; i < 16; ++i) mx = fmaxf(mx, fmaxf(sA0[i], sA1[i]));
      m_run = fmaxf(mx, __shfl_xor(mx, 32)); }
    { const float nm = -m_run;
#pragma unroll
      for (int i = 0; i < 16; ++i) { sA0[i] = nm; sA1[i] = nm; } }
    int B0 = 0, B1 = 2 * BUF;
    for (int t = 0; t < ntiles; t += 2) {
        AT_TILE(B0);
        if (t + 2 < ntiles) AT_WRITE(k0r, k1r, vr, B1);
        if (t + 4 < ntiles) AT_LOAD(k0r, k1r, vr, t + 4);
        AT_TILE(B0 + BUF);
        if (t + 3 < ntiles) AT_WRITE(k0y, k1y, vy, B1 + BUF);
        if (t + 5 < ntiles) AT_LOAD(k0y, k1y, vy, t + 5);
        __syncthreads();
        { const int n0 = B1; B1 = B0; B0 = n0; }
    }
#undef AT_LOAD
#undef AT_WRITE
#undef AT_TILE
#undef AT_SOFT
#undef AT_QK0
    const float inv = 1.f / (l_run + __shfl_xor(l_run, 32));
    GAS bf16* op = O + (size_t)(qrow0 + wave * 32 + r) * 512 + head * 64 + 4 * hh;
#pragma unroll
    for (int g = 0; g < 4; ++g) { v2u w; w.x = pk2(o0[4 * g] * inv, o0[4 * g + 1] * inv); w.y = pk2(o0[4 * g + 2] * inv, o0[4 * g + 3] * inv); *(GAS v2u*)(op + 8 * g) = w;
        v2u w2; w2.x = pk2(o1[4 * g] * inv, o1[4 * g + 1] * inv); w2.y = pk2(o1[4 * g + 2] * inv, o1[4 * g + 3] * inv); *(GAS v2u*)(op + 32 + 8 * g) = w2; }
}


constexpr int GR = 72;
__device__ __forceinline__ int gla_mb(int c) { return c < 4 ? 3 - c : 4 + (131 - c); }
__device__ __forceinline__ int gla_row0(int b, int c) { return c < 4 ? NLAT + b * CTXL + 64 * c : b * SEQ + 64 * (c - 4); }
constexpr int GL_BF = 0, GL_BB = GL_BF + 64 * 65 * 4, GL_A0 = GL_BB + 64 * 65 * 4;
__device__ __forceinline__ void gla_cumsum(const Fr& F, const unsigned char* ws, int row0, int h) {
    LAS float* BF = (LAS float*)(F.L + GL_BF); LAS float* BB = (LAS float*)(F.L + GL_BB); const int tid = F.tid;
    { const int t = tid >> 3, d8 = (tid & 7) * 8; const GAS float* gf = (const GAS float*)(ws + WS_AF) + (size_t)(row0 + t) * 256 + h * 64 + d8; const GAS float* gb = (const GAS float*)(ws + WS_AB) + (size_t)(row0 + t) * 256 + h * 64 + d8;
      const f32x4 f0 = *(const f32x4*)gf, f1 = *(const GAS f32x4*)(gf + 4), b0 = *(const f32x4*)gb, b1 = *(const GAS f32x4*)(gb + 4);
#pragma unroll
      for (int i = 0; i < 4; ++i) { BF[t * 65 + d8 + i] = f0[i]; BF[t * 65 + d8 + 4 + i] = f1[i]; BB[t * 65 + d8 + i] = b0[i]; BB[t * 65 + d8 + 4 + i] = b1[i]; } }
    __syncthreads();
    { const int arr = tid >> 8, seg = (tid >> 6) & 3, d = tid & 63; LAS float* B = arr ? BB : BF; LAS float* tot = (LAS float*)(F.L + GL_A0) + arr * 256;
      float v[16]; float s = 0.f;
#pragma unroll
      for (int i = 0; i < 16; ++i) { const int t = arr ? (63 - (seg * 16 + i)) : (seg * 16 + i); s += B[t * 65 + d]; v[i] = s; }
      tot[seg * 64 + d] = s;
      __syncthreads();
      float off = 0.f;
#pragma unroll
      for (int q = 0; q < 3; ++q) off += (q < seg) ? tot[q * 64 + d] : 0.f;
#pragma unroll
      for (int i = 0; i < 16; ++i) { const int t = arr ? (63 - (seg * 16 + i)) : (seg * 16 + i); B[t * 65 + d] = v[i] + off; } }
    __syncthreads();
}

__device__ __forceinline__ void gla_a_item(const Fr& F, unsigned char* ws, int item) {
    const int c = item % 132, bh = item / 132, h = bh & 3, b = bh >> 2; const int row0 = gla_row0(b, c); const int tid = F.tid, lane = F.lane, wave = F.wave;
    gla_cumsum(F, ws, row0, h);
    LAS float* BF = (LAS float*)(F.L + GL_BF); LAS float* BB = (LAS float*)(F.L + GL_BB);
    LAS bf16* KTF = (LAS bf16*)(F.L + GL_A0);
    LAS bf16* KTB = KTF + 64 * GR;
    LAS bf16* VT = KTB + 64 * GR;
    const GAS bf16* P = (const GAS bf16*)(ws + WS_P);
    { const int t = tid >> 3, d8 = (tid & 7) * 8; const v4u kr = *(const GAS v4u*)(P + (size_t)(row0 + t) * INPAD + O_GK + h * 64 + d8);
#pragma unroll
      for (int i = 0; i < 8; ++i) { const int d = d8 + i; const float k = (i & 1) ? bfhi(kr[i >> 1]) : bflo(kr[i >> 1]);
          KTF[d * GR + t] = (bf16)f2bf(k * __expf(BF[63 * 65 + d] - BF[t * 65 + d])); KTB[d * GR + t] = (bf16)f2bf(k * __expf(BB[d] - BB[t * 65 + d])); }
#pragma unroll
      for (int q = 0; q < 2; ++q) { const int e8 = ((tid & 7) + 8 * q) * 8; const v4u vr = *(const GAS v4u*)(P + (size_t)(row0 + t) * INPAD + O_GV + h * 128 + e8);
#pragma unroll
          for (int i = 0; i < 8; ++i) VT[(e8 + i) * GR + t] = (bf16)((i & 1) ? (vr[i >> 1] >> 16) : (vr[i >> 1] & 0xffffu)); } }
    __syncthreads();
    const int r = lane & 31, hh = lane >> 5, eb = wave & 3, db = wave >> 2;
#pragma unroll
    for (int dir = 0; dir < 2; ++dir) { const LAS bf16* KT = dir ? KTB : KTF; f32x16 acc;
#pragma unroll
        for (int i = 0; i < 16; ++i) acc[i] = 0.f;
#pragma unroll
        for (int s = 0; s < 4; ++s) { const bf16x8 av = *(const LAS bf16x8*)(VT + (32 * eb + r) * GR + 16 * s + 8 * hh), bk = *(const LAS bf16x8*)(KT + (32 * db + r) * GR + 16 * s + 8 * hh);
            acc = __builtin_amdgcn_mfma_f32_32x32x16_bf16(av, bk, acc, 0, 0, 0); }
        const int chain = bh * 2 + dir, m = dir ? gla_mb(c) : c; GAS float* dst = (GAS float*)(ws + WS_GST) + ((size_t)chain * 132 + m) * 8192;
#pragma unroll
        for (int g = 0; g < 16; ++g) { const int e = 32 * eb + (g & 3) + 8 * (g >> 2) + 4 * hh; dst[e * 64 + 32 * db + r] = acc[g]; }
        if (wave == 0 && dir == 0) ((GAS float*)(ws + WS_GDEC))[((size_t)chain * 132 + m) * 64 + lane] = __expf(BF[63 * 65 + lane]);
        if (wave == 1 && dir == 1) ((GAS float*)(ws + WS_GDEC))[((size_t)chain * 132 + m) * 64 + lane] = __expf(BB[lane]); }
    __syncthreads();
}

__device__ __forceinline__ void gla_scan_q(const Fr& F, unsigned char* ws, int item) {
    const int chain = item >> 4, part = item & 15; const int idx = part * 512 + F.tid;
    GAS float* st = (GAS float*)(ws + WS_GST) + (size_t)chain * 132 * 8192 + idx; const GAS float* dec = (const GAS float*)(ws + WS_GDEC) + (size_t)chain * 132 * 64 + (idx & 63);
    float s = 0.f; float dn[6], an[6];
#pragma unroll
    for (int k = 0; k < 6; ++k) { dn[k] = st[(size_t)k * 8192]; an[k] = dec[k * 64]; }
    for (int m = 0; m < 132; m += 6) {
        float d2[6], a2[6];
#pragma unroll
        for (int k = 0; k < 6; ++k) { d2[k] = dn[k]; a2[k] = an[k]; }
        if (m + 6 < 132) {
#pragma unroll
            for (int k = 0; k < 6; ++k) { dn[k] = st[(size_t)(m + 6 + k) * 8192]; an[k] = dec[(m + 6 + k) * 64]; } }
#pragma unroll
        for (int k = 0; k < 6; ++k) { st[(size_t)(m + k) * 8192] = s; s = a2[k] * s + d2[k]; }
    }
}

__device__ __forceinline__ void gla_c_item(const Fr& F, const Args& a, unsigned char* ws, int l, int item) {
    const int c = item % 132, bh = item / 132, h = bh & 3, b = bh >> 2; const int row0 = gla_row0(b, c); const int tid = F.tid, lane = F.lane, wave = F.wave;
    gla_cumsum(F, ws, row0, h);
    LAS float* BF = (LAS float*)(F.L + GL_BF); LAS float* BB = (LAS float*)(F.L + GL_BB);
    LAS bf16* QF = (LAS bf16*)(F.L + GL_A0);
    LAS bf16* KF = QF + 64 * GR;
    LAS bf16* QBk = KF + 64 * GR;
    LAS bf16* KBk = QBk + 64 * GR;
    LAS bf16* VT = KBk + 64 * GR;
    LAS bf16* SF = VT + 128 * GR;
    LAS bf16* SB = SF + 128 * GR;
    LAS float* red = (LAS float*)(SB + 128 * GR);
    const GAS bf16* P = (const GAS bf16*)(ws + WS_P);
    { const int t = tid >> 3, d8 = (tid & 7) * 8; const GAS bf16* pr = P + (size_t)(row0 + t) * INPAD; const v4u qr = *(const GAS v4u*)(pr + O_GQ + h * 64 + d8), kr = *(const GAS v4u*)(pr + O_GK + h * 64 + d8);
      v4u qf, kf, qb, kb;
#pragma unroll
      for (int i = 0; i < 4; ++i) { const float q0 = bflo(qr[i]) * 0.125f, q1 = bfhi(qr[i]) * 0.125f, k0 = bflo(kr[i]), k1 = bfhi(kr[i]);
          const float f0 = BF[t * 65 + d8 + 2 * i], f1 = BF[t * 65 + d8 + 2 * i + 1], g0 = BB[t * 65 + d8 + 2 * i], g1 = BB[t * 65 + d8 + 2 * i + 1];
          qf[i] = pk2(q0 * __expf(f0), q1 * __expf(f1)); kf[i] = pk2(k0 * __expf(-f0), k1 * __expf(-f1)); qb[i] = pk2(q0 * __expf(g0), q1 * __expf(g1)); kb[i] = pk2(k0 * __expf(-g0), k1 * __expf(-g1)); }
      *(LAS v4u*)(QF + t * GR + d8) = qf; *(LAS v4u*)(KF + t * GR + d8) = kf; *(LAS v4u*)(QBk + t * GR + d8) = qb; *(LAS v4u*)(KBk + t * GR + d8) = kb;
#pragma unroll
      for (int q = 0; q < 2; ++q) { const int e8 = ((tid & 7) + 8 * q) * 8; const v4u vr = *(const GAS v4u*)(pr + O_GV + h * 128 + e8);
#pragma unroll
          for (int i = 0; i < 8; ++i) VT[(e8 + i) * GR + t] = (bf16)((i & 1) ? (vr[i >> 1] >> 16) : (vr[i >> 1] & 0xffffu)); } }
    { const GAS float* sf = (const GAS float*)(ws + WS_GST) + ((size_t)(bh * 2) * 132 + c) * 8192; const GAS float* sb = (const GAS float*)(ws + WS_GST) + ((size_t)(bh * 2 + 1) * 132 + gla_mb(c)) * 8192;
#pragma unroll
      for (int q = 0; q < 2; ++q) { const int idx = (tid + 512 * q) * 8, e = idx >> 6, d = idx & 63;
          const f32x4 x0 = *(const GAS f32x4*)(sf + idx), x1 = *(const GAS f32x4*)(sf + idx + 4), y0 = *(const GAS f32x4*)(sb + idx), y1 = *(const GAS f32x4*)(sb + idx + 4);
          v4u w; w.x = pk2(x0[0], x0[1]); w.y = pk2(x0[2], x0[3]); w.z = pk2(x1[0], x1[1]); w.w = pk2(x1[2], x1[3]); *(LAS v4u*)(SF + e * GR + d) = w;
          v4u z; z.x = pk2(y0[0], y0[1]); z.y = pk2(y0[2], y0[3]); z.z = pk2(y1[0], y1[1]); z.w = pk2(y1[2], y1[3]); *(LAS v4u*)(SB + e * GR + d) = z; } }
    __syncthreads();
    const int r = lane & 31, hh = lane >> 5, eb = wave & 3, ib = wave >> 2;
    f32x16 O;
#pragma unroll
    for (int i = 0; i < 16; ++i) O[i] = 0.f;
#pragma unroll
    for (int dir = 0; dir < 2; ++dir) { const LAS bf16* Qd = dir ? QBk : QF; const LAS bf16* Kd = dir ? KBk : KF; const LAS bf16* Sd = dir ? SB : SF;
        bf16x8 qfr[4];
#pragma unroll
        for (int s = 0; s < 4; ++s) qfr[s] = *(const LAS bf16x8*)(Qd + (32 * ib + r) * GR + 16 * s + 8 * hh);
#pragma unroll
        for (int jb = 0; jb < 2; ++jb) { f32x16 pt;
#pragma unroll
            for (int i = 0; i < 16; ++i) pt[i] = 0.f;
#pragma unroll
            for (int s = 0; s < 4; ++s) { const bf16x8 ka = *(const LAS bf16x8*)(Kd + (32 * jb + kap(r)) * GR + 16 * s + 8 * hh); pt = __builtin_amdgcn_mfma_f32_32x32x16_bf16(ka, qfr[s], pt, 0, 0, 0); }
            const int ti = 32 * ib + r;
#pragma unroll
            for (int g = 0; g < 16; ++g) { const int tj = 32 * jb + kap((g & 3) + 8 * (g >> 2) + 4 * hh); const bool keep = dir ? (tj >= ti) : (tj <= ti); pt[g] = keep ? pt[g] : 0.f; }
#pragma unroll
            for (int s2 = 0; s2 < 2; ++s2) { v4u w; w.x = pkbf2(pt[8 * s2 + 0], pt[8 * s2 + 1]); w.y = pkbf2(pt[8 * s2 + 2], pt[8 * s2 + 3]); w.z = pkbf2(pt[8 * s2 + 4], pt[8 * s2 + 5]); w.w = pkbf2(pt[8 * s2 + 6], pt[8 * s2 + 7]);
                const bf16x8 va = *(const LAS bf16x8*)(VT + (32 * eb + r) * GR + 32 * jb + 16 * s2 + 8 * hh);
                O = __builtin_amdgcn_mfma_f32_32x32x16_bf16(va, __builtin_bit_cast(bf16x8, w), O, 0, 0, 0); } }
#pragma unroll
        for (int s = 0; s < 4; ++s) { const bf16x8 sa = *(const LAS bf16x8*)(Sd + (32 * eb + r) * GR + 16 * s + 8 * hh); O = __builtin_amdgcn_mfma_f32_32x32x16_bf16(sa, qfr[s], O, 0, 0, 0); } }
    { float ss = 0.f;
#pragma unroll
      for (int g = 0; g < 16; ++g) ss += O[g] * O[g];
      ss += __shfl_xor(ss, 32);
      if (hh == 0) red[eb * 64 + 32 * ib + r] = ss; }
    __syncthreads();
    { const int ti = 32 * ib + r; const float tot = (red[ti] + red[64 + ti]) + (red[128 + ti] + red[192 + ti]); const float rs = 1.f / sqrtf(tot * (1.f / 128.f) + RMS_EPS);
      const GAS float* gn = (const GAS float*)INP(a, I_GNORM) + l * 128; const GAS bf16* pr = P + (size_t)(row0 + ti) * INPAD + O_GR + h * 128; GAS bf16* o = (GAS bf16*)(ws + WS_OBR) + (size_t)(row0 + ti) * 512 + h * 128;
#pragma unroll
      for (int g4 = 0; g4 < 4; ++g4) { const int e = 32 * eb + 8 * g4 + 4 * hh; const f32x4 gv = *(const GAS f32x4*)(gn + e); const v2u rw = *(const GAS v2u*)(pr + e);
          const float r0 = bflo(rw.x), r1 = bfhi(rw.x), r2 = bflo(rw.y), r3 = bfhi(rw.y);
          const float y0 = O[4 * g4] * rs * gv[0] * (r0 / (1.f + __expf(-r0))), y1 = O[4 * g4 + 1] * rs * gv[1] * (r1 / (1.f + __expf(-r1)));
          const float y2 = O[4 * g4 + 2] * rs * gv[2] * (r2 / (1.f + __expf(-r2))), y3 = O[4 * g4 + 3] * rs * gv[3] * (r3 / (1.f + __expf(-r3)));
          v2u w; w.x = pk2(y0, y1); w.y = pk2(y2, y3); *(GAS v2u*)(o + e) = w; } }
    __syncthreads();
}

__device__ __forceinline__ void gate_row(const Fr& F, unsigned char* ws, int row) {
    const int lane = F.lane; const GAS bf16* pg = (const GAS bf16*)(ws + WS_P) + (size_t)row * INPAD + O_GATE; const GAS bf16* pu = (const GAS bf16*)(ws + WS_U) + (size_t)row * 3072; GAS bf16* po = (GAS bf16*)(ws + WS_YMB) + (size_t)row * 1024;
#pragma unroll
    for (int j = 0; j < 2; ++j) { const int c = 8 * lane + 512 * j; float y[8];
#pragma unroll
        for (int i = 0; i < 8; ++i) y[i] = 0.f;
#pragma unroll
        for (int br = 0; br < 3; ++br) { const v4u g = *(const GAS v4u*)(pg + br * 1024 + c), u = *(const GAS v4u*)(pu + br * 1024 + c);
#pragma unroll
            for (int i = 0; i < 4; ++i) { y[2 * i] += bflo(u[i]) * __builtin_amdgcn_rcpf(1.f + __expf(-bflo(g[i]))); y[2 * i + 1] += bfhi(u[i]) * __builtin_amdgcn_rcpf(1.f + __expf(-bfhi(g[i]))); } }
        v4u o; o.x = pk2(y[0], y[1]); o.y = pk2(y[2], y[3]); o.z = pk2(y[4], y[5]); o.w = pk2(y[6], y[7]); *(GAS v4u*)(po + c) = o; }
}
__device__ __forceinline__ void hy_tr_item(const Fr& F, unsigned char* ws, int item) {
    LAS bf16* T = (LAS bf16*)F.L;
    const int tid = F.tid; const int cb = item & 7, sb = (item >> 3) & 127, b = item >> 10; const int c0 = cb * 64, s0 = sb * 64;
    { const int cc = tid >> 3, sq = tid & 7; const v4u v = *(const v4u*)((const bf16*)(ws + WS_OHYT) + ((size_t)(c0 + cc) * 2 + b) * 8192 + s0 + sq * 8);
      *(LAS v4u*)(T + cc * 72 + sq * 8) = v; }
    __syncthreads();
    { const int ss = tid >> 3, cq = tid & 7; unsigned short e[8];
#pragma unroll
      for (int j = 0; j < 8; ++j) e[j] = T[(cq * 8 + j) * 72 + ss];
      v4u o; o.x = e[0] | ((unsigned)e[1] << 16); o.y = e[2] | ((unsigned)e[3] << 16); o.z = e[4] | ((unsigned)e[5] << 16); o.w = e[6] | ((unsigned)e[7] << 16);
      *(v4u*)((bf16*)(ws + WS_OBR) + (size_t)2 * MALL * 512 + (size_t)(b * 8192 + s0 + ss) * 512 + c0 + cq * 8) = o; }
    __syncthreads();
}

__device__ __forceinline__ void ln1_mod2(const GAS float* xp, GAS float* xs, GAS bf16* hb, const GAS float* g1, const GAS float* b1, const GAS float* sh2, const GAS float* sc2, float (&x)[16], int lane) {
    float s = 0.f;
#pragma unroll
    for (int i = 0; i < 16; ++i) { x[i] = xp[lane + 64 * i]; s += x[i]; }
    float mean = wave_sum(s) * (1.f / 1024.f); float q = 0.f;
#pragma unroll
    for (int i = 0; i < 16; ++i) { x[i] -= mean; q += x[i] * x[i]; }
    float rstd = 1.f / sqrtf(wave_sum(q) * (1.f / 1024.f) + LN_EPS);
    s = 0.f;
#pragma unroll
    for (int i = 0; i < 16; ++i) { x[i] = x[i] * rstd * g1[lane + 64 * i] + b1[lane + 64 * i]; xs[lane + 64 * i] = x[i]; s += x[i]; }
    mean = wave_sum(s) * (1.f / 1024.f); q = 0.f;
#pragma unroll
    for (int i = 0; i < 16; ++i) { x[i] -= mean; q += x[i] * x[i]; }
    rstd = 1.f / sqrtf(wave_sum(q) * (1.f / 1024.f) + LN_EPS);
#pragma unroll
    for (int i = 0; i < 16; ++i) { x[i] = x[i] * rstd * (1.f + sc2[lane + 64 * i]) + sh2[lane + 64 * i]; hb[lane + 64 * i] = (bf16)f2bf(x[i]); }
}
__device__ __forceinline__ float reduce32(float (&p)[32], int lane) {
    float a[16], b[8], c[4], d[2];
    { const bool up = (lane & 32) != 0;
#pragma unroll
      for (int e = 0; e < 16; ++e) { const float send = up ? p[e] : p[e + 16], keep = up ? p[e + 16] : p[e]; a[e] = keep + __shfl_xor(send, 32); } }
    { const bool up = (lane & 16) != 0;
#pragma unroll
      for (int e = 0; e < 8; ++e) { const float send = up ? a[e] : a[e + 8], keep = up ? a[e + 8] : a[e]; b[e] = keep + __shfl_xor(send, 16); } }
    { const bool up = (lane & 8) != 0;
#pragma unroll
      for (int e = 0; e < 4; ++e) { const float send = up ? b[e] : b[e + 4], keep = up ? b[e + 4] : b[e]; c[e] = keep + __shfl_xor(send, 8); } }
    { const bool up = (lane & 4) != 0;
#pragma unroll
      for (int e = 0; e < 2; ++e) { const float send = up ? c[e] : c[e + 2], keep = up ? c[e + 2] : c[e]; d[e] = keep + __shfl_xor(send, 4); } }
    float r;
    { const bool up = (lane & 2) != 0; const float send = up ? d[0] : d[1], keep = up ? d[1] : d[0]; r = keep + __shfl_xor(send, 2); }
    return r + __shfl_xor(r, 1);
}
__device__ __forceinline__ void route_row(unsigned char* ws, int l, int row, float tot, const GAS float* rb, int lane, bool dry, LAS unsigned* lcnt) {
    float mylogit = (lane & 1) ? -3.0e38f : tot + rb[lane >> 1];
    float tv[4]; int ti[4];
#pragma unroll
    for (int k = 0; k < 4; ++k) { const float mx = wave_max(mylogit); const unsigned long long bal = __ballot(mylogit == mx); const int idx = __builtin_ctzll(bal); tv[k] = mx; ti[k] = idx >> 1; if (lane == idx) mylogit = -3.0e38f; }
    const float e1 = expf(tv[1] - tv[0]), e2 = expf(tv[2] - tv[0]), e3 = expf(tv[3] - tv[0]); const float inv = 1.f / (1.f + e1 + e2 + e3);
    if (lane < 4 && !dry) { const int e = lane == 0 ? ti[0] : lane == 1 ? ti[1] : lane == 2 ? ti[2] : ti[3]; const float g = (lane == 0 ? 1.f : lane == 1 ? e1 : lane == 2 ? e2 : e3) * inv;
        const unsigned pos = __hip_atomic_fetch_add(lcnt + e, 1u, __ATOMIC_RELAXED, __HIP_MEMORY_SCOPE_WORKGROUP);
        ((GAS int*)(ws + WS_TOPE))[row * 4 + lane] = e; ((GAS float*)(ws + WS_TOPG))[row * 4 + lane] = g; ((GAS int*)(ws + WS_SPOS))[row * 4 + lane] = (int)pos; }
}
__device__ __forceinline__ void ln1_router_row2(const Fr& F, const Args& a, unsigned char* ws, int l, int row0, const LAS float* wT  , bool dry, LAS unsigned* lcnt) {
    const int lane = F.lane; const GAS float* g1 = (const GAS float*)INP(a, I_LN1G) + l * 1024; const GAS float* b1 = (const GAS float*)INP(a, I_LN1B) + l * 1024;
    const int mi = row0 < NLAT ? (row0 >> 13) : 2; const GAS float* mod = (const GAS float*)(ws + WS_MOD) + ((size_t)l * 3 + mi) * 6144;
    float x0[16], x1[16];
    ln1_mod2((const GAS float*)(ws + WS_XPRE) + (size_t)row0 * 1024, (GAS float*)(ws + WS_XS) + (size_t)row0 * 1024, (GAS bf16*)(ws + WS_HBF) + (size_t)row0 * 1024, g1, b1, mod + 3072, mod + 4096, x0, lane);
    ln1_mod2((const GAS float*)(ws + WS_XPRE) + (size_t)(row0 + 1) * 1024, (GAS float*)(ws + WS_XS) + (size_t)(row0 + 1) * 1024, (GAS bf16*)(ws + WS_HBF) + (size_t)(row0 + 1) * 1024, g1, b1, mod + 3072, mod + 4096, x1, lane);
    float p0[32], p1[32];
#pragma unroll
    for (int e = 0; e < 32; ++e) { float s0 = 0.f, s1 = 0.f;
#pragma unroll
        for (int i = 0; i < 16; ++i) { const float w = wT[e * 1025 + lane + 64 * i]; s0 += x0[i] * w; s1 += x1[i] * w; }
        p0[e] = s0; p1[e] = s1; }
    const float t0 = reduce32(p0, lane), t1 = reduce32(p1, lane);
    const GAS float* rb = (const GAS float*)INP(a, I_RB) + l * 32;
    route_row(ws, l, row0, t0, rb, lane, dry, lcnt); route_row(ws, l, row0 + 1, t1, rb, lane, dry, lcnt);
}

__device__ __forceinline__ int moe_table(const Fr& F, unsigned char* ws, int l, LAS int* pst, LAS int* cntl, LAS int* ptab) {
    if (F.tid < 64) { const int e = F.tid & 31; const GAS unsigned* cnt = (const GAS unsigned*)(ws + WS_CTL) + CW_CNT + l * 32 * 64;
        const int c = (int)__hip_atomic_load(cnt + e * 64, __ATOMIC_RELAXED, __HIP_MEMORY_SCOPE_AGENT); const int np = (c + 255) >> 8;
        int incl = np;
#pragma unroll
        for (int o = 1; o < 32; o <<= 1) { const int v = __shfl_up(incl, o, 32); if (e >= o) incl += v; }
        const int first = incl - np;
        if (F.tid < 32) { cntl[e] = c; pst[e] = first << 8; if (e == 31) pst[32] = incl << 8;
#pragma unroll 1
            for (int j = 0; j < np; ++j) ptab[first + j] = e; } }
    __syncthreads();
    return __builtin_amdgcn_readfirstlane(pst[32] >> 8);
}

__device__ __forceinline__ void combine_row(const Fr& F, const Args& a, unsigned char* ws, int l, int row, GAS float* xso) {
    const int lane = F.lane; const GAS bf16* ys = (const GAS bf16*)(ws + WS_YSLOT) + (size_t)row * 4 * 1024; GAS float* xs = (GAS float*)(ws + WS_XS) + (size_t)row * 1024;
    const int mi = row < NLAT ? (row >> 13) : 2; const GAS float* mod = (const GAS float*)(ws + WS_MOD) + ((size_t)l * 3 + mi) * 6144; const GAS float* g2 = mod + 5120;
    const GAS float* lg = (const GAS float*)INP(a, I_LN2G) + l * 1024; const GAS float* lb = (const GAS float*)INP(a, I_LN2B) + l * 1024;
    f32x4 v[4]; float s = 0.f;
#pragma unroll
    for (int j = 0; j < 4; ++j) { const int k = 4 * lane + 256 * j; f32x4 f; f.x = 0.f; f.y = 0.f; f.z = 0.f; f.w = 0.f;
#pragma unroll
        for (int kk = 0; kk < 4; ++kk) { const v2u w = *(const GAS v2u*)(ys + (size_t)kk * 1024 + k); f.x += bflo(w.x); f.y += bfhi(w.x); f.z += bflo(w.y); f.w += bfhi(w.y); }
        v[j] = *(const GAS f32x4*)(xs + k) * DN_ALPHA + *(const GAS f32x4*)(g2 + k) * f; s += (v[j].x + v[j].y) + (v[j].z + v[j].w); }
    const float mean = wave_sum(s) * (1.f / 1024.f); float q = 0.f;
#pragma unroll
    for (int j = 0; j < 4; ++j) { v[j] = v[j] - mean; q += (v[j].x * v[j].x + v[j].y * v[j].y) + (v[j].z * v[j].z + v[j].w * v[j].w); }
    const float rstd = 1.f / sqrtf(wave_sum(q) * (1.f / 1024.f) + LN_EPS);
#pragma unroll
    for (int j = 0; j < 4; ++j) { const int k = 4 * lane + 256 * j; v[j] = v[j] * rstd * *(const GAS f32x4*)(lg + k) + *(const GAS f32x4*)(lb + k); if (l == 0) *(GAS f32x4*)(xso + (size_t)row * 1024 + k) = v[j]; }
    if (l == 1) {
#pragma unroll
        for (int j = 0; j < 4; ++j) *(GAS f32x4*)((GAS float*)a.out + (size_t)row * 1024 + 4 * lane + 256 * j) = v[j];
    }
}

constexpr int NPH_PRO = 3, NPH_LAYER = 12, NPH = NPH_PRO + 2 * NPH_LAYER;
constexpr float QSCALE = 0.10206207261596575f * 1.4426950408889634f;

__global__ void __launch_bounds__(512, 2) fwd(Args args) {
    extern __shared__ __attribute__((aligned(16))) unsigned char lds[];
    Fr F; F.L = (LAS unsigned char*)lds; F.tid = threadIdx.x; F.lane = F.tid & 63; F.wave = __builtin_amdgcn_readfirstlane(F.tid >> 6); F.G = gridDim.x; F.bid = blockIdx.x;
    volatile LAS unsigned* MISC = (volatile LAS unsigned*)(F.L + LDS_MISC);
    unsigned char* wsraw = args.ws; unsigned char* ws = (unsigned char*)(GAS unsigned char*)wsraw;
#define ctl ((unsigned*)(ws + WS_CTL))
    for (int u = F.tid; u < (LDS_BYTES - LDS_MISC) / 4; u += 512) ((LAS unsigned*)(F.L + LDS_MISC))[u] = 0u;
    __syncthreads();
#if !MK_PER_PHASE
    XcdBarrier bar = xcd_barrier_post(ctl + CW_BAR, MISC + 8);
#define SEAM() xcd_barrier(bar)
#else
#define SEAM() do {} while (0)
#endif
#define HYF(l_, Ln_, blk_, FILT_, HP_) hy_filter_item(F.L, F.tid, INP(args, I_HW1) + (size_t)(l_) * 33 * 64, INP(args, I_HB1) + (l_) * 64, INP(args, I_HW2) + (size_t)(l_) * 64 * 64, INP(args, I_HB2) + (l_) * 64, INP(args, I_HFREQ) + (l_) * 64, INP(args, I_HW3) + (size_t)(l_) * 64 * 2048, Ln_, blk_, FILT_, HP_)
#define PHASE_BEGIN() do { asm volatile("" : "+v"(F.tid)); F.lane = F.tid & 63; asm volatile("" : "+s"(wsraw)); ws = (unsigned char*)(GAS unsigned char*)wsraw; gw = F.bid * 8 + F.wave; gt = F.bid * 512 + F.tid; } while (0)
    const int lo = args.ph_lo, hi = args.ph_hi;
#ifndef MK_ATTVAR
#define MK_ATTVAR 0
#endif
#ifndef MK_DUP
#define MK_DUP 0
#endif
#ifndef MK_DUPN
#define MK_DUPN 1
#endif
#define TIMES(k) (1 + ((MK_DUP >> (k)) & 1) * MK_DUPN)
#ifndef MK_SUB
#define MK_SUB 0xffff
#endif
#define SUB(k) ((MK_SUB >> (k)) & 1)
#ifndef MK_MASK
#define MK_MASK 0x7fff
#endif
#define IN(k) (((MK_MASK >> (k)) & 1) && lo <= (k) && (k) < hi)
#define INL(j) (((MK_MASK >> (3 + (j))) & 1) && lo <= (pb + (j)) && (pb + (j)) < hi)
    int gw = F.bid * 8 + F.wave, gt = F.bid * 512 + F.tid; const int NGW = F.G * 8, NGT = F.G * 512;

    if (IN(0)) for (int r_ = 0; r_ < 1 + (args.dupk == 0); ++r_) {
        PHASE_BEGIN();
        for (int rep_ = 0; rep_ < TIMES(0); ++rep_) {
        __syncthreads();
        for (int step_ = 0; step_ < 2; ++step_) { const bool do_filt = (step_ == 0) == ((F.bid & 1) != 0); __syncthreads();
        if (!do_filt) {
        { LAS float* scr = (LAS float*)(F.L + F.wave * 8448);
          constexpr int I_IN = 16 * 214, I_UQ = 6 * 24, I_UKV = 4 * 32, I_BR = 8 * 32, I_OUT = 16 * 32, I_M1 = 32 * 16 * 64, I_M2 = 32 * 16 * 32, PER_LAYER = I_IN + I_UQ + I_UKV + 3 * I_BR + I_OUT + I_M1 + I_M2;
          for (int it = gw; it < 2 * PER_LAYER; it += NGW) {
              const int l = it / PER_LAYER; int r = it - l * PER_LAYER; unsigned char* wbl = ws + WS_W + (size_t)l * WB_LAYER;
              if (r < I_IN) { tr_item(INP(args, I_WIN) + (size_t)l * 1024 * INTOT, 1024, INTOT, (bf16*)(wbl + WB_IN), 0, nullptr, 1.f, scr, r, F.lane); continue; } r -= I_IN;
              if (r < I_UQ) { tr_item(INP(args, I_WUQ) + (size_t)l * 384 * 768, 384, 768, (bf16*)(wbl + WB_UQ), 0, INP(args, I_QNORM) + l * 384, QSCALE, scr, r, F.lane); continue; } r -= I_UQ;
              if (r < I_UKV) { tr_item(INP(args, I_WUKV) + (size_t)l * 256 * 1024, 256, 1024, (bf16*)(wbl + WB_UKV), 0, INP(args, I_KVNORM) + l * 256, 1.f, scr, r, F.lane); continue; } r -= I_UKV;
              if (r < 3 * I_BR) { const int br = r / I_BR; tr_item(INP(args, I_WBG + br) + (size_t)l * 512 * 1024, 512, 1024, (bf16*)(wbl + WB_BR) + (size_t)br * 1024 * 512, 0, nullptr, 1.f, scr, r - br * I_BR, F.lane); continue; } r -= 3 * I_BR;
              if (r < I_OUT) { tr_item(INP(args, I_WOUT) + (size_t)l * 1024 * 1024, 1024, 1024, (bf16*)(wbl + WB_OUT), 0, nullptr, 1.f, scr, r, F.lane); continue; } r -= I_OUT;
              if (r < I_M1) { const int e = r >> 10; tr_item(INP(args, I_MW1) + ((size_t)l * 32 + e) * 1024 * 2048, 1024, 2048, (bf16*)(wbl + WB_M1) + (size_t)e * 2048 * 1024, 1, nullptr, 1.f, scr, r & 1023, F.lane); continue; } r -= I_M1;
              { const int e = r >> 9; tr_item(INP(args, I_MW2) + ((size_t)l * 32 + e) * 1024 * 1024, 1024, 1024, (bf16*)(wbl + WB_M2) + (size_t)e * 1024 * 1024, 0, nullptr, 1.f, scr, r & 511, F.lane); }
          }
          for (int i = gt; i < 2 * 64 * 1024 / 8; i += NGT) { const int l = i >> 13, j = i & 8191; *(v4u*)((bf16*)(ws + WS_W + (size_t)l * WB_LAYER + WB_IN) + (size_t)INTOT * 1024 + (size_t)j * 8) = (v4u){0u, 0u, 0u, 0u}; }
        }
        if (F.bid < 192) { LAS float* act = (LAS float*)(F.L + 98304);
            __syncthreads();
            for (int i = F.tid; i < 3072; i += 512) { const float x = i < 2048 ? INP(args, I_C)[i] : INP(args, I_CCTX)[i - 2048]; act[i] = silu_(x); }
            __syncthreads();
            for (int it = F.bid; it < 192; it += F.G) { const int l = it / 96, r = it - l * 96, kb = r / 12, nb = r - kb * 12, n = nb * 512 + F.tid;
                const float* W = INP(args, I_ADAW) + (size_t)l * 1024 * 6144; float a0 = 0.f, a1 = 0.f, a2 = 0.f;
#pragma unroll 8
                for (int k = kb * 128; k < kb * 128 + 128; ++k) { const float w = W[(size_t)k * 6144 + n]; a0 += act[k] * w; a1 += act[1024 + k] * w; a2 += act[2048 + k] * w; }
                float* mp = (float*)(ws + WS_MODP) + (((size_t)kb * 2 + l) * 3) * 6144 + n; mp[0] = a0; mp[6144] = a1; mp[2 * 6144] = a2; } }
        for (int i = gt; i < 8192 * 16; i += NGT) { const int t = i >> 4, j = i & 15; const float pos = (float)((j < 8) ? (t >> 6) : (t & 63)); const float inv = powf(10000.f, -(float)(j & 7) / 8.f); const float ang = pos * inv;
            float* rp = (float*)(ws + WS_ROPE) + (size_t)i * 2; rp[0] = cosf(ang); rp[1] = sinf(ang); }
        for (int i = gt; i < FFTN; i += NGT) { float sn, cs; sincospif((float)i / 8192.f, &sn, &cs); f32x2 w; w.x = cs; w.y = -sn; ((f32x2*)(ws + WS_TW))[i] = w; }
        } else {
        __syncthreads();
        for (int it = F.bid; it < 264; it += F.G) { if (it < 256) HYF(0, 8192, it, (float*)(ws + WS_FILT), (float*)(ws + WS_HPART)); else HYF(0, 256, it - 256, (float*)(ws + WS_FILTC), (float*)(ws + WS_HPARTC)); }
        } }
        }
        SEAM();
    }
#ifdef MK_XBAR
    for (int k_ = 0; k_ < MK_XBAR; ++k_) SEAM();
#endif
    if (IN(1)) {
        PHASE_BEGIN();
        for (int i = gt; i < 2 * 3 * 6144; i += NGT) { const int l = i / 18432, n = i % 6144; float s = INP(args, I_ADAB)[l * 6144 + n];
#pragma unroll
            for (int kb = 0; kb < 8; ++kb) s += ((const float*)(ws + WS_MODP))[(size_t)kb * 2 * 18432 + i];
            ((float*)(ws + WS_MOD))[i] = s; }
        SEAM();
    }
    if (IN(2)) for (int r_ = 0; r_ < 1 + (args.dupk == 2); ++r_) {
        PHASE_BEGIN();
        for (int row = gw; row < MALL; row += NGW) { const int mi = row < NLAT ? (row >> 13) : 2; const float* mod = (const float*)(ws + WS_MOD) + (size_t)mi * 6144;
            ln_mod_row(row < NLAT ? INP(args, I_X) + (size_t)row * 1024 : INP(args, I_CTX) + (size_t)(row - NLAT) * 1024, mod, mod + 1024, (bf16*)(ws + WS_HBF) + (size_t)row * 1024, F.lane); }
        SEAM();
    }

    for (int l = 0; l < 2; ++l) {
        const int pb = NPH_PRO + l * NPH_LAYER;
#define wb (ws + WS_W + (size_t)l * WB_LAYER)
        const int nrows = l == 1 ? NLAT : MALL, nPM = nrows / 256;
        if (INL(0)) for (int r_ = 0; r_ < 1 + (args.dupk == 3); ++r_) {
            PHASE_BEGIN();
            if (SUB(0)) { pg8::Gemm g{(const bf16*)(ws + WS_HBF), (const bf16*)(wb + WB_IN), MALL, INPAD, 1024}; pg8::StaticOrder S; S.init(MALL, INPAD, F.G, F.bid);
              pg8::EpiP E{(GAS bf16*)(ws + WS_P), INPAD};
              pg8::gemm_phase<pg8::EpiP, pg8::StaticOrder, true, true>(F.L, g, S, E, F.tid); }
            if (TIMES(2) > 1) { PHASE_BEGIN(); pg8::Gemm g{(const bf16*)(ws + WS_HBF), (const bf16*)(wb + WB_IN), MALL, INPAD, 1024}; pg8::StaticOrder S; S.init(MALL, INPAD, F.G, F.bid);
#ifdef MK_NULLEPI
              pg8::EpiNull E{}; pg8::gemm_phase<pg8::EpiNull, pg8::StaticOrder, true, true>(F.L, g, S, E, F.tid);
#else
              pg8::EpiP E{(GAS bf16*)(ws + WS_P), INPAD}; pg8::gemm_phase<pg8::EpiP, pg8::StaticOrder, true, true>(F.L, g, S, E, F.tid);
#endif
            }
            PHASE_BEGIN();
            for (int rep_ = 0; rep_ < TIMES(3); ++rep_) if (SUB(1)) for (int c = F.bid; c < 512; c += F.G) kspec_item(F, ws, c);
            SEAM();
        }
        if (INL(1)) for (int r_ = 0; r_ < 1 + (args.dupk == 4); ++r_) {
            PHASE_BEGIN();
            for (int rep_ = 0; rep_ < TIMES(4); ++rep_) {
            __syncthreads();
            const int nconv = 2 * 64 * 24 + (l == 0 ? 2 * 2 * 24 : 0);
            for (int it = F.bid; it < nconv; it += F.G) {
                if (it < 2 * 64 * 24) { const int cb = it % 24, tb = (it / 24) & 63, b = it / (24 * 64);
                    conv3_item(F, args, (const GAS bf16*)(ws + WS_P) + (size_t)b * SEQ * INPAD, SEQ, (GAS bf16*)(ws + WS_HYT) + (size_t)b * SEQ, l, tb * 128, cb * 64); }
                else { const int i2 = it - 2 * 64 * 24; const int cb = i2 % 24, tb = (i2 / 24) & 1, b = i2 / (24 * 2);
                    conv3_item(F, args, (const GAS bf16*)(ws + WS_P) + (size_t)(NLAT + b * CTXL) * INPAD, CTXL, (GAS bf16*)(ws + WS_HYTC) + (size_t)b * CTXL, l, tb * 128, cb * 64); }
            }
            LAS float* wa = (LAS float*)(F.L + 65536);
            for (int i = F.tid; i < 8192; i += 512) wa[i] = i < 4096 ? INP(args, I_WA2F)[(size_t)l * 4096 + i] : INP(args, I_WA2B)[(size_t)l * 4096 + i - 4096];
            __syncthreads();
            for (int row = gw; row < MALL; row += NGW) post_row(F, args, ws, l, row, wa);
            }
            SEAM();
        }
        if (INL(2)) for (int r_ = 0; r_ < 1 + (args.dupk == 5); ++r_) {
            PHASE_BEGIN();
            for (int rep_ = 0; rep_ < TIMES(5); ++rep_) if (SUB(2)) { pg8::Gemm g{(const bf16*)(ws + WS_NQ), (const bf16*)(wb + WB_UQ), nrows, 768, 384}; pg8::StaticOrder S; S.init(nrows, 768, F.G, F.bid);
              pg8::EpiP E{(GAS bf16*)(ws + WS_QB), 768};
              pg8::gemm_phase<pg8::EpiP, pg8::StaticOrder, true, true>(F.L, g, S, E, F.tid); }
            PHASE_BEGIN();
            for (int rep_ = 0; rep_ < TIMES(5); ++rep_) if (SUB(3)) { pg8::Gemm g{(const bf16*)(ws + WS_NKV), (const bf16*)(wb + WB_UKV), MALL, 1024, 256}; pg8::StaticOrder S; S.init(MALL, 1024, F.G, (F.bid + F.G - 230 % F.G) % F.G);
              pg8::EpiKV E{(GAS bf16*)(ws + WS_KB), (GAS bf16*)(ws + WS_VT), NLAT, KEYS, CTXL};
              pg8::gemm_phase<pg8::EpiKV, pg8::StaticOrder, true, true>(F.L, g, S, E, F.tid); }
            PHASE_BEGIN();
            for (int rep_ = 0; rep_ < TIMES(7); ++rep_) for (int it = (F.bid + F.G - 198 % F.G) % F.G; it < 1056; it += F.G) gla_a_item(F, ws, it);
            PHASE_BEGIN();
            for (int rep_ = 0; rep_ < TIMES(6); ++rep_) if (SUB(4)) for (int c = F.bid; c < 512; c += F.G) hyconv_item(F, args, ws, l, c);
            PHASE_BEGIN();
            for (int rep_ = 0; rep_ < TIMES(15); ++rep_) if (SUB(5) && l == 0) for (int c = F.bid; c < 512; c += F.G) hyctx_item(F, args, ws, l, c);
            SEAM();
        }
        if (INL(3)) {
            PHASE_BEGIN();
            const int nunits = 512 + (l == 0 ? 16 : 0);
            for (int it = F.bid; it < 256; it += F.G) gla_scan_q(F, ws, it);
            for (int rep_ = 0; rep_ < TIMES(8); ++rep_) { unsigned* qh = ctl + CW_QCTR + (l * 4 + rep_) * 64;
            for (;;) {
                if (F.tid == 0) MISC[0] = __hip_atomic_fetch_add(qh, 1u, __ATOMIC_RELAXED, __HIP_MEMORY_SCOPE_AGENT);
                __syncthreads();
                int u = __builtin_amdgcn_readfirstlane((int)MISC[0]);
                __syncthreads();
                if (u >= nunits) break;
                int bh, qrow0, nt;
                if (u < 512) { bh = u >> 5; qrow0 = (bh >> 3) * SEQ + (u & 31) * 256; nt = KEYS / 64; } else { bh = u - 512; qrow0 = NLAT + (bh >> 3) * CTXL; nt = CTXL / 64; }
                attn_unit(rep_ == 0 ? 0 : MK_ATTVAR, F, (const GAS bf16*)(ws + WS_QB), (const GAS bf16*)(ws + WS_KB) + (size_t)bh * KEYS * 96, (const GAS bf16*)(ws + WS_VT) + (size_t)bh * 64 * KEYS, rep_ == 0 ? (GAS bf16*)(ws + WS_OBR) + (size_t)MALL * 512 : (GAS bf16*)(ws + WS_XPRE), qrow0, bh & 7, nt, (const GAS float*)(ws + WS_ROPE));
            }
            }
            SEAM();
        }
        if (INL(4)) for (int r_ = 0; r_ < 1 + (args.dupk == 7); ++r_) {
            PHASE_BEGIN();
            for (int rep_ = 0; rep_ < TIMES(9); ++rep_) {
            for (int it = F.bid; it < 1056; it += F.G) { if (l == 1 && (it % 132) < 4) continue; gla_c_item(F, args, ws, l, it); }
            for (int it = F.bid; it < 2048; it += F.G) hy_tr_item(F, ws, it);
            }
            SEAM();
        }
        if (INL(5)) for (int r_ = 0; r_ < 1 + (args.dupk == 8); ++r_) {
            PHASE_BEGIN();
            pg8::Gemm g{(const bf16*)(ws + WS_OBR), (const bf16*)(wb + WB_BR), MALL, 1024, 512}; pg8::MergeOrder S{nPM, MALL / 256, F.G, F.bid};
            pg8::EpiU E{(GAS bf16*)(ws + WS_U), MALL / 256};
            pg8::gemm_phase<pg8::EpiU, pg8::MergeOrder, true, true>(F.L, g, S, E, F.tid);
            if (TIMES(10) > 1) { PHASE_BEGIN(); pg8::gemm_phase<pg8::EpiU, pg8::MergeOrder, true, true>(F.L, g, S, E, F.tid); }
            SEAM();
            PHASE_BEGIN();
            for (int rep_ = 0; rep_ < TIMES(17); ++rep_) for (int row = gw; row < nrows; row += NGW) gate_row(F, ws, row);
            SEAM();
        }
        if (INL(6)) for (int r_ = 0; r_ < 1 + (args.dupk == 9); ++r_) {
            PHASE_BEGIN();
            pg8::Gemm g{(const bf16*)(ws + WS_YMB), (const bf16*)(wb + WB_OUT), nrows, 1024, 1024}; pg8::StaticOrder S; S.init(nrows, 1024, F.G, F.bid);
            pg8::EpiOut E{l == 0 ? (const GAS float*)INP(args, I_X) : (const GAS float*)(ws + WS_XS), l == 0 ? (const GAS float*)INP(args, I_CTX) - (size_t)NLAT * 1024 : (const GAS float*)(ws + WS_XS), (GAS float*)(ws + WS_XPRE), (const GAS float*)(ws + WS_MOD) + (size_t)l * 18432, NLAT, DN_ALPHA};
            pg8::gemm_phase<pg8::EpiOut, pg8::StaticOrder, true, true>(F.L, g, S, E, F.tid);
            if (TIMES(11) > 1) { PHASE_BEGIN(); pg8::gemm_phase<pg8::EpiOut, pg8::StaticOrder, true, true>(F.L, g, S, E, F.tid); }
            SEAM();
        }
        if (INL(7)) {
            PHASE_BEGIN();
            LAS float* wT = (LAS float*)F.L; const float* rw = INP(args, I_RW) + (size_t)l * 1024 * 32;
            LAS unsigned* lcnt = (LAS unsigned*)(F.L + LDS_TAB + 512); LAS unsigned* lbase = lcnt + 32;
#pragma unroll 8
            for (int i = F.tid; i < 32768; i += 512) wT[(i & 31) * 1025 + (i >> 5)] = rw[i];
            if (F.tid < 32) lcnt[F.tid] = 0u;
            __syncthreads();
            for (int rep_ = TIMES(1) - 1; rep_ >= 0; --rep_) for (int rp = gw; rp < nrows / 2; rp += NGW) ln1_router_row2(F, args, ws, l, 2 * rp, wT, rep_ > 0, lcnt);
            __syncthreads();
            if (F.tid < 32) lbase[F.tid] = __hip_atomic_fetch_add(ctl + CW_CNT + (l * 32 + F.tid) * 64, lcnt[F.tid], __ATOMIC_RELAXED, __HIP_MEMORY_SCOPE_AGENT);
            __syncthreads();
            if (F.lane < 8) { int* tope = (int*)(ws + WS_TOPE); int* spos = (int*)(ws + WS_SPOS);
                for (int rp = gw; rp < nrows / 2; rp += NGW) { const int s_ = rp * 8 + F.lane; spos[s_] += (int)lbase[tope[s_]]; } }
            SEAM();
        }
        LAS int* pst = (LAS int*)(F.L + LDS_TAB); LAS int* cntl = pst + 64; LAS int* ptab = pst + 128;
        if (INL(8)) for (int r_ = 0; r_ < 1 + (args.dupk == 11); ++r_) {
            PHASE_BEGIN();
            moe_table(F, ws, l, pst, cntl, ptab);
            for (int rep_ = 0; rep_ < TIMES(12); ++rep_) {
            const int nslot = nrows * 4; const int* tope = (const int*)(ws + WS_TOPE); const int* spos = (const int*)(ws + WS_SPOS); int* rslot = (int*)(ws + WS_RSLOT);
            for (int s = gt; s < nslot; s += NGT) rslot[pst[tope[s]] + spos[s]] = s;
            for (int i = gt; i < 32 * 256; i += NGT) { const int e = i >> 8, r = pst[e] + cntl[e] + (i & 255); if (r < pst[e + 1]) rslot[r] = -1; }
            }
            SEAM();
        }
        if (INL(9)) for (int r_ = 0; r_ < 1 + (args.dupk == 12); ++r_) {
            PHASE_BEGIN();
            const int npanel = moe_table(F, ws, l, pst, cntl, ptab);
            pg8::Gemm g{(const bf16*)(ws + WS_HBF), (const bf16*)(wb + WB_M1), XG_ROWS, 2048, 1024}; pg8::MoeOrder<8> S{(const LAS int*)ptab, npanel, F.G, F.bid};
            pg8::EpiMoe1 E{(GAS bf16*)(ws + WS_ACT), (const GAS float*)INP(args, I_MB1) + (size_t)l * 32 * 2048};
            pg8::gemm_phase_g<pg8::EpiMoe1, pg8::MoeOrder<8>, true, true>(F.L, g, S, E, F.tid, (const GAS int*)(ws + WS_RSLOT));
            if (TIMES(13) > 1) { PHASE_BEGIN(); pg8::gemm_phase_g<pg8::EpiMoe1, pg8::MoeOrder<8>, true, true>(F.L, g, S, E, F.tid, (const GAS int*)(ws + WS_RSLOT)); }
            SEAM();
        }
        if (INL(10)) for (int r_ = 0; r_ < 1 + (args.dupk == 13); ++r_) {
            PHASE_BEGIN();
            const int npanel = moe_table(F, ws, l, pst, cntl, ptab);
            pg8::Gemm g{(const bf16*)(ws + WS_ACT), (const bf16*)(wb + WB_M2), XG_ROWS, 1024, 1024}; pg8::MoeOrder<4> S{(const LAS int*)ptab, npanel, F.G, F.bid};
            pg8::EpiMoe2 E{(GAS bf16*)(ws + WS_YSLOT), (const GAS float*)INP(args, I_MB2) + (size_t)l * 32 * 1024, (const GAS int*)(ws + WS_RSLOT), (const GAS float*)(ws + WS_TOPG)};
            pg8::gemm_phase<pg8::EpiMoe2, pg8::MoeOrder<4>, true, true>(F.L, g, S, E, F.tid);
            if (TIMES(14) > 1) { PHASE_BEGIN(); pg8::gemm_phase<pg8::EpiMoe2, pg8::MoeOrder<4>, true, true>(F.L, g, S, E, F.tid); }
            if (l == 0) { PHASE_BEGIN(); __syncthreads();
                for (int it = (F.G - 1 - F.bid); it < 256; it += F.G) HYF(1, 8192, it, (float*)(ws + WS_FILT), (float*)(ws + WS_HPART)); }
            SEAM();
        }
        if (INL(11)) {
            PHASE_BEGIN();
            for (int rep_ = TIMES(16) - 1; rep_ >= 0; --rep_) for (int row = gw; row < nrows; row += NGW) { combine_row(F, args, ws, l, row, rep_ > 0 ? (GAS float*)(ws + WS_XPRE) : (GAS float*)(ws + WS_XS));
                if (l == 0) { const int mi = row < NLAT ? (row >> 13) : 2; const float* mod = (const float*)(ws + WS_MOD) + (size_t)(3 + mi) * 6144;
                    ln_mod_row((const float*)(ws + WS_XS) + (size_t)row * 1024, mod, mod + 1024, (bf16*)(ws + WS_HBF) + (size_t)row * 1024, F.lane); } }
            if (l == 0) SEAM();
        }
    }
#undef wb
#undef ctl
#undef IN
#undef INL
}

extern "C" void kernel_launch(void* const* d_in, const int* in_sizes, int n_in, void* d_out, int out_size, void* d_ws, size_t ws_size, hipStream_t stream) {
    static int grid = 0;
    if (grid == 0) {
        if (n_in != 39 || out_size != NLAT * D || ws_size < WS_END) { fprintf(stderr, "kernel_launch: expected 39 inputs, %d outputs, >= %zu B workspace; got %d, %d, %zu\n", NLAT * D, (size_t)WS_END, n_in, out_size, ws_size); grid = -1; return; }
        int dev = 0, cus = 0, per_cu = 0;
        if (hipGetDevice(&dev) != hipSuccess || hipDeviceGetAttribute(&cus, hipDeviceAttributeMultiprocessorCount, dev) != hipSuccess) { grid = -1; return; }
        if (hipFuncSetAttribute((const void*)fwd, hipFuncAttributeMaxDynamicSharedMemorySize, LDS_BYTES) != hipSuccess) { fprintf(stderr, "kernel_launch: hipFuncSetAttribute failed\n"); grid = -1; return; }
        if (hipOccupancyMaxActiveBlocksPerMultiprocessor(&per_cu, (const void*)fwd, 512, LDS_BYTES) != hipSuccess || per_cu < 1) fprintf(stderr, "kernel_launch: occupancy query says %d\n", per_cu);
        (void)hipGetLastError();
        grid = cus;
    }
    if (grid < 0) return;
    (void)hipMemsetAsync((char*)d_ws + WS_CTL, 0, (size_t)CW_DBG * 4, stream);
    Args a{};
    for (int i = 0; i < 39; ++i) a.in[i] = (const float*)d_in[i];
    a.out = (float*)d_out; a.ws = (unsigned char*)d_ws;
#ifdef MK_DUPPH
    a.dupk = MK_DUPPH;
#else
    a.dupk = -1;
#endif
#if MK_PER_PHASE
    for (int ph = 0; ph < NPH; ++ph) { a.ph_lo = ph; a.ph_hi = ph + 1; hipLaunchKernelGGL(fwd, dim3(grid), dim3(512), LDS_BYTES, stream, a); }
#else
    a.ph_lo = 0; a.ph_hi = NPH;
    hipLaunchKernelGGL(fwd, dim3(grid), dim3(512), LDS_BYTES, stream, a);
#endif
}
```

```cpp
#include <hip/hip_runtime.h>
#include <cstdio>
#include <cstdint>

#ifndef MK_PER_PHASE
#define MK_PER_PHASE 0
#endif

constexpr int D = 1024, NB = 2, SEQ = 8192, CTXL = 256, NLAT = NB * SEQ, NCTX = NB * CTXL, MALL = NLAT + NCTX;
constexpr int KEYS = CTXL + SEQ;
constexpr int INTOT = 6848, INPAD = 6912;
constexpr int O_GK = 0, O_GV = 256, O_GAF = 768, O_GAB = 784, O_MKVA = 800, O_MKR = 1056, O_GQ = 1088, O_GR = 1344, O_MQA = 1856, O_HY = 2240, O_GATE = 3776;
constexpr int NEXP = 32, TOPK = 4, NSLOT = MALL * TOPK;
constexpr int XG_ROWS = 75776;
constexpr int NPANEL_MAX = XG_ROWS / 256;
constexpr float LN_EPS = 1e-5f, RMS_EPS = 1e-6f, DN_ALPHA = 1.41421356237f;
constexpr int FFTN = 16384;

constexpr size_t al256(size_t x) { return (x + 255) & ~(size_t)255; }
constexpr size_t WS_CTL = 0, CTL_ZERO_BYTES = 1u << 20;
constexpr size_t WS_MODP = CTL_ZERO_BYTES;
constexpr size_t WS_MOD = WS_MODP + al256((size_t)8 * 2 * 3 * 6144 * 4);
constexpr size_t WS_ROPE = WS_MOD + al256((size_t)2 * 3 * 6144 * 4);
constexpr size_t WS_TW = WS_ROPE + al256((size_t)8192 * 16 * 2 * 4);
constexpr size_t WS_HPART = WS_TW + al256((size_t)FFTN * 8);
constexpr size_t WS_HPARTC = WS_HPART + al256((size_t)256 * 1024 * 4);
constexpr size_t WS_TOPE = WS_HPARTC + al256((size_t)8 * 1024 * 4);
constexpr size_t WS_TOPG = WS_TOPE + al256((size_t)NSLOT * 4);
constexpr size_t WS_SPOS = WS_TOPG + al256((size_t)NSLOT * 4);
constexpr size_t WS_RSLOT = WS_SPOS + al256((size_t)NSLOT * 4);
constexpr size_t WS_GDEC = WS_RSLOT + al256((size_t)XG_ROWS * 4);
constexpr size_t WB_IN = 0, WB_UQ = WB_IN + (size_t)INPAD * 1024 * 2, WB_UKV = WB_UQ + (size_t)768 * 384 * 2, WB_BR = WB_UKV + (size_t)1024 * 256 * 2,
                 WB_OUT = WB_BR + (size_t)3 * 1024 * 512 * 2, WB_M1 = WB_OUT + (size_t)1024 * 1024 * 2, WB_M2 = WB_M1 + (size_t)32 * 2048 * 1024 * 2,
                 WB_LAYER = WB_M2 + (size_t)32 * 1024 * 1024 * 2;
constexpr size_t WS_W = WS_GDEC + al256((size_t)16 * 132 * 64 * 4);
constexpr size_t WS_XS = WS_W + 2 * WB_LAYER;
constexpr size_t WS_XPRE = WS_XS + (size_t)MALL * D * 4;
constexpr size_t WS_HBF = WS_XPRE + (size_t)MALL * D * 4;
constexpr size_t WS_P = WS_HBF + (size_t)MALL * D * 2;
constexpr size_t WS_XG = WS_P;
constexpr size_t WS_NQ = WS_P + (size_t)MALL * INPAD * 2;
constexpr size_t WS_NKV = WS_NQ + (size_t)MALL * 384 * 2;
constexpr size_t WS_QB = WS_NKV + (size_t)MALL * 256 * 2;
constexpr size_t WS_KB = WS_QB + (size_t)MALL * 768 * 2;
constexpr size_t WS_VT = WS_KB + (size_t)16 * KEYS * 96 * 2;
constexpr size_t WS_AF = WS_VT + (size_t)16 * 64 * KEYS * 2;
constexpr size_t WS_AB = WS_AF + (size_t)MALL * 256 * 4;
constexpr size_t WS_YM = WS_AB + (size_t)MALL * 256 * 4;
constexpr size_t WS_GSB = WS_YM;
static_assert((size_t)16 * 132 * 8192 * 2 <= (size_t)MALL * D * 4, "GSB overlay");
constexpr int ECAP = MALL;
constexpr size_t WS_ELIST = WS_YM + ((size_t)40 << 20);
static_assert(WS_GSB + (size_t)16 * 132 * 8192 * 2 <= WS_ELIST && WS_ELIST + (size_t)32 * ECAP * 4 <= WS_YM + (size_t)MALL * D * 4, "ELIST overlay");
constexpr size_t WS_YMB = WS_YM + (size_t)MALL * D * 4;
constexpr size_t WS_U = WS_YMB + (size_t)MALL * D * 2;
constexpr size_t WS_R1 = WS_U + (size_t)MALL * 3072 * 2;
constexpr size_t WS_OF = WS_R1;
constexpr size_t WS_GST = WS_R1;
constexpr size_t WS_OB = WS_OF + (size_t)MALL * 512 * 4;
constexpr size_t WS_HYT = WS_OB + (size_t)MALL * 512 * 4;
constexpr size_t WS_HYTC = WS_HYT + (size_t)1536 * NLAT * 2;
constexpr size_t WS_OHYT = WS_HYTC + (size_t)1536 * NCTX * 2;
constexpr size_t WS_OBR = WS_OHYT + (size_t)512 * NLAT * 2;
constexpr size_t WS_R1_END = WS_OBR + (size_t)3 * MALL * 512 * 2;
constexpr size_t WS_YSLOT = WS_R1;
static_assert(WS_YSLOT + (size_t)NSLOT * D * 2 <= WS_R1_END, "YSLOT overlay");
static_assert(WS_GST + (size_t)16 * 132 * 8192 * 4 <= WS_HYT, "GST overlay");
constexpr size_t WS_FILT = WS_R1_END;
constexpr size_t WS_FILTC = WS_FILT + (size_t)4 * 512 * 8192 * 4;
constexpr size_t WS_R2 = WS_FILTC + (size_t)4 * 512 * 256 * 4;
constexpr size_t WS_K0S = WS_R2;
constexpr size_t WS_K1S = WS_K0S + (size_t)512 * FFTN * 8;
constexpr size_t WS_R2_END = WS_R2 + (size_t)XG_ROWS * D * 2;
constexpr size_t WS_ACT = WS_R2;
static_assert(WS_ACT + (size_t)XG_ROWS * D * 2 <= WS_R2_END && WS_K1S + (size_t)512 * FFTN * 8 <= WS_R2_END, "ACT overlay");
static_assert((size_t)XG_ROWS * D * 2 <= (size_t)MALL * INPAD * 2, "XG overlay");
constexpr size_t WS_END = WS_R2_END;

constexpr int CW_BAR = 4096;
constexpr int CW_CNT = 8192;
constexpr int CW_QCTR = 8192 + 2 * 32 * 64;
constexpr int CW_DBG = 16384;
static_assert(CW_QCTR + 8 * 64 <= CW_DBG, "ctl map");

constexpr int LDS_STAGE = 147456;
constexpr int LDS_TAB = LDS_STAGE;
constexpr int LDS_MISC = LDS_STAGE + 4096;
constexpr int LDS_BYTES = 155648;

#define GAS __attribute__((address_space(1)))
#define LAS __attribute__((address_space(3)))
typedef unsigned short bf16;
typedef unsigned v4u __attribute__((ext_vector_type(4)));
typedef unsigned v2u __attribute__((ext_vector_type(2)));
typedef float f32x2 __attribute__((ext_vector_type(2)));
typedef float f32x4 __attribute__((ext_vector_type(4)));
typedef float f32x16 __attribute__((ext_vector_type(16)));
typedef short bf16x8 __attribute__((ext_vector_type(8)));
#define LDS_WAIT() asm volatile("s_waitcnt lgkmcnt(0)" ::: "memory")
#define VM_WAIT() asm volatile("s_waitcnt vmcnt(0)" ::: "memory")
typedef __bf16 bf16v2_t __attribute__((ext_vector_type(2)));
__device__ __forceinline__ unsigned pk2(float lo, float hi) { f32x2 f; f.x = lo; f.y = hi; return __builtin_bit_cast(unsigned, __builtin_convertvector(f, bf16v2_t)); }
__device__ __forceinline__ unsigned f2bf(float f) { return (unsigned)__builtin_bit_cast(unsigned short, (__bf16)f); }
__device__ __forceinline__ float bf2f(unsigned h) { return __builtin_bit_cast(float, h << 16); }
__device__ __forceinline__ float bflo(unsigned w) { return __builtin_bit_cast(float, w << 16); }
__device__ __forceinline__ float bfhi(unsigned w) { return __builtin_bit_cast(float, w & 0xffff0000u); }
template <int CTRL> __device__ __forceinline__ float dpp_mov(float v) { return __builtin_bit_cast(float, __builtin_amdgcn_update_dpp(0, __builtin_bit_cast(int, v), CTRL, 0xf, 0xf, true)); }
__device__ __forceinline__ float rd_lane(float v, int l) { return __builtin_bit_cast(float, __builtin_amdgcn_readlane(__builtin_bit_cast(int, v), l)); }
__device__ __forceinline__ float wave_sum(float v) {
    v += dpp_mov<0xB1>(v); v += dpp_mov<0x4E>(v); v += dpp_mov<0x141>(v); v += dpp_mov<0x140>(v);
    return (rd_lane(v, 0) + rd_lane(v, 16)) + (rd_lane(v, 32) + rd_lane(v, 48));
}
__device__ __forceinline__ float wave_max(float v) {
    v = fmaxf(v, dpp_mov<0xB1>(v)); v = fmaxf(v, dpp_mov<0x4E>(v)); v = fmaxf(v, dpp_mov<0x141>(v)); v = fmaxf(v, dpp_mov<0x140>(v));
    return fmaxf(fmaxf(rd_lane(v, 0), rd_lane(v, 16)), fmaxf(rd_lane(v, 32), rd_lane(v, 48)));
}
__device__ __forceinline__ float sigmoidf_(float x) { return 1.f / (1.f + __expf(-x)); }

namespace pg8 {
#define PG8_LAS __attribute__((address_space(3)))
typedef unsigned short bf16_t;
typedef short bf16x8 __attribute__((ext_vector_type(8)));
typedef float f32x4 __attribute__((ext_vector_type(4)));
typedef unsigned u32x4 __attribute__((ext_vector_type(4)));
constexpr int BM = 256, BK = 64, HALF = 128, HTB = HALF * BK * 2  , STAGE_BYTES = 8 * HTB, NXCD = 8, WGM = 8;

__host__ __device__ __forceinline__ int lds_byte(int r, int c) { const int st = (r >> 4) * 2 + (c >> 5), rr = r & 15, cc = c & 31, ob = rr * 64 + cc * 2; return st * 1024 + (ob ^ (((ob >> 9) & 1) << 5)); }
__host__ __device__ __forceinline__ void stage_rc(int b, int& R, int& C) { const int st = b / 1024, sb = b % 1024, swz = sb ^ (((sb >> 9) & 1) << 5); R = (st >> 1) * 16 + swz / 64; C = (st & 1) * 32 + (swz % 64) / 2; }
__host__ __device__ __forceinline__ int perm32(int rho) { const int n = rho >> 4, i = rho & 15; return 8 * (i >> 2) + 4 * n + (i & 3); }

struct Unit { int pm, pn; };
struct Gemm { const bf16_t* A; const bf16_t* Bt; int M, N, K; };

struct StaticOrder {
    int nM, nN, nwg, G, c;
    __host__ __device__ void init(int M, int N, int G_, int c_) { nM = M / BM; nN = N / BM; nwg = nM * nN; G = G_; c = c_; }
    __host__ __device__ bool next(int i, Unit& u) const {
        const long L = (long)i * G + c; if (L >= nwg) return false;
        int wgid = (int)L; { const int q = nwg / NXCD, r = nwg % NXCD, xcd = wgid % NXCD, off = wgid / NXCD; wgid = (xcd < r ? xcd * (q + 1) : r * (q + 1) + (xcd - r) * q) + off; }
        const int nig = WGM * nN, gid = wgid / nig, fm = gid * WGM, gsz = (nM - fm) < WGM ? (nM - fm) : WGM;
        u.pm = fm + ((wgid % nig) % gsz); u.pn = (wgid % nig) / gsz; return true;
    }
    __device__ __forceinline__ void a_ready(const Unit&) const {}
    __device__ __forceinline__ void done(const Unit&) const {}
};

__device__ __forceinline__ unsigned cvt_pk_bf16(float lo, float hi) { return ::pk2(lo, hi); }
typedef float f32x2 __attribute__((ext_vector_type(2)));

typedef unsigned u32x2e __attribute__((ext_vector_type(2)));
__device__ __forceinline__ unsigned pkbf(float lo, float hi) { return cvt_pk_bf16(lo, hi); }

struct EpiP {
    static constexpr bool PERM = true, AFTER_DRAIN = false;
    __attribute__((address_space(1))) bf16_t* O; int ldc;
    __device__ __forceinline__ void operator()(const f32x4 (&acc)[2][2][4][2], const Unit& u, int wr, int wc, int fr, int fq) const {
        const int row0 = u.pm * BM + wr * 64 + fr, col0 = u.pn * BM + wc * 32 + 8 * fq;
#pragma unroll
        for (int ai = 0; ai < 2; ++ai)
#pragma unroll
            for (int m = 0; m < 4; ++m) { __attribute__((address_space(1))) bf16_t* rowp = O + (size_t)(row0 + ai * HALF + m * 16) * ldc + col0;
#pragma unroll
                for (int bj = 0; bj < 2; ++bj) { const f32x4 v0 = acc[ai][bj][m][0], v1 = acc[ai][bj][m][1];
                    u32x4 w; w.x = pkbf(v0[0], v0[1]); w.y = pkbf(v0[2], v0[3]); w.z = pkbf(v1[0], v1[1]); w.w = pkbf(v1[2], v1[3]);
                    *(__attribute__((address_space(1))) u32x4*)(rowp + bj * HALF) = w; } }
    }
};

struct EpiU {
    static constexpr bool PERM = true, AFTER_DRAIN = false;
    __attribute__((address_space(1))) bf16_t* O; int sPM;
    __device__ __forceinline__ void operator()(const f32x4 (&acc)[2][2][4][2], const Unit& u, int wr, int wc, int fr, int fq) const {
        const int pm = u.pm % sPM; const int row0 = pm * BM + wr * 64 + fr, col0 = u.pn * BM + wc * 32 + 8 * fq;
#pragma unroll
        for (int ai = 0; ai < 2; ++ai)
#pragma unroll
            for (int m = 0; m < 4; ++m) { __attribute__((address_space(1))) bf16_t* rowp = O + (size_t)(row0 + ai * HALF + m * 16) * 3072 + col0;
#pragma unroll
                for (int bj = 0; bj < 2; ++bj) { const f32x4 v0 = acc[ai][bj][m][0], v1 = acc[ai][bj][m][1];
                    u32x4 w; w.x = pkbf(v0[0], v0[1]); w.y = pkbf(v0[2], v0[3]); w.z = pkbf(v1[0], v1[1]); w.w = pkbf(v1[2], v1[3]);
                    *(__attribute__((address_space(1))) u32x4*)(rowp + bj * HALF) = w; } }
    }
};

struct EpiNull {
    static constexpr bool PERM = true, AFTER_DRAIN = false;
    __device__ __forceinline__ void operator()(const f32x4 (&acc)[2][2][4][2], const Unit& u, int wr, int wc, int fr, int fq) const {
#pragma unroll
        for (int ai = 0; ai < 2; ++ai)
#pragma unroll
            for (int bj = 0; bj < 2; ++bj)
#pragma unroll
                for (int m = 0; m < 4; ++m)
#pragma unroll
                    for (int n = 0; n < 2; ++n) asm volatile("" :: "v"(acc[ai][bj][m][n]));
    }
};

struct EpiQ {
    static constexpr bool PERM = false, AFTER_DRAIN = false;
    bf16_t* O; const float* rope; int nlat;
    __device__ __forceinline__ void operator()(const f32x4 (&acc)[2][2][4][2], const Unit& u, int wr, int wc, int fr, int fq) const {
        const int row0 = u.pm * BM + wr * 64 + fr;
#pragma unroll
        for (int bj = 0; bj < 2; ++bj) {
            const int g32 = u.pn * 8 + bj * 4 + wc; const bool isrope = (g32 % 3) == 2; const int colb = g32 * 32 + 4 * fq;
#pragma unroll
            for (int ai = 0; ai < 2; ++ai)
#pragma unroll
                for (int m = 0; m < 4; ++m) { const int row = row0 + ai * HALF + m * 16;
                    f32x4 v0 = acc[ai][bj][m][0], v1 = acc[ai][bj][m][1];
                    if (isrope && row < nlat) { const float* cs = rope + ((size_t)(row & 8191) * 16 + 4 * fq) * 2;
                        const f32x4 c01 = *(const f32x4*)cs, c23 = *(const f32x4*)(cs + 4);
                        const float c[4] = {c01[0], c01[2], c23[0], c23[2]}, s[4] = {c01[1], c01[3], c23[1], c23[3]};
                        f32x4 a, b;
#pragma unroll
                        for (int i = 0; i < 4; ++i) { a[i] = v0[i] * c[i] - v1[i] * s[i]; b[i] = v1[i] * c[i] + v0[i] * s[i]; }
                        v0 = a; v1 = b; }
                    bf16_t* p = O + (size_t)row * 768 + colb;
                    u32x2e w0, w1; w0.x = pkbf(v0[0], v0[1]); w0.y = pkbf(v0[2], v0[3]); w1.x = pkbf(v1[0], v1[1]); w1.y = pkbf(v1[2], v1[3]);
                    *(u32x2e*)p = w0; *(u32x2e*)(p + 16) = w1; }
        }
    }
};

struct EpiKV {
    static constexpr bool PERM = false, AFTER_DRAIN = false;
    __attribute__((address_space(1))) bf16_t* KB; __attribute__((address_space(1))) bf16_t* VT; int nlat, keys, ctxl;
    __device__ __forceinline__ void operator()(const f32x4 (&acc)[2][2][4][2], const Unit& u, int wr, int wc, int fr, int fq) const {
        const int row0 = u.pm * BM + wr * 64 + fr;
#pragma unroll
        for (int ai = 0; ai < 2; ++ai)
#pragma unroll
            for (int m = 0; m < 4; ++m) { const int row = row0 + ai * HALF + m * 16;
                int b, key; if (row < nlat) { b = row >> 13; key = ctxl + (row & 8191); } else { const int r2 = row - nlat; b = r2 >> 8; key = r2 & 255; }
#pragma unroll
                for (int bj = 0; bj < 2; ++bj) { const int head = u.pn * 2 + bj; const size_t bh = (size_t)(b * 8 + head);
#pragma unroll
                    for (int n = 0; n < 2; ++n) { const f32x4 v = acc[ai][bj][m][n]; const int cw = (wc & 1) * 32 + n * 16 + 4 * fq;
                        if (wc < 2) { u32x2e w; w.x = pkbf(v[0], v[1]); w.y = pkbf(v[2], v[3]); *(__attribute__((address_space(1))) u32x2e*)(KB + (bh * keys + key) * 96 + cw) = w; }
                        else { __attribute__((address_space(1))) bf16_t* p = VT + (bh * 64 + cw) * keys + key; const unsigned w0 = pkbf(v[0], v[1]), w1 = pkbf(v[2], v[3]);
                            p[0] = (bf16_t)(w0 & 0xffff); p[(size_t)keys] = (bf16_t)(w0 >> 16); p[(size_t)2 * keys] = (bf16_t)(w1 & 0xffff); p[(size_t)3 * keys] = (bf16_t)(w1 >> 16); } } }
                asm volatile("" ::: "memory"); }
    }
};

struct EpiMerge {
    static constexpr bool PERM = false, AFTER_DRAIN = false;
    const bf16_t* P; float* YM; bf16_t* YMB; int nPM, ldp, ogate;
    __device__ __forceinline__ void operator()(const f32x4 (&acc)[2][2][4][2], const Unit& u, int wr, int wc, int fr, int fq) const {
        const int br = u.pm / nPM, pm = u.pm - br * nPM, pn = u.pn & 3;
        const int row0 = pm * BM + wr * 64 + fr;
#pragma unroll
        for (int ai = 0; ai < 2; ++ai)
#pragma unroll
            for (int m = 0; m < 4; ++m) { const int row = row0 + ai * HALF + m * 16;
#pragma unroll
                for (int bj = 0; bj < 2; ++bj)
#pragma unroll
                    for (int n = 0; n < 2; ++n) { const int col = pn * BM + bj * HALF + wc * 32 + n * 16 + 4 * fq;
                        const u32x2e gw = *(const u32x2e*)(P + (size_t)row * ldp + ogate + br * 1024 + col);
                        const float g0 = __builtin_bit_cast(float, gw.x << 16), g1 = __builtin_bit_cast(float, gw.x & 0xffff0000u), g2 = __builtin_bit_cast(float, gw.y << 16), g3 = __builtin_bit_cast(float, gw.y & 0xffff0000u);
                        f32x4 v = acc[ai][bj][m][n];
                        v[0] *= 1.f / (1.f + __expf(-g0)); v[1] *= 1.f / (1.f + __expf(-g1)); v[2] *= 1.f / (1.f + __expf(-g2)); v[3] *= 1.f / (1.f + __expf(-g3));
                        float* yp = YM + (size_t)row * 1024 + col;
                        if (br == 0) *(f32x4*)yp = v;
                        else if (br == 1) { const f32x4 o = *(const f32x4*)yp; *(f32x4*)yp = o + v; }
                        else { const f32x4 o = *(const f32x4*)yp + v; u32x2e w; w.x = pkbf(o[0], o[1]); w.y = pkbf(o[2], o[3]); *(u32x2e*)(YMB + (size_t)row * 1024 + col) = w; } } }
    }
};

struct EpiOut {
    static constexpr bool PERM = false, AFTER_DRAIN = false;
    const __attribute__((address_space(1))) float* XL; const __attribute__((address_space(1))) float* XC; __attribute__((address_space(1))) bf16_t* XPRE; const __attribute__((address_space(1))) float* mod; int nlat; float alpha; int rb;
    __device__ __forceinline__ void operator()(const f32x4 (&acc)[2][2][4][2], const Unit& u, int wr, int wc, int fr, int fq) const {
        const int rbase = u.pm * BM, row0 = rbase + wr * 64 + fr; const int mi = rbase < nlat ? (rbase >> 13) : 2; const int colb = u.pn * BM + wc * 32 + 4 * fq;
        const __attribute__((address_space(1))) float* xr = (rbase < nlat ? XL : XC) + (size_t)row0 * 1024 + colb;
        const __attribute__((address_space(1))) bf16_t* xrb = (const __attribute__((address_space(1))) bf16_t*)XL + (size_t)row0 * 1024 + colb;
        __attribute__((address_space(1))) bf16_t* orow = XPRE + (size_t)row0 * 1024 + colb;
        const __attribute__((address_space(1))) float* gp = mod + mi * 6144 + 2048 + colb;
        f32x4 gv[2][2], xq[2][2][2];
#define EPO_LOAD(dst, roff) do { if (rb) { const u32x2e w_ = *(const __attribute__((address_space(1))) u32x2e*)(xrb + (roff)); dst[0] = ::bflo(w_.x); dst[1] = ::bfhi(w_.x); dst[2] = ::bflo(w_.y); dst[3] = ::bfhi(w_.y); } \
                                 else dst = *(const __attribute__((address_space(1))) f32x4*)(xr + (roff)); } while (0)
#pragma unroll
        for (int bj = 0; bj < 2; ++bj)
#pragma unroll
            for (int n = 0; n < 2; ++n) { gv[bj][n] = *(const __attribute__((address_space(1))) f32x4*)(gp + bj * HALF + n * 16); EPO_LOAD(xq[0][bj][n], bj * HALF + n * 16); }
#pragma unroll
        for (int k = 0; k < 8; ++k) { const int ai = k >> 2, m = k & 3; const size_t ro = (size_t)(ai * HALF + m * 16) * 1024;
            if (k + 1 < 8) { const size_t rn = (size_t)(((k + 1) >> 2) * HALF + ((k + 1) & 3) * 16) * 1024;
#pragma unroll
                for (int bj = 0; bj < 2; ++bj)
#pragma unroll
                    for (int n = 0; n < 2; ++n) EPO_LOAD(xq[(k + 1) & 1][bj][n], rn + bj * HALF + n * 16); }
#pragma unroll
            for (int bj = 0; bj < 2; ++bj)
#pragma unroll
                for (int n = 0; n < 2; ++n) { const f32x4 y = xq[k & 1][bj][n] * alpha + gv[bj][n] * acc[ai][bj][m][n];
                    u32x2e w; w.x = pkbf(y[0], y[1]); w.y = pkbf(y[2], y[3]); *(__attribute__((address_space(1))) u32x2e*)(orow + ro + bj * HALF + n * 16) = w; } }
#undef EPO_LOAD
    }
};

struct EpiMoe1 {
    static constexpr bool PERM = false, AFTER_DRAIN = false;
    __attribute__((address_space(1))) bf16_t* ACT; const __attribute__((address_space(1))) float* b1;
    __device__ __forceinline__ void operator()(const f32x4 (&acc)[2][2][4][2], const Unit& u, int wr, int wc, int fr, int fq) const {
        const int e = u.pn >> 3, j = u.pn & 7; const int row0 = u.pm * BM + wr * 64 + fr; const __attribute__((address_space(1))) float* be = b1 + (size_t)e * 2048;
        const int colb = 128 * j + wc * 32 + 4 * fq;
        const f32x4 bg0 = *(const __attribute__((address_space(1))) f32x4*)(be + colb), bl0 = *(const __attribute__((address_space(1))) f32x4*)(be + 1024 + colb), bg1 = *(const __attribute__((address_space(1))) f32x4*)(be + colb + 16), bl1 = *(const __attribute__((address_space(1))) f32x4*)(be + 1024 + colb + 16);
#pragma unroll
        for (int ai = 0; ai < 2; ++ai)
#pragma unroll
            for (int m = 0; m < 4; ++m) { const int row = row0 + ai * HALF + m * 16; __attribute__((address_space(1))) bf16_t* op = ACT + (size_t)row * 1024 + colb;
#pragma unroll
                for (int n = 0; n < 2; ++n) { const f32x4 g = acc[ai][0][m][n] + (n ? bg1 : bg0), l = acc[ai][1][m][n] + (n ? bl1 : bl0); f32x4 o;
#pragma unroll
                    for (int i = 0; i < 4; ++i) { const float gg = fminf(g[i], 7.f), ll = fminf(fmaxf(l[i], -7.f), 7.f);
                        o[i] = gg * __builtin_amdgcn_rcpf(1.f + __builtin_amdgcn_exp2f(-1.702f * 1.4426950408889634f * gg)) * (ll + 1.f); }
                    u32x2e w; w.x = pkbf(o[0], o[1]); w.y = pkbf(o[2], o[3]); *(__attribute__((address_space(1))) u32x2e*)(op + n * 16) = w; }
                __builtin_amdgcn_sched_barrier(0); }
    }
};

struct EpiMoe2 {
    static constexpr bool PERM = false, AFTER_DRAIN = false;
    __attribute__((address_space(1))) bf16_t* YSLOT; const __attribute__((address_space(1))) float* b2; const __attribute__((address_space(1))) int* rslot; const __attribute__((address_space(1))) float* gate;
    const PG8_LAS int* pst; const PG8_LAS int* cnt;
    __device__ __forceinline__ void operator()(const f32x4 (&acc)[2][2][4][2], const Unit& u, int wr, int wc, int fr, int fq) const {
        const int e = u.pn >> 2, j = u.pn & 3; const int row0 = u.pm * BM + wr * 64 + fr; const int colb = j * BM + wc * 32 + 4 * fq; const __attribute__((address_space(1))) float* be = b2 + (size_t)e * 1024 + colb;
        f32x4 bv[2][2]; int slot[8]; float gt[8]; const int pe = pst[e], ce = cnt[e];
#pragma unroll
        for (int bj = 0; bj < 2; ++bj)
#pragma unroll
            for (int n = 0; n < 2; ++n) bv[bj][n] = *(const __attribute__((address_space(1))) f32x4*)(be + bj * HALF + n * 16);
#pragma unroll
        for (int k = 0; k < 8; ++k) { const int rl = row0 + (k >> 2) * HALF + (k & 3) * 16 - pe; slot[k] = rl < ce ? rslot[e * 16896 + rl] : -1; }
#pragma unroll
        for (int k = 0; k < 8; ++k) gt[k] = slot[k] >= 0 ? gate[slot[k]] : 0.f;
#pragma unroll
        for (int k = 0; k < 8; ++k) { const int ai = k >> 2, m = k & 3;
            if (slot[k] >= 0) { __attribute__((address_space(1))) bf16_t* yr = YSLOT + (size_t)slot[k] * 1024 + colb;
#pragma unroll
                for (int bj = 0; bj < 2; ++bj)
#pragma unroll
                    for (int n = 0; n < 2; ++n) { const f32x4 o = (acc[ai][bj][m][n] + bv[bj][n]) * gt[k];
                        u32x2e w; w.x = pkbf(o[0], o[1]); w.y = pkbf(o[2], o[3]); *(__attribute__((address_space(1))) u32x2e*)(yr + bj * HALF + n * 16) = w; } }
            __builtin_amdgcn_sched_barrier(0); }
    }
};

struct MergeOrder {
    int nPM, sPM, G, c;
    __device__ __forceinline__ bool next(int i, Unit& u) const {
        const int L = i * G + c; if (L >= nPM * 12) return false;
        const int t = L / 3, br = L - 3 * t, pm = t >> 2, pn = t & 3; u.pm = br * sPM + pm; u.pn = br * 4 + pn; return true;
    }
    __device__ __forceinline__ void a_ready(const Unit&) const {}
    __device__ __forceinline__ void done(const Unit&) const {}
};
constexpr int ECAP_ = 16896;
template <int nN> struct MoeOrder {
    const PG8_LAS int* ptab; int npanel, G, c; const PG8_LAS int* pst; const PG8_LAS int* cnt;
    __device__ __forceinline__ int rowslot(const Unit& u, int r, const __attribute__((address_space(1))) int* list) const {
        const int e = u.pn / nN; const int rl = r - pst[e]; return rl < cnt[e] ? list[e * ECAP_ + rl] : -1; }
    __device__ __forceinline__ bool next(int i, Unit& u) const {
        constexpr int PB = 32 / nN; int pm, pn;
        if (G == 256) { const int x = c & 7, w = c >> 3, s = i * 8 + x; pm = s * PB + w / nN; pn = w % nN; }
        else { const int L = i * G + c; pm = L / nN; pn = L - pm * nN; }
        if (pm >= npanel) return false;
        const int e = __builtin_amdgcn_readfirstlane(ptab[pm]);
        u.pm = pm; u.pn = e * nN + pn; return true;
    }
    __device__ __forceinline__ void a_ready(const Unit&) const {}
    __device__ __forceinline__ void done(const Unit&) const {}
};
template <class Epi, class Sched, bool ALIGN_EPI = false, bool SP2 = false>
__device__ __forceinline__ void gemm_phase(PG8_LAS unsigned char* lds, const Gemm g, const Sched& S, const Epi& E, const int tid) {
    const int wid = __builtin_amdgcn_readfirstlane(tid >> 6), lane = tid & 63, wr = wid >> 2, wc = wid & 3, fr = lane & 15, fq = lane >> 4;
    const int K = g.K, nt = K / BK;
    unsigned voffA[2], voffB[2];
#pragma unroll
    for (int i = 0; i < 2; ++i) { int R, C; stage_rc(tid * 16 + i * 8192, R, C); const int Rb = Epi::PERM ? ((R & ~31) + perm32(R & 31)) : R;
        voffA[i] = (unsigned)(R * K + C) * 2u; voffB[i] = (unsigned)(Rb * K + C) * 2u; }
    const size_t kstep = (size_t)(BK * 2);
    const size_t hstep = (size_t)HALF * K * 2;
    const size_t tstep = 2 * hstep;
    const unsigned ldsw = (unsigned)wid * 1024u;
    const int aoff = lds_byte(wr * 64 + fr, fq * 8), boff = lds_byte(wc * 32 + fr, fq * 8);
#define PG8_SA(b, h) (((b) * 2 + (h)) * HTB)
#define PG8_SB(b, h) ((4 + (b) * 2 + (h)) * HTB)
#define PG8_STAGE(bufoff, gbase, voff) do { _Pragma("unroll") for (int _i = 0; _i < 2; ++_i) \
        __builtin_amdgcn_global_load_lds((const unsigned*)((const char*)(gbase) + (voff)[_i]), (PG8_LAS unsigned*)(lds + (bufoff) + ldsw + _i * 8192), 16, 0, 0); } while (0)
#define PG8_LDA(dst, b, h) do { _Pragma("unroll") for (int m = 0; m < 4; ++m) _Pragma("unroll") for (int k = 0; k < 2; ++k) dst[m][k] = *(const PG8_LAS bf16x8*)(lds + PG8_SA(b, h) + aoff + m * 2048 + k * 1024); } while (0)
#define PG8_LDB(dst, b, h) do { _Pragma("unroll") for (int n = 0; n < 2; ++n) _Pragma("unroll") for (int k = 0; k < 2; ++k) dst[n][k] = *(const PG8_LAS bf16x8*)(lds + PG8_SB(b, h) + boff + n * 2048 + k * 1024); } while (0)
#define PG8_MMA(ai, bj, At, Bt) do { __builtin_amdgcn_s_setprio(1); _Pragma("unroll") for (int m = 0; m < 4; ++m) _Pragma("unroll") for (int n = 0; n < 2; ++n) _Pragma("unroll") for (int k = 0; k < 2; ++k) \
        acc[ai][bj][m][n] = __builtin_amdgcn_mfma_f32_16x16x32_bf16(Bt[n][k], At[m][k], acc[ai][bj][m][n], 0, 0, 0); __builtin_amdgcn_s_setprio(0); } while (0)
#define PG8_WAIT_V(n) asm volatile("s_waitcnt vmcnt(" #n ")" ::: "memory")
#define PG8_WAIT_L(n) asm volatile("s_waitcnt lgkmcnt(" #n ")" ::: "memory")
#define PG8_BAR __builtin_amdgcn_s_barrier()
#define PG8_SCHED __builtin_amdgcn_sched_barrier(0)
    Unit cur, nxt; int ui = 0;
    if (!S.next(0, cur)) return;
    f32x4 acc[2][2][4][2];
#pragma unroll
    for (int a = 0; a < 2; ++a)
#pragma unroll
        for (int b = 0; b < 2; ++b)
#pragma unroll
            for (int m = 0; m < 4; ++m)
#pragma unroll
                for (int n = 0; n < 2; ++n) acc[a][b][m][n] = (f32x4){0.f, 0.f, 0.f, 0.f};
    bf16x8 At[4][2], B0[2][2], B1[2][2];
    const char* cA = (const char*)g.A + (size_t)cur.pm * tstep; const char* cB = (const char*)g.Bt + (size_t)cur.pn * tstep;
    S.a_ready(cur);
    if constexpr (SP2) {
        PG8_STAGE(PG8_SB(0, 0), cB, voffB); PG8_STAGE(PG8_SB(0, 1), cB + hstep, voffB); PG8_STAGE(PG8_SA(0, 0), cA, voffA); PG8_STAGE(PG8_SA(0, 1), cA + hstep, voffA);
        if (wr == 1) PG8_BAR;
        PG8_WAIT_V(2); PG8_BAR;
        PG8_STAGE(PG8_SB(1, 0), cB + kstep, voffB); PG8_STAGE(PG8_SA(1, 0), cA + kstep, voffA); PG8_STAGE(PG8_SB(1, 1), cB + hstep + kstep, voffB);
        PG8_WAIT_V(6); PG8_BAR;
    } else {
        PG8_STAGE(PG8_SB(0, 0), cB, voffB); PG8_STAGE(PG8_SA(0, 0), cA, voffA); PG8_STAGE(PG8_SB(0, 1), cB + hstep, voffB); PG8_STAGE(PG8_SA(0, 1), cA + hstep, voffA);
        if (wr == 1) PG8_BAR;
        PG8_WAIT_V(4); PG8_BAR;
        PG8_STAGE(PG8_SB(1, 0), cB + kstep, voffB); PG8_STAGE(PG8_SA(1, 0), cA + kstep, voffA); PG8_STAGE(PG8_SB(1, 1), cB + hstep + kstep, voffB);
        PG8_WAIT_V(6); PG8_BAR;
    }
    for (;;) {
        const bool has_next = S.next(ui + 1, nxt);
        const char* nA = has_next ? (const char*)g.A + (size_t)nxt.pm * tstep : cA; const char* nB = has_next ? (const char*)g.Bt + (size_t)nxt.pn * tstep : cB;
#pragma unroll 1
        for (int t = 0; t < nt; t += 2) {
            const bool last = (t == nt - 2);
            const char* a1 = cA + (size_t)(t + 1) * kstep;
            const char* a2 = last ? nA : cA + (size_t)(t + 2) * kstep; const char* b2 = last ? nB : cB + (size_t)(t + 2) * kstep;
            const char* a3 = a2 + kstep; const char* b3 = b2 + kstep;
            if (last && has_next) S.a_ready(nxt);
            if constexpr (SP2) {
            PG8_LDB(B0, 0, 0); PG8_LDB(B1, 0, 1); PG8_SCHED; PG8_LDA(At, 0, 0); PG8_STAGE(PG8_SA(1, 1), a1 + hstep, voffA);
            PG8_WAIT_V(8); PG8_WAIT_L(0); PG8_BAR; PG8_MMA(0, 0, At, B0); PG8_MMA(0, 1, At, B1); PG8_BAR; PG8_SCHED;
            PG8_LDA(At, 0, 1); PG8_STAGE(PG8_SB(0, 0), b2, voffB); PG8_STAGE(PG8_SB(0, 1), b2 + hstep, voffB); PG8_STAGE(PG8_SA(0, 0), a2, voffA);
            PG8_WAIT_V(8); PG8_WAIT_L(0); PG8_BAR; PG8_MMA(1, 0, At, B0); PG8_MMA(1, 1, At, B1); PG8_BAR; PG8_SCHED;
            PG8_LDB(B0, 1, 0); PG8_LDB(B1, 1, 1); PG8_SCHED; PG8_LDA(At, 1, 0); PG8_STAGE(PG8_SA(0, 1), a2 + hstep, voffA);
            PG8_WAIT_V(8); PG8_WAIT_L(0); PG8_BAR; PG8_MMA(0, 0, At, B0); PG8_MMA(0, 1, At, B1); PG8_BAR; PG8_SCHED;
            PG8_LDA(At, 1, 1); PG8_STAGE(PG8_SB(1, 0), b3, voffB); PG8_STAGE(PG8_SB(1, 1), b3 + hstep, voffB); PG8_STAGE(PG8_SA(1, 0), a3, voffA);
            PG8_WAIT_V(8); PG8_WAIT_L(0); PG8_BAR; PG8_MMA(1, 0, At, B0); PG8_MMA(1, 1, At, B1); PG8_BAR; PG8_SCHED;
            } else {
            PG8_LDB(B0, 0, 0); PG8_SCHED; PG8_LDA(At, 0, 0); PG8_STAGE(PG8_SA(1, 1), a1 + hstep, voffA);
            PG8_WAIT_L(8); PG8_BAR; PG8_WAIT_L(0); PG8_MMA(0, 0, At, B0); PG8_BAR; PG8_SCHED;
            PG8_LDB(B1, 0, 1); PG8_STAGE(PG8_SB(0, 0), b2, voffB);
            PG8_BAR; PG8_WAIT_L(0); PG8_MMA(0, 1, At, B1); PG8_BAR;
            PG8_LDA(At, 0, 1); PG8_STAGE(PG8_SA(0, 0), a2, voffA);
            PG8_BAR; PG8_WAIT_L(0); PG8_MMA(1, 0, At, B0); PG8_BAR; PG8_SCHED;
            PG8_STAGE(PG8_SB(0, 1), b2 + hstep, voffB);
            PG8_WAIT_V(6); PG8_BAR; PG8_MMA(1, 1, At, B1); PG8_BAR;
            PG8_LDB(B0, 1, 0); PG8_SCHED; PG8_LDA(At, 1, 0); PG8_STAGE(PG8_SA(0, 1), a2 + hstep, voffA);
            PG8_WAIT_L(8); PG8_BAR; PG8_WAIT_L(0); PG8_MMA(0, 0, At, B0); PG8_BAR; PG8_SCHED;
            PG8_LDB(B1, 1, 1); PG8_STAGE(PG8_SB(1, 0), b3, voffB);
            PG8_BAR; PG8_WAIT_L(0); PG8_MMA(0, 1, At, B1); PG8_BAR;
            PG8_LDA(At, 1, 1); PG8_STAGE(PG8_SA(1, 0), a3, voffA);
            PG8_BAR; PG8_WAIT_L(0); PG8_MMA(1, 0, At, B0); PG8_BAR; PG8_SCHED;
            PG8_STAGE(PG8_SB(1, 1), b3 + hstep, voffB);
            PG8_WAIT_V(6); PG8_BAR; PG8_MMA(1, 1, At, B1); PG8_BAR;
            }
        }
        if constexpr (ALIGN_EPI) { if (wr == 0) PG8_BAR; }
        if constexpr (!Epi::AFTER_DRAIN) { E(acc, cur, wr, wc, fr, fq); S.done(cur); }
        if (!has_next) break;
#pragma unroll
        for (int a = 0; a < 2; ++a)
#pragma unroll
            for (int b = 0; b < 2; ++b)
#pragma unroll
                for (int m = 0; m < 4; ++m)
#pragma unroll
                    for (int n = 0; n < 2; ++n) acc[a][b][m][n] = (f32x4){0.f, 0.f, 0.f, 0.f};
        cur = nxt; cA = nA; cB = nB; ++ui;
        if constexpr (ALIGN_EPI) { if (wr == 1) PG8_BAR; }
    }
    PG8_WAIT_V(0);
    if constexpr (!ALIGN_EPI) { if (wr == 0) PG8_BAR; }
    PG8_BAR;
    if constexpr (Epi::AFTER_DRAIN) { E.fused(acc, cur, wr, wc, fr, fq, lds, wid, lane); S.done(cur); }
#undef PG8_SA
#undef PG8_SB
#undef PG8_STAGE
#undef PG8_LDA
#undef PG8_LDB
#undef PG8_MMA
#undef PG8_WAIT_V
#undef PG8_WAIT_L
#undef PG8_BAR
#undef PG8_SCHED
}
template <class Epi, class Sched, bool ALIGN_EPI = false, bool SP2 = false>
__device__ __forceinline__ void gemm_phase_g(PG8_LAS unsigned char* lds, const Gemm g, const Sched& S, const Epi& E, const int tid, const __attribute__((address_space(1))) int* rsl) {
    static_assert(SP2, "gather variant: SP2 loop only");
    const int wid = __builtin_amdgcn_readfirstlane(tid >> 6), lane = tid & 63, wr = wid >> 2, wc = wid & 3, fr = lane & 15, fq = lane >> 4;
    const int K = g.K, nt = K / BK;
    unsigned voffA[2] = {0u, 0u}, voffB[2]; int srR[2], srC[2]; unsigned vAc[2][2], vAn[2][2];
#pragma unroll
    for (int i = 0; i < 2; ++i) { int R, C; stage_rc(tid * 16 + i * 8192, R, C); const int Rb = Epi::PERM ? ((R & ~31) + perm32(R & 31)) : R;
        srR[i] = R; srC[i] = C; voffB[i] = (unsigned)(Rb * K + C) * 2u; }
#define PG8_GCALC(dst, un) do { _Pragma("unroll") for (int h_ = 0; h_ < 2; ++h_) _Pragma("unroll") for (int i_ = 0; i_ < 2; ++i_) { const int rr_ = S.rowslot(un, (un).pm * 256 + h_ * 128 + srR[i_], rsl); \
        dst[h_][i_] = (unsigned)(((rr_ < 0 ? 0 : (rr_ >> 2)) * K + srC[i_]) * 2); } } while (0)
    const size_t kstep = (size_t)(BK * 2);
    const size_t hstep = (size_t)HALF * K * 2;
    const size_t tstep = 2 * hstep;
    const unsigned ldsw = (unsigned)wid * 1024u;
    const int aoff = lds_byte(wr * 64 + fr, fq * 8), boff = lds_byte(wc * 32 + fr, fq * 8);
#define PG8_SA(b, h) (((b) * 2 + (h)) * HTB)
#define PG8_SB(b, h) ((4 + (b) * 2 + (h)) * HTB)
#define PG8_STAGE(bufoff, gbase, voff) do { _Pragma("unroll") for (int _i = 0; _i < 2; ++_i) \
        __builtin_amdgcn_global_load_lds((const unsigned*)((const char*)(gbase) + (voff)[_i]), (PG8_LAS unsigned*)(lds + (bufoff) + ldsw + _i * 8192), 16, 0, 0); } while (0)
#define PG8_LDA(dst, b, h) do { _Pragma("unroll") for (int m = 0; m < 4; ++m) _Pragma("unroll") for (int k = 0; k < 2; ++k) dst[m][k] = *(const PG8_LAS bf16x8*)(lds + PG8_SA(b, h) + aoff + m * 2048 + k * 1024); } while (0)
#define PG8_LDB(dst, b, h) do { _Pragma("unroll") for (int n = 0; n < 2; ++n) _Pragma("unroll") for (int k = 0; k < 2; ++k) dst[n][k] = *(const PG8_LAS bf16x8*)(lds + PG8_SB(b, h) + boff + n * 2048 + k * 1024); } while (0)
#define PG8_MMA(ai, bj, At, Bt) do { __builtin_amdgcn_s_setprio(1); _Pragma("unroll") for (int m = 0; m < 4; ++m) _Pragma("unroll") for (int n = 0; n < 2; ++n) _Pragma("unroll") for (int k = 0; k < 2; ++k) \
        acc[ai][bj][m][n] = __builtin_amdgcn_mfma_f32_16x16x32_bf16(Bt[n][k], At[m][k], acc[ai][bj][m][n], 0, 0, 0); __builtin_amdgcn_s_setprio(0); } while (0)
#define PG8_WAIT_V(n) asm volatile("s_waitcnt vmcnt(" #n ")" ::: "memory")
#define PG8_WAIT_L(n) asm volatile("s_waitcnt lgkmcnt(" #n ")" ::: "memory")
#define PG8_BAR __builtin_amdgcn_s_barrier()
#define PG8_SCHED __builtin_amdgcn_sched_barrier(0)
    Unit cur, nxt; int ui = 0;
    if (!S.next(0, cur)) return;
    f32x4 acc[2][2][4][2];
#pragma unroll
    for (int a = 0; a < 2; ++a)
#pragma unroll
        for (int b = 0; b < 2; ++b)
#pragma unroll
            for (int m = 0; m < 4; ++m)
#pragma unroll
                for (int n = 0; n < 2; ++n) acc[a][b][m][n] = (f32x4){0.f, 0.f, 0.f, 0.f};
    bf16x8 At[4][2], B0[2][2], B1[2][2];
    const char* cA = (const char*)g.A; PG8_GCALC(vAc, cur); const char* cB = (const char*)g.Bt + (size_t)cur.pn * tstep;
    S.a_ready(cur);
    if constexpr (SP2) {
        PG8_STAGE(PG8_SB(0, 0), cB, voffB); PG8_STAGE(PG8_SB(0, 1), cB + hstep, voffB); PG8_STAGE(PG8_SA(0, 0), cA, vAc[0]); PG8_STAGE(PG8_SA(0, 1), cA, vAc[1]);
        if (wr == 1) PG8_BAR;
        PG8_WAIT_V(2); PG8_BAR;
        PG8_STAGE(PG8_SB(1, 0), cB + kstep, voffB); PG8_STAGE(PG8_SA(1, 0), cA + kstep, vAc[0]); PG8_STAGE(PG8_SB(1, 1), cB + hstep + kstep, voffB);
        PG8_WAIT_V(6); PG8_BAR;
    } else {
        PG8_STAGE(PG8_SB(0, 0), cB, voffB); PG8_STAGE(PG8_SA(0, 0), cA, voffA); PG8_STAGE(PG8_SB(0, 1), cB + hstep, voffB); PG8_STAGE(PG8_SA(0, 1), cA + hstep, voffA);
        if (wr == 1) PG8_BAR;
        PG8_WAIT_V(4); PG8_BAR;
        PG8_STAGE(PG8_SB(1, 0), cB + kstep, voffB); PG8_STAGE(PG8_SA(1, 0), cA + kstep, voffA); PG8_STAGE(PG8_SB(1, 1), cB + hstep + kstep, voffB);
        PG8_WAIT_V(6); PG8_BAR;
    }
    for (;;) {
        const bool has_next = S.next(ui + 1, nxt);
        const char* nA = cA; if (has_next) PG8_GCALC(vAn, nxt); else { vAn[0][0] = vAc[0][0]; vAn[0][1] = vAc[0][1]; vAn[1][0] = vAc[1][0]; vAn[1][1] = vAc[1][1]; } const char* nB = has_next ? (const char*)g.Bt + (size_t)nxt.pn * tstep : cB;
#pragma unroll 1
        for (int t = 0; t < nt; t += 2) {
            const bool last = (t == nt - 2);
            const char* a1 = cA + (size_t)(t + 1) * kstep;
            const char* a2 = last ? nA : cA + (size_t)(t + 2) * kstep; const char* b2 = last ? nB : cB + (size_t)(t + 2) * kstep;
            const char* a3 = a2 + kstep; const char* b3 = b2 + kstep;
            if (last && has_next) S.a_ready(nxt);
            if constexpr (SP2) {
            PG8_LDB(B0, 0, 0); PG8_LDB(B1, 0, 1); PG8_SCHED; PG8_LDA(At, 0, 0); PG8_STAGE(PG8_SA(1, 1), a1, vAc[1]);
            PG8_WAIT_V(8); PG8_WAIT_L(0); PG8_BAR; PG8_MMA(0, 0, At, B0); PG8_MMA(0, 1, At, B1); PG8_BAR; PG8_SCHED;
            PG8_LDA(At, 0, 1); PG8_STAGE(PG8_SB(0, 0), b2, voffB); PG8_STAGE(PG8_SB(0, 1), b2 + hstep, voffB); PG8_STAGE(PG8_SA(0, 0), a2, (last ? vAn[0] : vAc[0]));
            PG8_WAIT_V(8); PG8_WAIT_L(0); PG8_BAR; PG8_MMA(1, 0, At, B0); PG8_MMA(1, 1, At, B1); PG8_BAR; PG8_SCHED;
            PG8_LDB(B0, 1, 0); PG8_LDB(B1, 1, 1); PG8_SCHED; PG8_LDA(At, 1, 0); PG8_STAGE(PG8_SA(0, 1), a2, (last ? vAn[1] : vAc[1]));
            PG8_WAIT_V(8); PG8_WAIT_L(0); PG8_BAR; PG8_MMA(0, 0, At, B0); PG8_MMA(0, 1, At, B1); PG8_BAR; PG8_SCHED;
            PG8_LDA(At, 1, 1); PG8_STAGE(PG8_SB(1, 0), b3, voffB); PG8_STAGE(PG8_SB(1, 1), b3 + hstep, voffB); PG8_STAGE(PG8_SA(1, 0), a3, (last ? vAn[0] : vAc[0]));
            PG8_WAIT_V(8); PG8_WAIT_L(0); PG8_BAR; PG8_MMA(1, 0, At, B0); PG8_MMA(1, 1, At, B1); PG8_BAR; PG8_SCHED;
            } else {
            PG8_LDB(B0, 0, 0); PG8_SCHED; PG8_LDA(At, 0, 0); PG8_STAGE(PG8_SA(1, 1), a1 + hstep, voffA);
            PG8_WAIT_L(8); PG8_BAR; PG8_WAIT_L(0); PG8_MMA(0, 0, At, B0); PG8_BAR; PG8_SCHED;
            PG8_LDB(B1, 0, 1); PG8_STAGE(PG8_SB(0, 0), b2, voffB);
            PG8_BAR; PG8_WAIT_L(0); PG8_MMA(0, 1, At, B1); PG8_BAR;
            PG8_LDA(At, 0, 1); PG8_STAGE(PG8_SA(0, 0), a2, voffA);
            PG8_BAR; PG8_WAIT_L(0); PG8_MMA(1, 0, At, B0); PG8_BAR; PG8_SCHED;
            PG8_STAGE(PG8_SB(0, 1), b2 + hstep, voffB);
            PG8_WAIT_V(6); PG8_BAR; PG8_MMA(1, 1, At, B1); PG8_BAR;
            PG8_LDB(B0, 1, 0); PG8_SCHED; PG8_LDA(At, 1, 0); PG8_STAGE(PG8_SA(0, 1), a2 + hstep, voffA);
            PG8_WAIT_L(8); PG8_BAR; PG8_WAIT_L(0); PG8_MMA(0, 0, At, B0); PG8_BAR; PG8_SCHED;
            PG8_LDB(B1, 1, 1); PG8_STAGE(PG8_SB(1, 0), b3, voffB);
            PG8_BAR; PG8_WAIT_L(0); PG8_MMA(0, 1, At, B1); PG8_BAR;
            PG8_LDA(At, 1, 1); PG8_STAGE(PG8_SA(1, 0), a3, voffA);
            PG8_BAR; PG8_WAIT_L(0); PG8_MMA(1, 0, At, B0); PG8_BAR; PG8_SCHED;
            PG8_STAGE(PG8_SB(1, 1), b3 + hstep, voffB);
            PG8_WAIT_V(6); PG8_BAR; PG8_MMA(1, 1, At, B1); PG8_BAR;
            }
        }
        if constexpr (ALIGN_EPI) { if (wr == 0) PG8_BAR; }
        if constexpr (!Epi::AFTER_DRAIN) { E(acc, cur, wr, wc, fr, fq); S.done(cur); }
        if (!has_next) break;
#pragma unroll
        for (int a = 0; a < 2; ++a)
#pragma unroll
            for (int b = 0; b < 2; ++b)
#pragma unroll
                for (int m = 0; m < 4; ++m)
#pragma unroll
                    for (int n = 0; n < 2; ++n) acc[a][b][m][n] = (f32x4){0.f, 0.f, 0.f, 0.f};
        cur = nxt; cA = nA; cB = nB; ++ui; vAc[0][0] = vAn[0][0]; vAc[0][1] = vAn[0][1]; vAc[1][0] = vAn[1][0]; vAc[1][1] = vAn[1][1];
        if constexpr (ALIGN_EPI) { if (wr == 1) PG8_BAR; }
    }
    PG8_WAIT_V(0);
    if constexpr (!ALIGN_EPI) { if (wr == 0) PG8_BAR; }
    PG8_BAR;
    if constexpr (Epi::AFTER_DRAIN) { E.fused(acc, cur, wr, wc, fr, fq, lds, wid, lane); S.done(cur); }
#undef PG8_GCALC
#undef PG8_SA
#undef PG8_SB
#undef PG8_STAGE
#undef PG8_LDA
#undef PG8_LDB
#undef PG8_MMA
#undef PG8_WAIT_V
#undef PG8_WAIT_L
#undef PG8_BAR
#undef PG8_SCHED
}
}

#define XB_TMO      128
#define XB_XCNT(j)  (256  + 64 * (j))
#define XB_XSUB(j)  (1280 + 64 * (j))
#define XB_XGEN(j)  (2304 + 64 * (j))
#define XB_TOP      3328
#define XB_TOPGEN   3392
#define XCD_BAR_WORDS 3456
#define XB_SPIN_CAP (1u << 18)

__device__ __forceinline__ unsigned xb_ld(unsigned* p)              { return __hip_atomic_load(p, __ATOMIC_RELAXED, __HIP_MEMORY_SCOPE_AGENT); }
__device__ __forceinline__ unsigned xb_add(unsigned* p, unsigned v) { return __hip_atomic_fetch_add(p, v, __ATOMIC_RELAXED, __HIP_MEMORY_SCOPE_AGENT); }
__device__ __forceinline__ unsigned xb_xcc_id() { return (unsigned)__builtin_amdgcn_s_getreg((3 << 11) | 20) & 0xFu; }
#define XB_SPIN(cond, bar) do { unsigned _sp = 0; while (cond) { __builtin_amdgcn_s_sleep(1); \
    if ((++_sp & 255u) == 0u) { if (xb_ld(&(bar)[XB_TMO])) break; if (_sp > XB_SPIN_CAP) { atomicAdd(&(bar)[XB_TMO], 1u); break; } } } } while (0)

struct XcdBarrier {
    unsigned* bar; unsigned x;
    volatile LAS unsigned* st;
};
__device__ __forceinline__ XcdBarrier xcd_barrier_post(unsigned* bar, volatile LAS unsigned* st) {
    XcdBarrier b; b.bar = bar; b.x = xb_xcc_id(); b.st = st;
    if (threadIdx.x == 0) (void)xb_add(&bar[XB_XCNT(b.x)], 1u);
    return b;
}
__device__ __forceinline__ void xcd_barrier_complete(unsigned* bar, unsigned x, unsigned& nloc, unsigned& nx) {
    const unsigned G = gridDim.x * gridDim.y * gridDim.z;
    unsigned sum, cnt, mine, sp = 0u;
    for (;;) {
        sum = 0u; cnt = 0u; mine = 0u;
#pragma unroll
        for (unsigned j = 0; j < 16; ++j) { const unsigned c = xb_ld(&bar[XB_XCNT(j)]); sum += c; cnt += (c > 0u) ? 1u : 0u; mine = (j == x) ? c : mine; }
        if (sum == G) break;
        __builtin_amdgcn_s_sleep(1);
        if ((++sp & 255u) == 0u) { if (xb_ld(&bar[XB_TMO])) break; if (sp > XB_SPIN_CAP) { atomicAdd(&bar[XB_TMO], 1u); break; } }
    }
    nloc = mine > 0u ? mine : 1u; nx = cnt > 0u ? cnt : 1u;
}
__device__ __forceinline__ void xcd_barrier(const XcdBarrier& b) {
    asm volatile("s_waitcnt vmcnt(0)" ::: "memory");
    __syncthreads();
    if (threadIdx.x == 0) {
        unsigned* bar = b.bar;
        __builtin_amdgcn_s_waitcnt(0);
        unsigned nloc = b.st[0], nx = b.st[1];
        if (nloc == 0u) { xcd_barrier_complete(bar, b.x, nloc, nx); b.st[0] = nloc; b.st[1] = nx; }
        const unsigned old = xb_add(&bar[XB_XSUB(b.x)], 1u);
        const unsigned gen = old / nloc;
        if (old + 1u == (gen + 1u) * nloc) {
            __builtin_amdgcn_fence(__ATOMIC_RELEASE, "agent");
            asm volatile("s_waitcnt vmcnt(0)" ::: "memory");
            const unsigned og = xb_add(&bar[XB_TOP], 1u);
            const unsigned tg = og / nx;
            if (og + 1u == (tg + 1u) * nx) xb_add(&bar[XB_TOPGEN], 1u);
            else XB_SPIN(xb_ld(&bar[XB_TOPGEN]) == tg, bar);
            __builtin_amdgcn_fence(__ATOMIC_ACQUIRE, "agent");
            xb_add(&bar[XB_XGEN(b.x)], 1u);
            asm volatile("s_waitcnt vmcnt(0)" ::: "memory");
        } else {
            XB_SPIN(xb_ld(&bar[XB_XGEN(b.x)]) == gen, bar);
            __builtin_amdgcn_fence(__ATOMIC_ACQUIRE, "agent");
            asm volatile("s_waitcnt vmcnt(0)" ::: "memory");
        }
    }
    __syncthreads();
}

struct Args { const float* in[39]; float* out; unsigned char* ws; int ph_lo, ph_hi, dupk, pad; };
enum { I_X = 0, I_C, I_CTX, I_CCTX, I_ADAW, I_ADAB, I_WIN, I_WA2F, I_BAF, I_WA2B, I_BAB, I_GNORM, I_QNORM, I_WUQ, I_KVNORM, I_WUKV, I_HCW, I_HCB, I_HW1, I_HB1, I_HW2, I_HB2, I_HW3, I_HFREQ,
       I_HBIAS, I_WBG, I_WBM, I_WBH, I_WOUT, I_LN1G, I_LN1B, I_LN2G, I_LN2B, I_RW, I_RB, I_MW1, I_MB1, I_MW2, I_MB2 };

__device__ __forceinline__ int opq(int i) { asm volatile("" : "+s"(i)); return i; }
#define INP(A, i) ((const float*)(const GAS float*)((A).in[opq(i)]))
struct Fr { LAS unsigned char* L; int tid, lane, wave, G, bid; };

__device__ __forceinline__ void tr_item(const float* W, int K, int N, bf16* WT, int mode, const float* kscale, float scale, LAS float* scr, int item, int lane) {
    const int nblk = N / 32, kb = item / nblk, nb = item - kb * nblk, k0 = 64 * kb, n0 = 32 * nb;
#pragma unroll
    for (int i = 0; i < 8; ++i) { const int kk = 8 * i + (lane >> 3), c4 = (lane & 7) * 4; f32x4 v = __builtin_nontemporal_load((const GAS f32x4*)((const GAS float*)W + (size_t)(k0 + kk) * N + n0 + c4)) * scale;        if (kscale) v = v * kscale[k0 + kk];
        scr[kk * 33 + c4] = v[0]; scr[kk * 33 + c4 + 1] = v[1]; scr[kk * 33 + c4 + 2] = v[2]; scr[kk * 33 + c4 + 3] = v[3]; }
    LDS_WAIT(); asm volatile("" ::: "memory");
    const int c = lane & 7;
#pragma unroll
    for (int j = 0; j < 4; ++j) { const int n = (lane >> 3) + 8 * j; const LAS float* s = scr + (8 * c) * 33 + n;
        v4u o; o.x = pk2(s[0 * 33], s[1 * 33]); o.y = pk2(s[2 * 33], s[3 * 33]); o.z = pk2(s[4 * 33], s[5 * 33]); o.w = pk2(s[6 * 33], s[7 * 33]);
        int nn = n0 + n; if (mode == 1) { nn = nn < 1024 ? ((nn >> 7) * 256 + (nn & 127)) : ((((nn - 1024) >> 7) * 256) + 128 + ((nn - 1024) & 127)); }
        __builtin_nontemporal_store(o, (GAS v4u*)((GAS bf16*)WT + (size_t)nn * K + k0 + 8 * c)); }
    LDS_WAIT(); asm volatile("" ::: "memory");
}

__device__ __forceinline__ float silu_(float x) { return x / (1.f + expf(-x)); }

__device__ __forceinline__ void hy_filter_item(LAS unsigned char* L_, int tid_, const float* w1, const float* b1, const float* w2, const float* b2, const float* fr, const float* w3, int Ln, int blk, bf16* FILT, float* HP) {
    LAS float* zE = (LAS float*)L_;
    LAS float* h1 = zE + 32 * 36;
    LAS float* h2 = h1 + 32 * 64;
    const int tid = tid_, p0 = blk * 32;
    { const int p = tid >> 4, j = tid & 15; const int i = p0 + p;
      const float w = 6.283185307179586f * (float)i / (float)Ln; const float f = 1e-4f + (float)j * ((15.f - 1e-4f) / 15.f); const float ang = f * w;
      zE[p * 36 + 1 + j] = __cosf(ang); zE[p * 36 + 17 + j] = -__sinf(ang); if (j == 0) zE[p * 36] = (float)i / (float)(Ln - 1); }
    __syncthreads();
    { const int n = tid & 63; const float frn = fr[n], bn = b1[n];
#pragma unroll 1
      for (int q = 0; q < 4; ++q) { const int p = (tid >> 6) + 8 * q; float s = bn;
#pragma unroll 3
          for (int k = 0; k < 33; ++k) s += zE[p * 36 + k] * w1[k * 64 + n];
          h1[p * 64 + n] = __sinf(frn * s); } }
    __syncthreads();
    { const int n = tid & 63; const float frn = fr[n], bn = b2[n];
#pragma unroll 1
      for (int q = 0; q < 4; ++q) { const int p = (tid >> 6) + 8 * q; float s = bn;
#pragma unroll 4
          for (int k = 0; k < 64; ++k) s += h1[p * 64 + k] * w2[k * 64 + n];
          h2[p * 64 + n] = __sinf(frn * s); } }
    __syncthreads();
    { const int lane = tid & 63, wave_ = tid >> 6, r = lane & 31, hh = lane >> 5; const float d0 = -3.0701134573253945f, d1 = -15.350567286626972f;
      for (int cbk = wave_; cbk < 16; cbk += 8) { const int c = cbk * 32 + r; const float delta = fabsf(d0 + (float)c * ((d1 - d0) / 511.f));
          for (int o_ = 0; o_ < 2; ++o_) { float asum = 0.f;
              for (int dr = 0; dr < 2; ++dr) { const int j = (o_ * 2 + dr) * 512 + c; f32x16 acc;
#pragma unroll
                  for (int i = 0; i < 16; ++i) acc[i] = 0.f;
                  float bw[32];
#pragma unroll
                  for (int st = 0; st < 32; ++st) bw[st] = w3[(size_t)(2 * st + hh) * 2048 + j];
#pragma unroll
                  for (int st = 0; st < 32; ++st) acc = __builtin_amdgcn_mfma_f32_32x32x2f32(h2[r * 64 + 2 * st + hh], bw[st], acc, 0, 0, 0);
                  GAS bf16* dst = (GAS bf16*)FILT + ((size_t)j * Ln + p0);
#pragma unroll
                  for (int g = 0; g < 4; ++g) { f32x4 o;
#pragma unroll
                      for (int i = 0; i < 4; ++i) { const int p = 8 * g + 4 * hh + i; const float v = acc[4 * g + i] * __builtin_amdgcn_exp2f(-zE[p * 36] * delta * 1.4426950408889634f); o[i] = v; asum += fabsf(v); }
                      v2u ow; ow.x = pk2(o[0], o[1]); ow.y = pk2(o[2], o[3]); *(GAS v2u*)(dst + 8 * g + 4 * hh) = ow; } }
              asum += __shfl_xor(asum, 32);
              if (hh == 0) HP[((size_t)blk * 2 + o_) * 512 + c] = asum; } } }
    __syncthreads();
}

__device__ __forceinline__ void ln_mod_load(const GAS float* xrow, f32x4 (&v)[4], int lane) {
#pragma unroll
    for (int j = 0; j < 4; ++j) v[j] = ((const GAS f32x4*)xrow)[lane + 64 * j]; }
__device__ __forceinline__ void ln_mod_fin(f32x4 (&v)[4], const GAS float* sh, const GAS float* sc, GAS bf16* orow, int lane) {
    f32x4 av[4], bv[4];
#pragma unroll
    for (int j = 0; j < 4; ++j) { av[j] = ((const GAS f32x4*)sc)[lane + 64 * j]; bv[j] = ((const GAS f32x4*)sh)[lane + 64 * j]; }
    float s = 0.f;
#pragma unroll
    for (int j = 0; j < 4; ++j) s += (v[j].x + v[j].y) + (v[j].z + v[j].w);
    const float mean = wave_sum(s) * (1.f / D); float s2 = 0.f;
#pragma unroll
    for (int j = 0; j < 4; ++j) { v[j] = v[j] - mean; s2 += (v[j].x * v[j].x + v[j].y * v[j].y) + (v[j].z * v[j].z + v[j].w * v[j].w); }
    const float rstd = 1.f / sqrtf(wave_sum(s2) * (1.f / D) + LN_EPS);
    GAS v2u* o8 = (GAS v2u*)orow + lane;
#pragma unroll
    for (int j = 0; j < 4; ++j) { const f32x4 a = av[j], b = bv[j]; const f32x4 y = v[j] * rstd * (a + 1.f) + b;
        v2u w; w.x = pk2(y.x, y.y); w.y = pk2(y.z, y.w); o8[64 * j] = w; }
}
__device__ __forceinline__ void ln_mod_row_b(const GAS bf16* xrow, const float* sh, const float* sc, bf16* orow, int lane) {
    f32x4 v[4];
#pragma unroll
    for (int j = 0; j < 4; ++j) { const v2u w = ((const GAS v2u*)xrow)[lane + 64 * j]; v[j].x = bflo(w.x); v[j].y = bfhi(w.x); v[j].z = bflo(w.y); v[j].w = bfhi(w.y); }
    ln_mod_fin(v, (const GAS float*)sh, (const GAS float*)sc, (GAS bf16*)orow, lane); }
__device__ __forceinline__ void ln_mod_row(const float* xrow, const float* sh, const float* sc, bf16* orow, int lane) {
    f32x4 v[4]; ln_mod_load((const GAS float*)xrow, v, lane); ln_mod_fin(v, (const GAS float*)sh, (const GAS float*)sc, (GAS bf16*)orow, lane); }

__device__ __forceinline__ f32x2 cmul(f32x2 a, f32x2 b) { const f32x2 axx = __builtin_shufflevector(a, a, 0, 0), ayy = __builtin_shufflevector(a, a, 1, 1); f32x2 bs = __builtin_shufflevector(b, b, 1, 0); bs.x = -bs.x;
    return __builtin_elementwise_fma(ayy, bs, axx * b); }
__device__ __forceinline__ f32x2 cmulc(f32x2 a, f32x2 b) {
    const f32x2 bxx = __builtin_shufflevector(b, b, 0, 0), byy = __builtin_shufflevector(b, b, 1, 1); f32x2 as = __builtin_shufflevector(a, a, 1, 0); as.y = -as.y;
    return __builtin_elementwise_fma(as, byy, a * bxx); }
__device__ __forceinline__ f32x4 cswn(f32x4 w) { f32x4 r = __builtin_shufflevector(w, w, 1, 0, 3, 2); r.x = -r.x; r.z = -r.z; return r; }
__device__ __forceinline__ f32x4 cmul4(f32x4 x, f32x4 w, f32x4 wsn) { return __builtin_elementwise_fma(__builtin_shufflevector(x, x, 1, 1, 3, 3), wsn, __builtin_shufflevector(x, x, 0, 0, 2, 2) * w); }
__device__ __forceinline__ f32x4 cmulc4(f32x4 x, f32x4 w, f32x4 wsn) { return __builtin_shufflevector(x, x, 0, 0, 2, 2) * w - __builtin_shufflevector(x, x, 1, 1, 3, 3) * wsn; }
__device__ __forceinline__ int fpad(int i) { return i + 2 * (i >> 4); }
constexpr int FFT_LDS_ELEMS = FFTN + FFTN / 8;
__device__ __forceinline__ void fft16_dif(f32x2 (&x)[16]) {
    constexpr float wr[8] = {1.000000000e+00f, 9.238795325e-01f, 7.071067812e-01f, 3.826834324e-01f, 6.123233996e-17f, -3.826834324e-01f, -7.071067812e-01f, -9.238795325e-01f}, wi[8] = {-0.000000000e+00f, -3.826834324e-01f, -7.071067812e-01f, -9.238795325e-01f, -1.000000000e+00f, -9.238795325e-01f, -7.071067812e-01f, -3.826834324e-01f};
#pragma unroll
    for (int m = 16; m >= 2; m >>= 1) {
#pragma unroll
        for (int base = 0; base < 16; base += m)
#pragma unroll
            for (int j = 0; j < m / 2; ++j) { const f32x2 a = x[base + j], b = x[base + j + m / 2]; const f32x2 d = a - b; x[base + j] = a + b;
                const float cr = wr[j * (16 / m)], ci = wi[j * (16 / m)]; f32x2 t; t.x = d.x * cr - d.y * ci; t.y = d.x * ci + d.y * cr; x[base + j + m / 2] = t; }
    }
}
__device__ __forceinline__ void fft16_dit_inv(f32x2 (&x)[16]) {
    constexpr float wr[8] = {1.000000000e+00f, 9.238795325e-01f, 7.071067812e-01f, 3.826834324e-01f, 6.123233996e-17f, -3.826834324e-01f, -7.071067812e-01f, -9.238795325e-01f}, wi[8] = {-0.000000000e+00f, -3.826834324e-01f, -7.071067812e-01f, -9.238795325e-01f, -1.000000000e+00f, -9.238795325e-01f, -7.071067812e-01f, -3.826834324e-01f};
#pragma unroll
    for (int m = 2; m <= 16; m <<= 1) {
#pragma unroll
        for (int base = 0; base < 16; base += m)
#pragma unroll
            for (int j = 0; j < m / 2; ++j) { const f32x2 a = x[base + j], b = x[base + j + m / 2]; const float cr = wr[j * (16 / m)], ci = -wi[j * (16 / m)];
                f32x2 t; t.x = b.x * cr - b.y * ci; t.y = b.x * ci + b.y * cr; x[base + j] = a + t; x[base + j + m / 2] = a - t; }
    }
}
struct FftTw { f32x4 wq[4]; f32x2 ta, tb; };
__device__ __forceinline__ void fft_tw_load(FftTw& T, const GAS f32x2* TW, int tid) {
#pragma unroll
    for (int i = 0; i < 4; ++i) T.wq[i] = *(const GAS f32x4*)(TW + 2 * (tid + 512 * i));
    T.ta = TW[(tid & 255) * 4]; T.tb = TW[(tid & 15) * 64]; }
template <bool INV, int M> __device__ __forceinline__ void fft_r16_pass(LAS f32x2* X, f32x2 t, int tid) {
    constexpr int Q = M / 16, PQ = Q + 2 * (Q / 16);
    asm volatile("" : "+v"(t));
    f32x2 pw[16];
    pw[1] = t; pw[2] = cmul(t, t); pw[3] = cmul(pw[2], t); pw[4] = cmul(pw[2], pw[2]); pw[5] = cmul(pw[4], t); pw[6] = cmul(pw[4], pw[2]); pw[7] = cmul(pw[4], pw[3]); pw[8] = cmul(pw[4], pw[4]);
#pragma unroll
    for (int k = 1; k < 8; ++k) pw[8 + k] = cmul(pw[8], pw[k]);
#pragma unroll
    for (int it = 0; it < 2; ++it) { const int g = tid + 512 * it;
        const int j = g & (Q - 1), i0 = (g / Q) * M + j; LAS f32x2* p = X + fpad(i0);
        f32x2 x[16];
#pragma unroll
        for (int k = 0; k < 16; ++k) x[k] = p[k * PQ];
        if (!INV) { fft16_dif(x);
#pragma unroll
            for (int k = 1; k < 16; ++k) { const int f = ((k & 1) << 3) | ((k & 2) << 1) | ((k & 4) >> 1) | ((k & 8) >> 3); x[k] = cmul(x[k], pw[f]); } }
        else {
#pragma unroll
            for (int k = 1; k < 16; ++k) { const int f = ((k & 1) << 3) | ((k & 2) << 1) | ((k & 4) >> 1) | ((k & 8) >> 3); x[k] = cmulc(x[k], pw[f]); }
            fft16_dit_inv(x); }
#pragma unroll
        for (int k = 0; k < 16; ++k) p[k * PQ] = x[k];
    }
    __syncthreads();
}
template <bool LAST> __device__ __forceinline__ void fft_fwd(LAS f32x2* X, const FftTw& T, int tid) {
    { constexpr int q = FFTN / 4;
#pragma unroll
        for (int it = 0; it < 4; ++it) { const int g = tid + 512 * it;
            const int i0 = 2 * g;
            LAS f32x4* P0 = (LAS f32x4*)(X + fpad(i0)); LAS f32x4* P1 = (LAS f32x4*)(X + fpad(i0 + q)); LAS f32x4* P2 = (LAS f32x4*)(X + fpad(i0 + 2 * q)); LAS f32x4* P3 = (LAS f32x4*)(X + fpad(i0 + 3 * q));
            const f32x4 x0 = *P0, x1 = *P1, x2 = *P2, x3 = *P3;
            f32x4 w1 = T.wq[it]; asm volatile("" : "+v"(w1)); const f32x4 w1s = cswn(w1), w2 = cmul4(w1, w1, w1s), w2s = cswn(w2);
            const f32x4 a0 = x0 + x2, d02 = x0 - x2, a1 = x1 + x3, t = x1 - x3;
            f32x4 tr = __builtin_shufflevector(t, t, 1, 0, 3, 2); tr.y = -tr.y; tr.w = -tr.w;
            const f32x4 a2 = cmul4(d02, w1, w1s), a3 = cmul4(tr, w1, w1s);
            const f32x4 o0 = a0 + a1, o1 = cmul4(a0 - a1, w2, w2s), o2 = a2 + a3, o3 = cmul4(a2 - a3, w2, w2s);
            *P0 = o0; *P1 = o1; *P2 = o2; *P3 = o3;
            if (it & 1) __builtin_amdgcn_sched_barrier(0);
        }
        __syncthreads();
    }
    fft_r16_pass<false, 4096>(X, T.ta, tid);
    fft_r16_pass<false, 256>(X, T.tb, tid);
    if (LAST) {
#pragma unroll 2
    for (int blk = tid; blk < FFTN / 16; blk += 512) { LAS f32x4* p = (LAS f32x4*)(X + blk * 18); f32x2 x[16];
#pragma unroll
        for (int i = 0; i < 8; ++i) { const f32x4 v = p[i]; x[2 * i].x = v[0]; x[2 * i].y = v[1]; x[2 * i + 1].x = v[2]; x[2 * i + 1].y = v[3]; }
        fft16_dif(x);
#pragma unroll
        for (int i = 0; i < 8; ++i) { f32x4 v; v[0] = x[2 * i].x; v[1] = x[2 * i].y; v[2] = x[2 * i + 1].x; v[3] = x[2 * i + 1].y; p[i] = v; } }
    __syncthreads(); }
}
__device__ __forceinline__ void fft_mid(LAS f32x2* X, const GAS unsigned* KH, const GAS unsigned* KX, int tid) {
#pragma unroll
    for (int it = 0; it < 2; ++it) { const int blk = tid + 512 * it; LAS f32x4* p = (LAS f32x4*)(X + blk * 18); f32x2 x[16]; v4u ke[2], ko[2];
        const int fbp = (1024 - (int)(__builtin_bitreverse32((unsigned)blk) >> 22)) & 1023, blkp = (int)(__builtin_bitreverse32((unsigned)fbp) >> 22);
        const GAS v4u* kp = (const GAS v4u*)(KH + blk * 8); const GAS v4u* pp = blk ? (const GAS v4u*)(KH + blkp * 8) : (const GAS v4u*)KX; const float sg = blk ? -1.f : 1.f;
        ke[0] = kp[0]; ke[1] = kp[1]; ko[0] = pp[0]; ko[1] = pp[1];
#pragma unroll
        for (int i = 0; i < 8; ++i) { const f32x4 v = p[i]; x[2 * i].x = v[0]; x[2 * i].y = v[1]; x[2 * i + 1].x = v[2]; x[2 * i + 1].y = v[3]; }
        fft16_dif(x);
#pragma unroll
        for (int i = 0; i < 8; ++i) { const unsigned w0 = ke[i >> 2][i & 3], w1 = ko[(7 - i) >> 2][(7 - i) & 3]; f32x2 k0, k1; k0.x = bflo(w0); k0.y = bfhi(w0); k1.x = bflo(w1); k1.y = bfhi(w1) * sg;
            x[2 * i] = cmul(x[2 * i], k0); x[2 * i + 1] = cmul(x[2 * i + 1], k1); }
        fft16_dit_inv(x);
#pragma unroll
        for (int i = 0; i < 8; ++i) { f32x4 v; v[0] = x[2 * i].x; v[1] = x[2 * i].y; v[2] = x[2 * i + 1].x; v[3] = x[2 * i + 1].y; p[i] = v; } }
    __syncthreads();
}
template <bool FIRST> __device__ __forceinline__ void fft_inv(LAS f32x2* X, const FftTw& T, int tid) {
    if (FIRST) {
#pragma unroll 2
    for (int blk = tid; blk < FFTN / 16; blk += 512) { LAS f32x4* p = (LAS f32x4*)(X + blk * 18); f32x2 x[16];
#pragma unroll
        for (int i = 0; i < 8; ++i) { const f32x4 v = p[i]; x[2 * i].x = v[0]; x[2 * i].y = v[1]; x[2 * i + 1].x = v[2]; x[2 * i + 1].y = v[3]; }
        fft16_dit_inv(x);
#pragma unroll
        for (int i = 0; i < 8; ++i) { f32x4 v; v[0] = x[2 * i].x; v[1] = x[2 * i].y; v[2] = x[2 * i + 1].x; v[3] = x[2 * i + 1].y; p[i] = v; } }
    __syncthreads(); }
    fft_r16_pass<true, 256>(X, T.tb, tid);
    fft_r16_pass<true, 4096>(X, T.ta, tid);
    { constexpr int m = FFTN / 2, hm = m >> 1;
#pragma unroll
        for (int it = 0; it < 4; ++it) { const int g = tid + 512 * it;
            const int i0 = 2 * g;
            LAS f32x4* P0 = (LAS f32x4*)(X + fpad(i0)); LAS f32x4* P1 = (LAS f32x4*)(X + fpad(i0 + hm)); LAS f32x4* P2 = (LAS f32x4*)(X + fpad(i0 + m)); LAS f32x4* P3 = (LAS f32x4*)(X + fpad(i0 + m + hm));
            const f32x4 x0 = *P0, x1 = *P1, x2 = *P2, x3 = *P3;
            f32x4 w2 = T.wq[it]; asm volatile("" : "+v"(w2)); w2.y = -w2.y; w2.w = -w2.w;
            const f32x4 w2s = cswn(w2), w = cmul4(w2, w2, w2s), ws = cswn(w);
            const f32x4 t1 = cmul4(x1, w, ws), t3 = cmul4(x3, w, ws);
            const f32x4 a0 = x0 + t1, a1 = x0 - t1, a2 = x2 + t3, a3 = x2 - t3;
            const f32x4 u2 = cmul4(a2, w2, w2s), u3 = cmul4(a3, w2, w2s);
            f32x4 iu3 = __builtin_shufflevector(u3, u3, 1, 0, 3, 2); iu3.x = -iu3.x; iu3.z = -iu3.z;
            const f32x4 o0 = a0 + u2, o1 = a1 + iu3, o2 = a0 - u2, o3 = a1 - iu3;
            *P0 = o0; *P1 = o1; *P2 = o2; *P3 = o3;
            if (it & 1) __builtin_amdgcn_sched_barrier(0);
        }
        __syncthreads();
    }
}
__device__ __forceinline__ void fft_fwd4z(const f32x4 x0, const f32x4 x1, f32x4 w1, f32x4& o0, f32x4& o1, f32x4& o2, f32x4& o3) {
    asm volatile("" : "+v"(w1)); const f32x4 w1s = cswn(w1), w2 = cmul4(w1, w1, w1s), w2s = cswn(w2);
    f32x4 tr = __builtin_shufflevector(x1, x1, 1, 0, 3, 2); tr.y = -tr.y; tr.w = -tr.w;
    const f32x4 a2 = cmul4(x0, w1, w1s), a3 = cmul4(tr, w1, w1s);
    o0 = x0 + x1; o1 = cmul4(x0 - x1, w2, w2s); o2 = a2 + a3; o3 = cmul4(a2 - a3, w2, w2s); }
__device__ __forceinline__ void fft_inv4h(const f32x4 x0, const f32x4 x1, const f32x4 x2, const f32x4 x3, f32x4 w2, f32x4& o0, f32x4& o1) {
    asm volatile("" : "+v"(w2)); w2.y = -w2.y; w2.w = -w2.w;
    const f32x4 w2s = cswn(w2), w = cmul4(w2, w2, w2s), ws = cswn(w);
    const f32x4 t1 = cmul4(x1, w, ws), t3 = cmul4(x3, w, ws);
    const f32x4 a0 = x0 + t1, a1 = x0 - t1, a2 = x2 + t3, a3 = x2 - t3;
    const f32x4 u2 = cmul4(a2, w2, w2s), u3 = cmul4(a3, w2, w2s);
    f32x4 iu3 = __builtin_shufflevector(u3, u3, 1, 0, 3, 2); iu3.x = -iu3.x; iu3.z = -iu3.z;
    o0 = a0 + u2; o1 = a1 + iu3; }
__device__ __forceinline__ void fft_conv_core(LAS f32x2* X, const GAS unsigned* KH, const GAS unsigned* KX, const FftTw& T, int tid) {
    fft_r16_pass<false, 4096>(X, T.ta, tid); fft_r16_pass<false, 256>(X, T.tb, tid);
    fft_mid(X, KH, KX, tid);
    fft_r16_pass<true, 256>(X, T.tb, tid); fft_r16_pass<true, 4096>(X, T.ta, tid); }
__device__ __forceinline__ void fft_table(LAS f32x2* TL, const GAS f32x2* TW, int tid) { if (tid < 320) TL[tid] = tid < 64 ? TW[tid] : TW[(tid - 64) * 64]; }
__device__ __forceinline__ int brev14(int p) { return (int)(__builtin_bitreverse32((unsigned)p) >> 18); }

__device__ __forceinline__ void kspec_item(const Fr& F, const unsigned char* ws, int c) {
    LAS f32x2* X = (LAS f32x2*)F.L; LAS float* red = (LAS float*)(F.L + LDS_TAB);
    const GAS float* HP = (const GAS float*)(ws + WS_HPART); const GAS bf16* FILT = (const GAS bf16*)(ws + WS_FILT); const GAS f32x2* TW = (const GAS f32x2*)(ws + WS_TW);
    const int tid = F.tid; FftTw T; fft_tw_load(T, TW, tid);
    if (tid < 256) { const float v0 = wave_sum(HP[((size_t)tid * 2 + 0) * 512 + c]), v1 = wave_sum(HP[((size_t)tid * 2 + 1) * 512 + c]); if (F.lane == 0) { red[F.wave * 2] = v0; red[F.wave * 2 + 1] = v1; } }
    __syncthreads();
    const float inv0 = 1.f / (((red[0] + red[2]) + red[4]) + red[6]), inv1 = 1.f / (((red[1] + red[3]) + red[5]) + red[7]);
    const GAS bf16* f0 = FILT + ((size_t)0 * 512 + c) * 8192; const GAS bf16* b0 = FILT + ((size_t)1 * 512 + c) * 8192; const GAS bf16* f1 = FILT + ((size_t)2 * 512 + c) * 8192; const GAS bf16* b1 = FILT + ((size_t)3 * 512 + c) * 8192;
#pragma unroll
    for (int s = tid; s < 8192; s += 512) { f32x2 v; v.x = bf2f(f0[s]) * inv0; v.y = bf2f(f1[s]) * inv1; X[fpad(s)] = v;
        f32x2 w; if (s == 0) { w.x = 0.f; w.y = 0.f; } else { w.x = bf2f(b0[8192 - s]) * inv0; w.y = bf2f(b1[8192 - s]) * inv1; } X[fpad(8192 + s)] = w; }
    __syncthreads();
    fft_fwd<true>(X, T, tid);
    GAS unsigned* K0 = (GAS unsigned*)(ws + WS_K0S) + (size_t)c * (FFTN / 2); GAS unsigned* K1 = (GAS unsigned*)(ws + WS_K1S) + (size_t)c * (FFTN / 2);
    GAS unsigned* K0X = (GAS unsigned*)(ws + WS_K0S) + (size_t)512 * (FFTN / 2) + c * 8; GAS unsigned* K1X = (GAS unsigned*)(ws + WS_K1S) + (size_t)512 * (FFTN / 2) + c * 8;
    const float sc = 0.5f / (float)FFTN;
    for (int p = tid; p < FFTN; p += 512) { if ((p & 1) && p >= 16) continue; const int f = brev14(p), p2 = brev14((FFTN - f) & (FFTN - 1)); const f32x2 A = X[fpad(p)], B = X[fpad(p2)];
        f32x2 k0, k1; k0.x = (A.x + B.x) * sc; k0.y = (A.y - B.y) * sc; k1.x = (A.y + B.y) * sc; k1.y = (B.x - A.x) * sc;
        if (!(p & 1)) { K0[p >> 1] = pk2(k0.x, k0.y); K1[p >> 1] = pk2(k1.x, k1.y); } else { K0X[7 - (p >> 1)] = pk2(k0.x, k0.y); K1X[7 - (p >> 1)] = pk2(k1.x, k1.y); } }
    __syncthreads();
}

__device__ __forceinline__ void hyconv_item(const Fr& F, const Args& a, const unsigned char* ws, int l, int c) {
    LAS f32x2* X = (LAS f32x2*)F.L; const GAS f32x2* TW = (const GAS f32x2*)(ws + WS_TW); int tid = F.tid; asm volatile("" : "+v"(tid));
    const GAS bf16* vT = (const GAS bf16*)(ws + WS_HYT) + (size_t)c * NLAT; const GAS bf16* x1T = vT + (size_t)512 * NLAT; const GAS bf16* x2T = vT + (size_t)1024 * NLAT;
    const GAS unsigned* K0 = (const GAS unsigned*)(ws + WS_K0S) + (size_t)c * (FFTN / 2); const GAS unsigned* K1 = (const GAS unsigned*)(ws + WS_K1S) + (size_t)c * (FFTN / 2);
    const GAS unsigned* K0X = (const GAS unsigned*)(ws + WS_K0S) + (size_t)512 * (FFTN / 2) + c * 8; const GAS unsigned* K1X = (const GAS unsigned*)(ws + WS_K1S) + (size_t)512 * (FFTN / 2) + c * 8;
    const float bias0 = INP(a, I_HBIAS)[(size_t)l * 1024 + c], bias1 = INP(a, I_HBIAS)[(size_t)l * 1024 + 512 + c];
    FftTw T; fft_tw_load(T, TW, tid);
    unsigned vr[4][4]; f32x4 zr[4][2];
    constexpr int q = FFTN / 4;
#define HY_PTRS(g_) LAS f32x4* P0 = (LAS f32x4*)(X + fpad(2 * (g_))); LAS f32x4* P1 = (LAS f32x4*)(X + fpad(2 * (g_) + q)); LAS f32x4* P2 = (LAS f32x4*)(X + fpad(2 * (g_) + 2 * q)); LAS f32x4* P3 = (LAS f32x4*)(X + fpad(2 * (g_) + 3 * q))
#define HY_LD4(dst_, base_, g_) do { dst_[0] = *(const GAS unsigned*)((base_) + 2 * (g_)); dst_[1] = *(const GAS unsigned*)((base_) + 8192 + 2 * (g_)); dst_[2] = *(const GAS unsigned*)((base_) + q + 2 * (g_)); dst_[3] = *(const GAS unsigned*)((base_) + 8192 + q + 2 * (g_)); } while (0)
#pragma unroll
    for (int it = 0; it < 4; ++it) { const int g = tid + 512 * it; HY_LD4(vr[it], vT, g); }
#pragma unroll
    for (int it = 0; it < 4; ++it) { const int g = tid + 512 * it; HY_PTRS(g);
        f32x4 x0, x1, o0, o1, o2, o3; x0[0] = bflo(vr[it][0]); x0[1] = bflo(vr[it][1]); x0[2] = bfhi(vr[it][0]); x0[3] = bfhi(vr[it][1]); x1[0] = bflo(vr[it][2]); x1[1] = bflo(vr[it][3]); x1[2] = bfhi(vr[it][2]); x1[3] = bfhi(vr[it][3]);
        fft_fwd4z(x0, x1, T.wq[it], o0, o1, o2, o3); *P0 = o0; *P1 = o1; *P2 = o2; *P3 = o3; }
    __syncthreads();
    fft_conv_core(X, K0, K0X, T, tid);
#pragma unroll
    for (int it = 0; it < 4; ++it) { const int g = tid + 512 * it; HY_PTRS(g); unsigned xr[4]; HY_LD4(xr, x1T, g);
        const f32x4 i0 = *P0, i1 = *P1, i2 = *P2, i3 = *P3; f32x4 y0, y1, o0, o1, o2, o3; fft_inv4h(i0, i1, i2, i3, T.wq[it], y0, y1);
        f32x4 z0, z1;
        z0[0] = bflo(xr[0]) * (y0[0] + bias0 * bflo(vr[it][0])); z0[1] = bflo(xr[1]) * (y0[1] + bias0 * bflo(vr[it][1])); z0[2] = bfhi(xr[0]) * (y0[2] + bias0 * bfhi(vr[it][0])); z0[3] = bfhi(xr[1]) * (y0[3] + bias0 * bfhi(vr[it][1]));
        z1[0] = bflo(xr[2]) * (y1[0] + bias0 * bflo(vr[it][2])); z1[1] = bflo(xr[3]) * (y1[1] + bias0 * bflo(vr[it][3])); z1[2] = bfhi(xr[2]) * (y1[2] + bias0 * bfhi(vr[it][2])); z1[3] = bfhi(xr[3]) * (y1[3] + bias0 * bfhi(vr[it][3]));
        zr[it][0] = z0; zr[it][1] = z1;
        fft_fwd4z(z0, z1, T.wq[it], o0, o1, o2, o3); *P0 = o0; *P1 = o1; *P2 = o2; *P3 = o3; }
    __syncthreads();
    fft_conv_core(X, K1, K1X, T, tid);
    GAS bf16* o = (GAS bf16*)(ws + WS_OHYT) + (size_t)c * NLAT; unsigned xr2[4][4];
#pragma unroll
    for (int it = 0; it < 4; ++it) { const int g = tid + 512 * it; HY_LD4(xr2[it], x2T, g); }
#pragma unroll
    for (int it = 0; it < 4; ++it) { const int g = tid + 512 * it; HY_PTRS(g); const unsigned (&xr)[4] = xr2[it];
        const f32x4 i0 = *P0, i1 = *P1, i2 = *P2, i3 = *P3; f32x4 y0, y1; fft_inv4h(i0, i1, i2, i3, T.wq[it], y0, y1);
        const f32x4 z0 = zr[it][0], z1 = zr[it][1];
        *(GAS unsigned*)(o + 2 * g) = pk2(bflo(xr[0]) * (y0[0] + bias1 * z0[0]), bfhi(xr[0]) * (y0[2] + bias1 * z0[2]));
        *(GAS unsigned*)(o + 8192 + 2 * g) = pk2(bflo(xr[1]) * (y0[1] + bias1 * z0[1]), bfhi(xr[1]) * (y0[3] + bias1 * z0[3]));
        *(GAS unsigned*)(o + q + 2 * g) = pk2(bflo(xr[2]) * (y1[0] + bias1 * z1[0]), bfhi(xr[2]) * (y1[2] + bias1 * z1[2]));
        *(GAS unsigned*)(o + 8192 + q + 2 * g) = pk2(bflo(xr[3]) * (y1[1] + bias1 * z1[1]), bfhi(xr[3]) * (y1[3] + bias1 * z1[3])); }
#undef HY_PTRS
#undef HY_LD4
    __syncthreads();
}

__device__ __forceinline__ void hyctx_item(const Fr& F, const Args& a, const unsigned char* ws, int l, int c) {
    LAS float* fl = (LAS float*)F.L;
    LAS float* vv = fl + 1024;
    LAS float* zz = vv + 512;
    LAS float* red = zz + 512;
    const float* HP = (const float*)(ws + WS_HPARTC); const GAS bf16* FC = (const GAS bf16*)(ws + WS_FILTC); const int tid = F.tid;
    if (tid < 16) red[tid] = HP[((size_t)(tid >> 1) * 2 + (tid & 1)) * 512 + c];
    __syncthreads();
    float s0 = 0.f, s1 = 0.f;
#pragma unroll
    for (int k = 0; k < 8; ++k) { s0 += red[2 * k]; s1 += red[2 * k + 1]; }
    const float inv0 = 1.f / s0, inv1 = 1.f / s1;
    const bf16* T = (const bf16*)(ws + WS_HYTC);
    for (int i = tid; i < 1024; i += 512) { const int q = i >> 8, s = i & 255; fl[i] = bf2f(FC[((size_t)q * 512 + c) * 256 + s]) * (q < 2 ? inv0 : inv1); }
    const int b = tid >> 8, t = tid & 255;
    const float v = bf2f(T[((size_t)c * 2 + b) * 256 + t]), x1 = bf2f(T[((size_t)(512 + c) * 2 + b) * 256 + t]), x2 = bf2f(T[((size_t)(1024 + c) * 2 + b) * 256 + t]);
    vv[tid] = v;
    __syncthreads();
    const float bias0 = INP(a, I_HBIAS)[(size_t)l * 1024 + c], bias1 = INP(a, I_HBIAS)[(size_t)l * 1024 + 512 + c];
    float y = 0.f;
    for (int s = 0; s <= t; ++s) y += fl[t - s] * vv[b * 256 + s];
    for (int s = t + 1; s < 256; ++s) y += fl[256 + s - t] * vv[b * 256 + s];
    const float z = x1 * (y + bias0 * v);
    zz[tid] = z;
    __syncthreads();
    float y2 = 0.f;
    for (int s = 0; s <= t; ++s) y2 += fl[512 + t - s] * zz[b * 256 + s];
    for (int s = t + 1; s < 256; ++s) y2 += fl[768 + s - t] * zz[b * 256 + s];
    bf16* OBR2 = (bf16*)(ws + WS_OBR) + (size_t)2 * MALL * 512;
    OBR2[(size_t)(NLAT + b * 256 + t) * 512 + c] = (bf16)f2bf(x2 * (y2 + bias1 * z));
    __syncthreads();
}

__device__ __forceinline__ void conv3_item(const Fr& F, const Args& a, const GAS bf16* Prows  , int Ls, GAS bf16* HT  , int l, int t0, int c0) {
    LAS float* T = (LAS float*)F.L;
    const int tid = F.tid;
    for (int idx = tid; idx < 130 * 32; idx += 512) { const int r = idx >> 5, c8 = (idx & 31) * 8; const int t = t0 - 1 + r;
        v4u v = (v4u){0u, 0u, 0u, 0u}; if (t >= 0 && t < Ls) v = *(const GAS v4u*)(Prows + (size_t)t * INPAD + O_HY + c0 + c8);
        LAS float* d = T + r * 257 + c8; d[0] = bflo(v.x); d[1] = bfhi(v.x); d[2] = bflo(v.y); d[3] = bfhi(v.y); d[4] = bflo(v.z); d[5] = bfhi(v.z); d[6] = bflo(v.w); d[7] = bfhi(v.w); }
    __syncthreads();
    const int tq = tid & 7;
#pragma unroll 1
    for (int k = 0; k < 4; ++k) { const int cc = (tid >> 3) + 64 * k, c3 = c0 + cc;
        const GAS float* cw = (const GAS float*)INP(a, I_HCW) + (size_t)l * 3 * 1536; const float w0 = cw[c3], w1 = cw[1536 + c3], w2 = cw[3072 + c3], bb = ((const GAS float*)INP(a, I_HCB))[(size_t)l * 1536 + c3];
#pragma unroll
        for (int hh = 0; hh < 2; ++hh) { float y[8];
#pragma unroll
            for (int j = 0; j < 8; ++j) { const int t = hh * 64 + tq * 8 + j; y[j] = T[t * 257 + cc] * w0 + T[(t + 1) * 257 + cc] * w1 + T[(t + 2) * 257 + cc] * w2 + bb; }
            v4u o; o.x = pk2(y[0], y[1]); o.y = pk2(y[2], y[3]); o.z = pk2(y[4], y[5]); o.w = pk2(y[6], y[7]);
            *(GAS v4u*)(HT + (size_t)c3 * (2 * Ls) + t0 + hh * 64 + tq * 8) = o; } }
    __syncthreads();
}

__device__ __forceinline__ void post_row(const Fr& F, const Args& a, unsigned char* ws, int l, int row, const LAS float* wa  ) {
    const int lane = F.lane; const bf16* pr = (const bf16*)(ws + WS_P) + (size_t)row * INPAD;
    const GAS bf16* prg = (const GAS bf16*)pr;
    const int hd = lane >> 3, p = lane & 7, p4 = (p & 3) * 4;
    const v2u wa4 = *(const GAS v2u*)(prg + O_MQA + 4 * lane); const unsigned wb2 = *(const GAS unsigned*)(prg + O_MQA + 256 + 2 * lane);
    const v2u w4 = *(const GAS v2u*)(prg + O_MKVA + 4 * lane);
    const float pa = bf2f(prg[O_GAF + (lane & 31)]);
    const v2u a1 = *(const GAS v2u*)(prg + O_MKR + p4), a2 = *(const GAS v2u*)(prg + O_MKR + 16 + p4);
    f32x4 c01, c23; c01 = (f32x4){1.f, 0.f, 1.f, 0.f}; c23 = c01;
    if (row < NLAT) { const GAS float* cs = (const GAS float*)(ws + WS_ROPE) + ((size_t)(row & 8191) * 16 + p4) * 2; c01 = *(const GAS f32x4*)cs; c23 = *(const GAS f32x4*)(cs + 4); }
    { float v[6];
      v[0] = bflo(wa4.x); v[1] = bfhi(wa4.x); v[2] = bflo(wa4.y); v[3] = bfhi(wa4.y); v[4] = bflo(wb2); v[5] = bfhi(wb2);
      const float ss = ((v[0] * v[0] + v[1] * v[1]) + (v[2] * v[2] + v[3] * v[3])) + (v[4] * v[4] + v[5] * v[5]);
      const float r = 1.f / sqrtf(wave_sum(ss) * (1.f / 384.f) + RMS_EPS); GAS bf16* o = (GAS bf16*)(ws + WS_NQ) + (size_t)row * 384;
      v2u w; w.x = pk2(v[0] * r, v[1] * r); w.y = pk2(v[2] * r, v[3] * r); *(GAS v2u*)(o + 4 * lane) = w; *(GAS unsigned*)(o + 256 + 2 * lane) = pk2(v[4] * r, v[5] * r); }
    { float v[4]; v[0] = bflo(w4.x); v[1] = bfhi(w4.x); v[2] = bflo(w4.y); v[3] = bfhi(w4.y);
      const float ss = (v[0] * v[0] + v[1] * v[1]) + (v[2] * v[2] + v[3] * v[3]);
      const float r = 1.f / sqrtf(wave_sum(ss) * (1.f / 256.f) + RMS_EPS); GAS bf16* o = (GAS bf16*)(ws + WS_NKV) + (size_t)row * 256;
      v2u w; w.x = pk2(v[0] * r, v[1] * r); w.y = pk2(v[2] * r, v[3] * r); *(GAS v2u*)(o + 4 * lane) = w; }
    { const float* baf = INP(a, I_BAF) + l * 256; const float* bab = INP(a, I_BAB) + l * 256;
      f32x4 xf = *(const GAS f32x4*)((const GAS float*)baf + 4 * lane), xb = *(const GAS f32x4*)((const GAS float*)bab + 4 * lane);
#pragma unroll
      for (int r = 0; r < 16; ++r) { const float pf = rd_lane(pa, r), pb = rd_lane(pa, 16 + r);
          xf += pf * *(const LAS f32x4*)(wa + r * 256 + 4 * lane); xb += pb * *(const LAS f32x4*)(wa + 4096 + r * 256 + 4 * lane); }
      f32x4 lf, lb;
#pragma unroll
      for (int j = 0; j < 4; ++j) {
          lf[j] = (fminf(xf[j], 0.f) - __logf(1.f + __expf(-fabsf(xf[j])))) * (1.f / 16.f); lb[j] = (fminf(xb[j], 0.f) - __logf(1.f + __expf(-fabsf(xb[j])))) * (1.f / 16.f); }
      *(GAS f32x4*)((GAS float*)(ws + WS_AF) + (size_t)row * 256 + 4 * lane) = lf; *(GAS f32x4*)((GAS float*)(ws + WS_AB) + (size_t)row * 256 + 4 * lane) = lb; }
    { const float x1[4] = {bflo(a1.x), bfhi(a1.x), bflo(a1.y), bfhi(a1.y)}, x2[4] = {bflo(a2.x), bfhi(a2.x), bflo(a2.y), bfhi(a2.y)}; float o[4]; int b, key;
      if (row < NLAT) { const int t = row & 8191; b = row >> 13; key = CTXL + t;
          const float cc[4] = {c01[0], c01[2], c23[0], c23[2]}, sn[4] = {c01[1], c01[3], c23[1], c23[3]};
#pragma unroll
          for (int i = 0; i < 4; ++i) o[i] = p < 4 ? x1[i] * cc[i] - x2[i] * sn[i] : x2[i] * cc[i] + x1[i] * sn[i]; }
      else { const int r2 = row - NLAT; b = r2 >> 8; key = r2 & 255;
#pragma unroll
          for (int i = 0; i < 4; ++i) o[i] = p < 4 ? x1[i] : x2[i]; }
      v2u w; w.x = pk2(o[0], o[1]); w.y = pk2(o[2], o[3]); *(GAS v2u*)((GAS bf16*)(ws + WS_KB) + ((size_t)(b * 8 + hd) * KEYS + key) * 96 + 64 + 4 * p) = w; }
}

__device__ __forceinline__ float max3f(float a, float b, float c) { float r; asm("v_max3_f32 %0, %1, %2, %3" : "=v"(r) : "v"(a), "v"(b), "v"(c)); return r; }
__device__ __forceinline__ int kap(int r) { return (r & 0x13) | ((r & 4) << 1) | ((r & 8) >> 1); }
__device__ __forceinline__ unsigned pkbf2(float lo, float hi) { unsigned r; asm volatile("v_cvt_pk_bf16_f32 %0, %1, %2" : "=v"(r) : "v"(lo), "v"(hi)); return r; }
__device__ __forceinline__ void attn_unit(const int VAR, const Fr& F, const GAS bf16* QB, const GAS bf16* KBh, const GAS bf16* VTh, GAS bf16* O, int qrow0, int head, int ntiles, const GAS float* rope) {
    constexpr int KROW = 208, VROW = 144, KBYTES = 64 * KROW, BUF = KBYTES + 64 * VROW;
    const int tid = F.tid, lane = F.lane, wave = F.wave, r = lane & 31, hh = lane >> 5;
    LAS unsigned char* L = F.L;
    bf16x8 qf[6];
    { const GAS bf16* qp = QB + (size_t)(qrow0 + wave * 32 + r) * 768 + head * 96 + 8 * hh;
#pragma unroll
      for (int ks = 0; ks < 6; ++ks) qf[ks] = *(const GAS bf16x8*)(qp + 16 * ks);
      if (qrow0 < NLAT) {
          const GAS float* cs = rope + ((size_t)((qrow0 + wave * 32 + r) & 8191) * 16 + 8 * hh) * 2;
          v4u a = __builtin_bit_cast(v4u, qf[4]), b = __builtin_bit_cast(v4u, qf[5]);
#pragma unroll
          for (int i = 0; i < 4; ++i) { const f32x4 c4 = *(const GAS f32x4*)(cs + 4 * i);
              const float x1l = bflo(a[i]), x1h = bfhi(a[i]), x2l = bflo(b[i]), x2h = bfhi(b[i]);
              a[i] = pk2(x1l * c4[0] - x2l * c4[1], x1h * c4[2] - x2h * c4[3]); b[i] = pk2(x2l * c4[0] + x1l * c4[1], x2h * c4[2] + x1h * c4[3]); }
          qf[4] = __builtin_bit_cast(bf16x8, a); qf[5] = __builtin_bit_cast(bf16x8, b); } }
    const int kq0 = tid, kq1 = 512 + tid;
    const int kl0 = (kq0 / 12) * KROW + (kq0 % 12) * 16, kl1 = (kq1 / 12) * KROW + (kq1 % 12) * 16;
    const int vrow = tid >> 3, vch = tid & 7; const int vl = KBYTES + vrow * VROW + vch * 16;
    const GAS bf16* vsrc = VTh + (size_t)vrow * KEYS + vch * 8;
    v4u k0r, k1r, vr; k1r = (v4u){0u, 0u, 0u, 0u};
#define AT_LOAD(K0_, K1_, V_, t_) do { if (VAR == 4) break; const GAS unsigned char* kt_ = (const GAS unsigned char*)KBh + (size_t)(t_) * (64 * 192); K0_ = *(const GAS v4u*)(kt_ + (size_t)kq0 * 16); if (tid < 256) K1_ = *(const GAS v4u*)(kt_ + (size_t)kq1 * 16); \
        V_ = *(const GAS v4u*)(vsrc + (size_t)(t_) * 64); } while (0)
#define AT_WRITE(K0_, K1_, V_, bo_) do { if (VAR == 4) break; LAS unsigned char* Bn_ = L + (bo_); *(LAS v4u*)(Bn_ + kl0) = K0_; if (tid < 256) *(LAS v4u*)(Bn_ + kl1) = K1_; *(LAS v4u*)(Bn_ + vl) = V_; } while (0)
#define AT_SOFT(S_, PB_, RS_, MX_) do { f32x2 pp_[8]; \
        _Pragma("unroll") for (int i_ = 0; i_ < 8; ++i_) { pp_[i_].x = __builtin_amdgcn_exp2f(S_[2 * i_]); pp_[i_].y = __builtin_amdgcn_exp2f(S_[2 * i_ + 1]); } \
        _Pragma("unroll") for (int s2_ = 0; s2_ < 2; ++s2_) { v4u w_; w_.x = pkbf2(pp_[4 * s2_].x, pp_[4 * s2_].y); w_.y = pkbf2(pp_[4 * s2_ + 1].x, pp_[4 * s2_ + 1].y); w_.z = pkbf2(pp_[4 * s2_ + 2].x, pp_[4 * s2_ + 2].y); w_.w = pkbf2(pp_[4 * s2_ + 3].x, pp_[4 * s2_ + 3].y); \
            PB_[s2_] = __builtin_bit_cast(bf16x8, w_); } \
        MX_ = 0.f; \
        pp_[0] += pp_[4]; pp_[1] += pp_[5]; pp_[2] += pp_[6]; pp_[3] += pp_[7]; pp_[0] += pp_[2]; pp_[1] += pp_[3]; RS_ = pp_[0] + pp_[1]; } while (0)
#define AT_TILE(bo_) do { const LAS unsigned char* B_ = L + (bo_); bf16x8 ka_[12], va_[8], pb0_[2], pb1_[2]; f32x2 rs0_, rs1_; float mx0_, mx1_; \
        _Pragma("unroll") for (int ks_ = 0; ks_ < 6; ++ks_) { ka_[2 * ks_] = *(const LAS bf16x8*)(B_ + koff + ks_ * 32); ka_[2 * ks_ + 1] = *(const LAS bf16x8*)(B_ + koff + 32 * KROW + ks_ * 32); } \
        _Pragma("unroll") for (int kb_ = 0; kb_ < 2; ++kb_) _Pragma("unroll") for (int s2_ = 0; s2_ < 2; ++s2_) { \
            va_[(kb_ * 2 + s2_) * 2] = *(const LAS bf16x8*)(B_ + voff + (32 * kb_ + 16 * s2_) * 2); va_[(kb_ * 2 + s2_) * 2 + 1] = *(const LAS bf16x8*)(B_ + voff + 32 * VROW + (32 * kb_ + 16 * s2_) * 2); } \
        asm volatile("s_waitcnt lgkmcnt(8)" ::: "memory"); __builtin_amdgcn_sched_barrier(0); \
        _Pragma("unroll") for (int ks_ = 0; ks_ < 6; ++ks_) sA0 = __builtin_amdgcn_mfma_f32_32x32x16_bf16(ka_[2 * ks_], qf[ks_], sA0, 0, 0, 0); \
        __builtin_amdgcn_sched_barrier(0); \
        _Pragma("unroll") for (int ks_ = 0; ks_ < 6; ++ks_) sA1 = __builtin_amdgcn_mfma_f32_32x32x16_bf16(ka_[2 * ks_ + 1], qf[ks_], sA1, 0, 0, 0); \
        AT_SOFT(sA0, pb0_, rs0_, mx0_); \
        _Pragma("unroll") for (int g_ = 0; g_ < 6; ++g_) { __builtin_amdgcn_sched_group_barrier(0x008, 1, 0); __builtin_amdgcn_sched_group_barrier(0x402, 10, 0); } \
        asm volatile("s_waitcnt lgkmcnt(0)" ::: "memory"); __builtin_amdgcn_sched_barrier(0); \
        _Pragma("unroll") for (int s2_ = 0; s2_ < 2; ++s2_) { o0 = __builtin_amdgcn_mfma_f32_32x32x16_bf16(va_[s2_ * 2], pb0_[s2_], o0, 0, 0, 0); o1 = __builtin_amdgcn_mfma_f32_32x32x16_bf16(va_[s2_ * 2 + 1], pb0_[s2_], o1, 0, 0, 0); } \
        AT_SOFT(sA1, pb1_, rs1_, mx1_); \
        _Pragma("unroll") for (int g_ = 0; g_ < 4; ++g_) { __builtin_amdgcn_sched_group_barrier(0x008, 1, 0); __builtin_amdgcn_sched_group_barrier(0x402, 14, 0); } \
        __builtin_amdgcn_sched_barrier(0); \
        _Pragma("unroll") for (int s2_ = 0; s2_ < 2; ++s2_) { o0 = __builtin_amdgcn_mfma_f32_32x32x16_bf16(va_[4 + s2_ * 2], pb1_[s2_], o0, 0, 0, 0); o1 = __builtin_amdgcn_mfma_f32_32x32x16_bf16(va_[4 + s2_ * 2 + 1], pb1_[s2_], o1, 0, 0, 0); } \
        float pm_; { const f32x2 rs_ = rs0_ + rs1_; const float rsum_ = rs_.x + rs_.y; l_run += rsum_; pm_ = rsum_ + __shfl_xor(rsum_, 32); (void)mx0_; (void)mx1_; \
          const float nm_ = -m_run; _Pragma("unroll") for (int i_ = 0; i_ < 16; ++i_) { sA0[i_] = nm_; sA1[i_] = nm_; } }        \
        _Pragma("unroll") for (int g_ = 0; g_ < 4; ++g_) { __builtin_amdgcn_sched_group_barrier(0x008, 1, 0); __builtin_amdgcn_sched_group_barrier(0x402, 10, 0); } \
        __builtin_amdgcn_sched_barrier(0); \
        if (__any(pm_ > 2048.f)) { const float dl_ = fmaxf(__builtin_amdgcn_logf(pm_) - 5.f, 0.f), al_ = __builtin_amdgcn_exp2f(-dl_); m_run += dl_; l_run *= al_; const float nm_ = -m_run; \
            _Pragma("unroll") for (int i_ = 0; i_ < 16; ++i_) { o0[i_] *= al_; o1[i_] *= al_; sA0[i_] = nm_; sA1[i_] = nm_; } } \
        __builtin_amdgcn_sched_barrier(0); } while (0)
#define AT_QK0(S0_, S1_, bo_) do { const LAS unsigned char* B_ = L + (bo_); _Pragma("unroll") for (int i_ = 0; i_ < 16; ++i_) { S0_[i_] = 0.f; S1_[i_] = 0.f; } \
        _Pragma("unroll") for (int ks_ = 0; ks_ < 6; ++ks_) { const bf16x8 a0_ = *(const LAS bf16x8*)(B_ + koff + ks_ * 32), a1_ = *(const LAS bf16x8*)(B_ + koff + 32 * KROW + ks_ * 32); \
            S0_ = __builtin_amdgcn_mfma_f32_32x32x16_bf16(a0_, qf[ks_], S0_, 0, 0, 0); S1_ = __builtin_amdgcn_mfma_f32_32x32x16_bf16(a1_, qf[ks_], S1_, 0, 0, 0); } } while (0)
    f32x16 o0, o1, sA0, sA1;
    const bool late = wave >= 4;
#pragma unroll
    for (int i = 0; i < 16; ++i) { o0[i] = 0.f; o1[i] = 0.f; }
    float m_run = -100.f, l_run = 0.f;
    const int koff = kap(r) * KROW + 16 * hh, voff = KBYTES + r * VROW + 16 * hh;
    v4u k0y, k1y, vy; k1y = (v4u){0u, 0u, 0u, 0u};
    AT_LOAD(k0r, k1r, vr, 0); AT_WRITE(k0r, k1r, vr, 0); AT_LOAD(k0r, k1r, vr, 1); AT_WRITE(k0r, k1r, vr, BUF);
    if (ntiles > 2) { AT_LOAD(k0r, k1r, vr, 2); AT_LOAD(k0y, k1y, vy, 3); }
    __syncthreads();
    AT_QK0(sA0, sA1, 0);
    { float mx = fmaxf(sA0[0], sA1[0]);
#pragma unroll
      for (int i = 1; i < 16; ++i) mx = fmaxf(mx, fmaxf(sA0[i], sA1[i]));
      m_run = fmaxf(mx, __shfl_xor(mx, 32)); }
    { const float nm = -m_run;
#pragma unroll
      for (int i = 0; i < 16; ++i) { sA0[i] = nm; sA1[i] = nm; } }
    int B0 = 0, B1 = 2 * BUF;
    for (int t = 0; t < ntiles; t += 2) {
        AT_TILE(B0);
        if (t + 2 < ntiles) AT_WRITE(k0r, k1r, vr, B1);
        if (t + 4 < ntiles) AT_LOAD(k0r, k1r, vr, t + 4);
        AT_TILE(B0 + BUF);
        if (t + 3 < ntiles) AT_WRITE(k0y, k1y, vy, B1 + BUF);
        if (t + 5 < ntiles) AT_LOAD(k0y, k1y, vy, t + 5);
        __syncthreads();
        { const int n0 = B1; B1 = B0; B0 = n0; }
    }
#undef AT_LOAD
#undef AT_WRITE
#undef AT_TILE
#undef AT_SOFT
#undef AT_QK0
    const float inv = 1.f / (l_run + __shfl_xor(l_run, 32));
    GAS bf16* op = O + (size_t)(qrow0 + wave * 32 + r) * 512 + head * 64 + 4 * hh;
#pragma unroll
    for (int g = 0; g < 4; ++g) { v2u w; w.x = pk2(o0[4 * g] * inv, o0[4 * g + 1] * inv); w.y = pk2(o0[4 * g + 2] * inv, o0[4 * g + 3] * inv); *(GAS v2u*)(op + 8 * g) = w;
        v2u w2; w2.x = pk2(o1[4 * g] * inv, o1[4 * g + 1] * inv); w2.y = pk2(o1[4 * g + 2] * inv, o1[4 * g + 3] * inv); *(GAS v2u*)(op + 32 + 8 * g) = w2; }
}


constexpr int GR = 72;
__device__ __forceinline__ int gla_mb(int c) { return c < 4 ? 3 - c : 4 + (131 - c); }
__device__ __forceinline__ int gla_row0(int b, int c) { return c < 4 ? NLAT + b * CTXL + 64 * c : b * SEQ + 64 * (c - 4); }
constexpr int GL_BF = 0, GL_BB = GL_BF + 64 * 65 * 4, GL_A0 = GL_BB + 64 * 65 * 4;
__device__ __forceinline__ void gla_cumsum(const Fr& F, const unsigned char* ws, int row0, int h) {
    LAS float* BF = (LAS float*)(F.L + GL_BF); LAS float* BB = (LAS float*)(F.L + GL_BB); const int tid = F.tid;
    { const int t = tid >> 3, d8 = (tid & 7) * 8; const GAS float* gf = (const GAS float*)(ws + WS_AF) + (size_t)(row0 + t) * 256 + h * 64 + d8; const GAS float* gb = (const GAS float*)(ws + WS_AB) + (size_t)(row0 + t) * 256 + h * 64 + d8;
      const f32x4 f0 = *(const f32x4*)gf, f1 = *(const GAS f32x4*)(gf + 4), b0 = *(const f32x4*)gb, b1 = *(const GAS f32x4*)(gb + 4);
#pragma unroll
      for (int i = 0; i < 4; ++i) { BF[t * 65 + d8 + i] = f0[i]; BF[t * 65 + d8 + 4 + i] = f1[i]; BB[t * 65 + d8 + i] = b0[i]; BB[t * 65 + d8 + 4 + i] = b1[i]; } }
    __syncthreads();
    { const int arr = tid >> 8, seg = (tid >> 6) & 3, d = tid & 63; LAS float* B = arr ? BB : BF; LAS float* tot = (LAS float*)(F.L + GL_A0) + arr * 256;
      float v[16]; float s = 0.f;
#pragma unroll
      for (int i = 0; i < 16; ++i) { const int t = arr ? (63 - (seg * 16 + i)) : (seg * 16 + i); s += B[t * 65 + d]; v[i] = s; }
      tot[seg * 64 + d] = s;
      __syncthreads();
      float off = 0.f;
#pragma unroll
      for (int q = 0; q < 3; ++q) off += (q < seg) ? tot[q * 64 + d] : 0.f;
#pragma unroll
      for (int i = 0; i < 16; ++i) { const int t = arr ? (63 - (seg * 16 + i)) : (seg * 16 + i); B[t * 65 + d] = v[i] + off; } }
    __syncthreads();
}

__device__ __forceinline__ void gla_a_item(const Fr& F, unsigned char* ws, int item) {
    const int c = item % 132, bh = item / 132, h = bh & 3, b = bh >> 2; const int row0 = gla_row0(b, c); const int tid = F.tid, lane = F.lane, wave = F.wave;
    gla_cumsum(F, ws, row0, h);
    LAS float* BF = (LAS float*)(F.L + GL_BF); LAS float* BB = (LAS float*)(F.L + GL_BB);
    LAS bf16* KTF = (LAS bf16*)(F.L + GL_A0);
    LAS bf16* KTB = KTF + 64 * GR;
    LAS bf16* VT = KTB + 64 * GR;
    const GAS bf16* P = (const GAS bf16*)(ws + WS_P);
    { const int t = tid >> 3, d8 = (tid & 7) * 8; const v4u kr = *(const GAS v4u*)(P + (size_t)(row0 + t) * INPAD + O_GK + h * 64 + d8);
#pragma unroll
      for (int i = 0; i < 8; ++i) { const int d = d8 + i; const float k = (i & 1) ? bfhi(kr[i >> 1]) : bflo(kr[i >> 1]);
          KTF[d * GR + t] = (bf16)f2bf(k * __expf(BF[63 * 65 + d] - BF[t * 65 + d])); KTB[d * GR + t] = (bf16)f2bf(k * __expf(BB[d] - BB[t * 65 + d])); }
#pragma unroll
      for (int q = 0; q < 2; ++q) { const int e8 = ((tid & 7) + 8 * q) * 8; const v4u vr = *(const GAS v4u*)(P + (size_t)(row0 + t) * INPAD + O_GV + h * 128 + e8);
#pragma unroll
          for (int i = 0; i < 8; ++i) VT[(e8 + i) * GR + t] = (bf16)((i & 1) ? (vr[i >> 1] >> 16) : (vr[i >> 1] & 0xffffu)); } }
    __syncthreads();
    const int r = lane & 31, hh = lane >> 5, eb = wave & 3, db = wave >> 2;
#pragma unroll
    for (int dir = 0; dir < 2; ++dir) { const LAS bf16* KT = dir ? KTB : KTF; f32x16 acc;
#pragma unroll
        for (int i = 0; i < 16; ++i) acc[i] = 0.f;
#pragma unroll
        for (int s = 0; s < 4; ++s) { const bf16x8 av = *(const LAS bf16x8*)(VT + (32 * eb + r) * GR + 16 * s + 8 * hh), bk = *(const LAS bf16x8*)(KT + (32 * db + r) * GR + 16 * s + 8 * hh);
            acc = __builtin_amdgcn_mfma_f32_32x32x16_bf16(av, bk, acc, 0, 0, 0); }
        const int chain = bh * 2 + dir, m = dir ? gla_mb(c) : c; GAS float* dst = (GAS float*)(ws + WS_GST) + ((size_t)chain * 132 + m) * 8192;
#pragma unroll
        for (int g = 0; g < 16; ++g) { const int e = 32 * eb + (g & 3) + 8 * (g >> 2) + 4 * hh; dst[e * 64 + 32 * db + r] = acc[g]; }
        if (wave == 0 && dir == 0) ((GAS float*)(ws + WS_GDEC))[((size_t)chain * 132 + m) * 64 + lane] = __expf(BF[63 * 65 + lane]);
        if (wave == 1 && dir == 1) ((GAS float*)(ws + WS_GDEC))[((size_t)chain * 132 + m) * 64 + lane] = __expf(BB[lane]); }
    __syncthreads();
}

__device__ __forceinline__ void gla_scan_q(const Fr& F, unsigned char* ws, int item) {
    const int chain = item >> 4, part = item & 15; const int idx = part * 512 + F.tid;
    GAS float* st = (GAS float*)(ws + WS_GST) + (size_t)chain * 132 * 8192 + idx; const GAS float* dec = (const GAS float*)(ws + WS_GDEC) + (size_t)chain * 132 * 64 + (idx & 63);
    GAS bf16* so = (GAS bf16*)(ws + WS_GSB) + (size_t)chain * 132 * 8192 + idx;
    float s = 0.f; float dn[6], an[6];
#pragma unroll
    for (int k = 0; k < 6; ++k) { dn[k] = st[(size_t)k * 8192]; an[k] = dec[k * 64]; }
    for (int m = 0; m < 132; m += 6) {
        float d2[6], a2[6];
#pragma unroll
        for (int k = 0; k < 6; ++k) { d2[k] = dn[k]; a2[k] = an[k]; }
        if (m + 6 < 132) {
#pragma unroll
            for (int k = 0; k < 6; ++k) { dn[k] = st[(size_t)(m + 6 + k) * 8192]; an[k] = dec[(m + 6 + k) * 64]; } }
#pragma unroll
        for (int k = 0; k < 6; ++k) { so[(size_t)(m + k) * 8192] = (bf16)f2bf(s); s = a2[k] * s + d2[k]; }
    }
}

__device__ __forceinline__ void gla_c_item(const Fr& F, const Args& a, unsigned char* ws, int l, int item) {
    const int c = item % 132, bh = item / 132, h = bh & 3, b = bh >> 2; const int row0 = gla_row0(b, c); const int tid = F.tid, lane = F.lane, wave = F.wave;
    gla_cumsum(F, ws, row0, h);
    LAS float* BF = (LAS float*)(F.L + GL_BF); LAS float* BB = (LAS float*)(F.L + GL_BB);
    LAS bf16* QF = (LAS bf16*)(F.L + GL_A0);
    LAS bf16* KF = QF + 64 * GR;
    LAS bf16* QBk = KF + 64 * GR;
    LAS bf16* KBk = QBk + 64 * GR;
    LAS bf16* VT = KBk + 64 * GR;
    LAS bf16* SF = VT + 128 * GR;
    LAS bf16* SB = SF + 128 * GR;
    LAS float* red = (LAS float*)(SB + 128 * GR);
    const GAS bf16* P = (const GAS bf16*)(ws + WS_P);
    { const int t = tid >> 3, d8 = (tid & 7) * 8; const GAS bf16* pr = P + (size_t)(row0 + t) * INPAD; const v4u qr = *(const GAS v4u*)(pr + O_GQ + h * 64 + d8), kr = *(const GAS v4u*)(pr + O_GK + h * 64 + d8);
      v4u qf, kf, qb, kb;
#pragma unroll
      for (int i = 0; i < 4; ++i) { const float q0 = bflo(qr[i]) * 0.125f, q1 = bfhi(qr[i]) * 0.125f, k0 = bflo(kr[i]), k1 = bfhi(kr[i]);
          const float f0 = BF[t * 65 + d8 + 2 * i], f1 = BF[t * 65 + d8 + 2 * i + 1], g0 = BB[t * 65 + d8 + 2 * i], g1 = BB[t * 65 + d8 + 2 * i + 1];
          qf[i] = pk2(q0 * __expf(f0), q1 * __expf(f1)); kf[i] = pk2(k0 * __expf(-f0), k1 * __expf(-f1)); qb[i] = pk2(q0 * __expf(g0), q1 * __expf(g1)); kb[i] = pk2(k0 * __expf(-g0), k1 * __expf(-g1)); }
      *(LAS v4u*)(QF + t * GR + d8) = qf; *(LAS v4u*)(KF + t * GR + d8) = kf; *(LAS v4u*)(QBk + t * GR + d8) = qb; *(LAS v4u*)(KBk + t * GR + d8) = kb;
#pragma unroll
      for (int q = 0; q < 2; ++q) { const int e8 = ((tid & 7) + 8 * q) * 8; const v4u vr = *(const GAS v4u*)(pr + O_GV + h * 128 + e8);
#pragma unroll
          for (int i = 0; i < 8; ++i) VT[(e8 + i) * GR + t] = (bf16)((i & 1) ? (vr[i >> 1] >> 16) : (vr[i >> 1] & 0xffffu)); } }
    { const GAS bf16* sf = (const GAS bf16*)(ws + WS_GSB) + ((size_t)(bh * 2) * 132 + c) * 8192; const GAS bf16* sb = (const GAS bf16*)(ws + WS_GSB) + ((size_t)(bh * 2 + 1) * 132 + gla_mb(c)) * 8192;
#pragma unroll
      for (int q = 0; q < 2; ++q) { const int idx = (tid + 512 * q) * 8, e = idx >> 6, d = idx & 63;
          *(LAS v4u*)(SF + e * GR + d) = *(const GAS v4u*)(sf + idx); *(LAS v4u*)(SB + e * GR + d) = *(const GAS v4u*)(sb + idx); } }
    __syncthreads();
    const int r = lane & 31, hh = lane >> 5, eb = wave & 3, ib = wave >> 2;
    f32x16 O;
#pragma unroll
    for (int i = 0; i < 16; ++i) O[i] = 0.f;
#pragma unroll
    for (int dir = 0; dir < 2; ++dir) { const LAS bf16* Qd = dir ? QBk : QF; const LAS bf16* Kd = dir ? KBk : KF; const LAS bf16* Sd = dir ? SB : SF;
        bf16x8 qfr[4];
#pragma unroll
        for (int s = 0; s < 4; ++s) qfr[s] = *(const LAS bf16x8*)(Qd + (32 * ib + r) * GR + 16 * s + 8 * hh);
#pragma unroll
        for (int jb = 0; jb < 2; ++jb) { f32x16 pt;
#pragma unroll
            for (int i = 0; i < 16; ++i) pt[i] = 0.f;
#pragma unroll
            for (int s = 0; s < 4; ++s) { const bf16x8 ka = *(const LAS bf16x8*)(Kd + (32 * jb + kap(r)) * GR + 16 * s + 8 * hh); pt = __builtin_amdgcn_mfma_f32_32x32x16_bf16(ka, qfr[s], pt, 0, 0, 0); }
            const int ti = 32 * ib + r;
#pragma unroll
            for (int g = 0; g < 16; ++g) { const int tj = 32 * jb + kap((g & 3) + 8 * (g >> 2) + 4 * hh); const bool keep = dir ? (tj >= ti) : (tj <= ti); pt[g] = keep ? pt[g] : 0.f; }
#pragma unroll
            for (int s2 = 0; s2 < 2; ++s2) { v4u w; w.x = pkbf2(pt[8 * s2 + 0], pt[8 * s2 + 1]); w.y = pkbf2(pt[8 * s2 + 2], pt[8 * s2 + 3]); w.z = pkbf2(pt[8 * s2 + 4], pt[8 * s2 + 5]); w.w = pkbf2(pt[8 * s2 + 6], pt[8 * s2 + 7]);
                const bf16x8 va = *(const LAS bf16x8*)(VT + (32 * eb + r) * GR + 32 * jb + 16 * s2 + 8 * hh);
                O = __builtin_amdgcn_mfma_f32_32x32x16_bf16(va, __builtin_bit_cast(bf16x8, w), O, 0, 0, 0); } }
#pragma unroll
        for (int s = 0; s < 4; ++s) { const bf16x8 sa = *(const LAS bf16x8*)(Sd + (32 * eb + r) * GR + 16 * s + 8 * hh); O = __builtin_amdgcn_mfma_f32_32x32x16_bf16(sa, qfr[s], O, 0, 0, 0); } }
    { float ss = 0.f;
#pragma unroll
      for (int g = 0; g < 16; ++g) ss += O[g] * O[g];
      ss += __shfl_xor(ss, 32);
      if (hh == 0) red[eb * 64 + 32 * ib + r] = ss; }
    __syncthreads();
    { const int ti = 32 * ib + r; const float tot = (red[ti] + red[64 + ti]) + (red[128 + ti] + red[192 + ti]); const float rs = 1.f / sqrtf(tot * (1.f / 128.f) + RMS_EPS);
      const GAS float* gn = (const GAS float*)INP(a, I_GNORM) + l * 128; const GAS bf16* pr = P + (size_t)(row0 + ti) * INPAD + O_GR + h * 128; GAS bf16* o = (GAS bf16*)(ws + WS_OBR) + (size_t)(row0 + ti) * 512 + h * 128;
#pragma unroll
      for (int g4 = 0; g4 < 4; ++g4) { const int e = 32 * eb + 8 * g4 + 4 * hh; const f32x4 gv = *(const GAS f32x4*)(gn + e); const v2u rw = *(const GAS v2u*)(pr + e);
          const float r0 = bflo(rw.x), r1 = bfhi(rw.x), r2 = bflo(rw.y), r3 = bfhi(rw.y);
          const float y0 = O[4 * g4] * rs * gv[0] * (r0 / (1.f + __expf(-r0))), y1 = O[4 * g4 + 1] * rs * gv[1] * (r1 / (1.f + __expf(-r1)));
          const float y2 = O[4 * g4 + 2] * rs * gv[2] * (r2 / (1.f + __expf(-r2))), y3 = O[4 * g4 + 3] * rs * gv[3] * (r3 / (1.f + __expf(-r3)));
          v2u w; w.x = pk2(y0, y1); w.y = pk2(y2, y3); *(GAS v2u*)(o + e) = w; } }
    __syncthreads();
}

__device__ __forceinline__ void gate_row(const Fr& F, unsigned char* ws, int row) {
    const int lane = F.lane; const GAS bf16* pg = (const GAS bf16*)(ws + WS_P) + (size_t)row * INPAD + O_GATE; const GAS bf16* pu = (const GAS bf16*)(ws + WS_U) + (size_t)row * 3072; GAS bf16* po = (GAS bf16*)(ws + WS_YMB) + (size_t)row * 1024;
    v4u gq[2][3], uq[2][3];
#pragma unroll
    for (int j = 0; j < 2; ++j)
#pragma unroll
        for (int br = 0; br < 3; ++br) { const int c = 8 * lane + 512 * j; gq[j][br] = *(const GAS v4u*)(pg + br * 1024 + c); uq[j][br] = *(const GAS v4u*)(pu + br * 1024 + c); }
#pragma unroll
    for (int j = 0; j < 2; ++j) { const int c = 8 * lane + 512 * j; float y[8];
#pragma unroll
        for (int i = 0; i < 8; ++i) y[i] = 0.f;
#pragma unroll
        for (int br = 0; br < 3; ++br) { const v4u g = gq[j][br], u = uq[j][br];
#pragma unroll
            for (int i = 0; i < 4; ++i) { y[2 * i] += bflo(u[i]) * __builtin_amdgcn_rcpf(1.f + __expf(-bflo(g[i]))); y[2 * i + 1] += bfhi(u[i]) * __builtin_amdgcn_rcpf(1.f + __expf(-bfhi(g[i]))); } }
        v4u o; o.x = pk2(y[0], y[1]); o.y = pk2(y[2], y[3]); o.z = pk2(y[4], y[5]); o.w = pk2(y[6], y[7]); *(GAS v4u*)(po + c) = o; }
}
__device__ __forceinline__ void hy_tr_item(const Fr& F, unsigned char* ws, int item) {
    LAS bf16* T = (LAS bf16*)F.L;
    const int tid = F.tid; const int cb = item & 7, sb = (item >> 3) & 15, b = item >> 7; const int c0 = cb * 64, s0 = sb * 512;
    { const int cc = tid >> 3, sq = tid & 7; const GAS bf16* src = (const GAS bf16*)(ws + WS_OHYT) + ((size_t)(c0 + cc) * 2 + b) * 8192 + s0 + sq * 8; v4u v[8];
#pragma unroll
      for (int q = 0; q < 8; ++q) v[q] = *(const GAS v4u*)(src + q * 64);
#pragma unroll
      for (int q = 0; q < 8; ++q) *(LAS v4u*)(T + q * (64 * 72) + ((cc & 7) * 8 + (cc >> 3)) * 72 + sq * 8) = v[q]; }
    __syncthreads();
    { const int ss = tid >> 3, cq = tid & 7; GAS bf16* dst = (GAS bf16*)(ws + WS_OBR) + (size_t)2 * MALL * 512 + (size_t)(b * 8192 + s0 + ss) * 512 + c0 + cq * 8;
#pragma unroll
      for (int q = 0; q < 8; ++q) { unsigned short e[8];
#pragma unroll
          for (int j = 0; j < 8; ++j) e[j] = T[q * (64 * 72) + (j * 8 + cq) * 72 + ss];
          v4u o; o.x = e[0] | ((unsigned)e[1] << 16); o.y = e[2] | ((unsigned)e[3] << 16); o.z = e[4] | ((unsigned)e[5] << 16); o.w = e[6] | ((unsigned)e[7] << 16);
          *(GAS v4u*)(dst + (size_t)q * 64 * 512) = o; } }
    __syncthreads();
}

struct Ln1Par { f32x4 g[4], b[4], sc[4], sh[4]; };
__device__ __forceinline__ void ln1_mod2(const v2u (&raw)[4], GAS bf16* xs, GAS bf16* hb, const Ln1Par& P, float (&x)[16], int lane) {
    float s = 0.f;
#pragma unroll
    for (int j = 0; j < 4; ++j) { const v2u w = raw[j]; f32x4 v; v[0] = bflo(w.x); v[1] = bfhi(w.x); v[2] = bflo(w.y); v[3] = bfhi(w.y); x[4 * j] = v[0]; x[4 * j + 1] = v[1]; x[4 * j + 2] = v[2]; x[4 * j + 3] = v[3]; s += (v[0] + v[1]) + (v[2] + v[3]); }
    float mean = wave_sum(s) * (1.f / 1024.f); float q = 0.f;
#pragma unroll
    for (int i = 0; i < 16; ++i) { x[i] -= mean; q += x[i] * x[i]; }
    float rstd = 1.f / sqrtf(wave_sum(q) * (1.f / 1024.f) + LN_EPS);
    s = 0.f;
#pragma unroll
    for (int j = 0; j < 4; ++j) { const f32x4 g = P.g[j], bb = P.b[j]; f32x4 o;
#pragma unroll
        for (int c = 0; c < 4; ++c) { x[4 * j + c] = x[4 * j + c] * rstd * g[c] + bb[c]; o[c] = x[4 * j + c]; s += o[c]; }
        v2u wo; wo.x = pk2(o[0], o[1]); wo.y = pk2(o[2], o[3]); *(GAS v2u*)(xs + 4 * lane + 256 * j) = wo; }
    mean = wave_sum(s) * (1.f / 1024.f); q = 0.f;
#pragma unroll
    for (int i = 0; i < 16; ++i) { x[i] -= mean; q += x[i] * x[i]; }
    rstd = 1.f / sqrtf(wave_sum(q) * (1.f / 1024.f) + LN_EPS);
#pragma unroll
    for (int j = 0; j < 4; ++j) { const f32x4 sc = P.sc[j], sh = P.sh[j];
#pragma unroll
        for (int c = 0; c < 4; ++c) x[4 * j + c] = x[4 * j + c] * rstd * (1.f + sc[c]) + sh[c];
        v2u w; w.x = pk2(x[4 * j], x[4 * j + 1]); w.y = pk2(x[4 * j + 2], x[4 * j + 3]); *(GAS v2u*)(hb + 4 * lane + 256 * j) = w; }
}
constexpr int RW_STRIDE = 1028;
__device__ __forceinline__ float reduce32(float (&p)[32], int lane) {
    float a[16], b[8], c[4], d[2];
#pragma unroll
    for (int e = 0; e < 16; ++e) { const auto r = __builtin_amdgcn_permlane32_swap(__builtin_bit_cast(unsigned, p[e]), __builtin_bit_cast(unsigned, p[e + 16]), false, false);
        a[e] = __builtin_bit_cast(float, (unsigned)r[0]) + __builtin_bit_cast(float, (unsigned)r[1]); }
#pragma unroll
    for (int e = 0; e < 8; ++e) { const auto r = __builtin_amdgcn_permlane16_swap(__builtin_bit_cast(unsigned, a[e]), __builtin_bit_cast(unsigned, a[e + 8]), false, false);
        b[e] = __builtin_bit_cast(float, (unsigned)r[0]) + __builtin_bit_cast(float, (unsigned)r[1]); }
    { const bool up = (lane & 8) != 0;
#pragma unroll
      for (int e = 0; e < 4; ++e) { const float send = up ? b[e] : b[e + 4], keep = up ? b[e + 4] : b[e]; c[e] = keep + dpp_mov<0x128>(send); } }
    { const bool up = (lane & 4) != 0;
#pragma unroll
      for (int e = 0; e < 2; ++e) { const float send = up ? c[e] : c[e + 2], keep = up ? c[e + 2] : c[e]; d[e] = keep + dpp_mov<0x141>(send); } }
    float r;
    { const bool up = (lane & 2) != 0; const float send = up ? d[0] : d[1], keep = up ? d[1] : d[0]; r = keep + dpp_mov<0x4E>(send); }
    return r + dpp_mov<0xB1>(r);
}
__device__ __forceinline__ void route_row(unsigned char* ws, int l, int row, float tot, const GAS float* rb, int lane, bool dry, LAS unsigned* lcnt) {
    float mylogit = (lane & 1) ? -3.0e38f : tot + rb[lane >> 1];
    float tv[4]; int ti[4];
#pragma unroll
    for (int k = 0; k < 4; ++k) { const float mx = wave_max(mylogit); const unsigned long long bal = __ballot(mylogit == mx); const int idx = __builtin_ctzll(bal); tv[k] = mx; ti[k] = idx >> 1; if (lane == idx) mylogit = -3.0e38f; }
    const float e1 = expf(tv[1] - tv[0]), e2 = expf(tv[2] - tv[0]), e3 = expf(tv[3] - tv[0]); const float inv = 1.f / (1.f + e1 + e2 + e3);
    if (lane < 4 && !dry) { const int e = lane == 0 ? ti[0] : lane == 1 ? ti[1] : lane == 2 ? ti[2] : ti[3]; const float g = (lane == 0 ? 1.f : lane == 1 ? e1 : lane == 2 ? e2 : e3) * inv;
        const unsigned pos = __hip_atomic_fetch_add(lcnt + e, 1u, __ATOMIC_RELAXED, __HIP_MEMORY_SCOPE_WORKGROUP);
        ((GAS int*)(ws + WS_TOPE))[row * 4 + lane] = e; ((GAS float*)(ws + WS_TOPG))[row * 4 + lane] = g; ((GAS int*)(ws + WS_SPOS))[row * 4 + lane] = (int)pos; }
}
__device__ __forceinline__ void ln1_router_row2(const Fr& F, const Args& a, unsigned char* ws, int l, int row0, const LAS float* wT  , bool dry, LAS unsigned* lcnt) {
    const int lane = F.lane; const GAS float* g1 = (const GAS float*)INP(a, I_LN1G) + l * 1024; const GAS float* b1 = (const GAS float*)INP(a, I_LN1B) + l * 1024;
    const int mi = row0 < NLAT ? (row0 >> 13) : 2; const GAS float* mod = (const GAS float*)(ws + WS_MOD) + ((size_t)l * 3 + mi) * 6144;
    float x0[16], x1[16];
    { v2u r0[4], r1[4]; Ln1Par PV; const GAS bf16* xp = (const GAS bf16*)(ws + WS_XPRE) + (size_t)row0 * 1024 + 4 * lane;
#pragma unroll
      for (int j = 0; j < 4; ++j) { r0[j] = *(const GAS v2u*)(xp + 256 * j); r1[j] = *(const GAS v2u*)(xp + 1024 + 256 * j); }
#pragma unroll
      for (int j = 0; j < 4; ++j) { PV.g[j] = *(const GAS f32x4*)(g1 + 4 * lane + 256 * j); PV.b[j] = *(const GAS f32x4*)(b1 + 4 * lane + 256 * j); PV.sh[j] = *(const GAS f32x4*)(mod + 3072 + 4 * lane + 256 * j); PV.sc[j] = *(const GAS f32x4*)(mod + 4096 + 4 * lane + 256 * j); }
      ln1_mod2(r0, (GAS bf16*)(ws + WS_XS) + (size_t)row0 * 1024, (GAS bf16*)(ws + WS_HBF) + (size_t)row0 * 1024, PV, x0, lane);
      ln1_mod2(r1, (GAS bf16*)(ws + WS_XS) + (size_t)(row0 + 1) * 1024, (GAS bf16*)(ws + WS_HBF) + (size_t)(row0 + 1) * 1024, PV, x1, lane); }
    float p0[32], p1[32];
#pragma unroll
    for (int e = 0; e < 32; ++e) { float s0 = 0.f, s1 = 0.f;
#pragma unroll
        for (int j = 0; j < 4; ++j) { const f32x4 w = *(const LAS f32x4*)(wT + e * RW_STRIDE + 4 * lane + 256 * j);
#pragma unroll
            for (int c = 0; c < 4; ++c) { s0 += x0[4 * j + c] * w[c]; s1 += x1[4 * j + c] * w[c]; } }
        p0[e] = s0; p1[e] = s1; }
    const float t0 = reduce32(p0, lane), t1 = reduce32(p1, lane);
    const GAS float* rb = (const GAS float*)INP(a, I_RB) + l * 32;
    route_row(ws, l, row0, t0, rb, lane, dry, lcnt); route_row(ws, l, row0 + 1, t1, rb, lane, dry, lcnt);
}

__device__ __forceinline__ int moe_table(const Fr& F, unsigned char* ws, int l, LAS int* pst, LAS int* cntl, LAS int* ptab) {
    if (F.tid < 64) { const int e = F.tid & 31; const GAS unsigned* cnt = (const GAS unsigned*)(ws + WS_CTL) + CW_CNT + l * 32 * 64;
        const int c = (int)__hip_atomic_load(cnt + e * 64, __ATOMIC_RELAXED, __HIP_MEMORY_SCOPE_AGENT); const int np = (c + 255) >> 8;
        int incl = np;
#pragma unroll
        for (int o = 1; o < 32; o <<= 1) { const int v = __shfl_up(incl, o, 32); if (e >= o) incl += v; }
        const int first = incl - np;
        if (F.tid < 32) { cntl[e] = c; pst[e] = first << 8; if (e == 31) pst[32] = incl << 8;
#pragma unroll 1
            for (int j = 0; j < np; ++j) ptab[first + j] = e; } }
    __syncthreads();
    return __builtin_amdgcn_readfirstlane(pst[32] >> 8);
}

__device__ __forceinline__ void combine_load(unsigned char* ws, int row, f32x4 (&f)[4], f32x4 (&x)[4], int lane) {
    const GAS bf16* ys = (const GAS bf16*)(ws + WS_YSLOT) + (size_t)row * 4 * 1024; const GAS bf16* xs = (const GAS bf16*)(ws + WS_XS) + (size_t)row * 1024;
#pragma unroll
    for (int j = 0; j < 4; ++j) { const int k = 4 * lane + 256 * j; v2u w[4];
#pragma unroll
        for (int kk = 0; kk < 4; ++kk) w[kk] = *(const GAS v2u*)(ys + (size_t)kk * 1024 + k);
        { const v2u wx = *(const GAS v2u*)(xs + k); x[j].x = bflo(wx.x); x[j].y = bfhi(wx.x); x[j].z = bflo(wx.y); x[j].w = bfhi(wx.y); }
        f[j].x = (bflo(w[0].x) + bflo(w[1].x)) + (bflo(w[2].x) + bflo(w[3].x)); f[j].y = (bfhi(w[0].x) + bfhi(w[1].x)) + (bfhi(w[2].x) + bfhi(w[3].x));
        f[j].z = (bflo(w[0].y) + bflo(w[1].y)) + (bflo(w[2].y) + bflo(w[3].y)); f[j].w = (bfhi(w[0].y) + bfhi(w[1].y)) + (bfhi(w[2].y) + bfhi(w[3].y)); } }
__device__ __forceinline__ void combine_fin(const Fr& F, const Args& a, unsigned char* ws, int l, int row, GAS bf16* xso, const f32x4 (&f)[4], const f32x4 (&x)[4]) {
    const int lane = F.lane;
    const int mi = row < NLAT ? (row >> 13) : 2; const GAS float* mod = (const GAS float*)(ws + WS_MOD) + ((size_t)l * 3 + mi) * 6144; const GAS float* g2 = mod + 5120;
    const GAS float* lg = (const GAS float*)INP(a, I_LN2G) + l * 1024; const GAS float* lb = (const GAS float*)INP(a, I_LN2B) + l * 1024;
    f32x4 v[4], lgv[4], lbv[4]; float s = 0.f;
#pragma unroll
    for (int j = 0; j < 4; ++j) { const int k = 4 * lane + 256 * j; lgv[j] = *(const GAS f32x4*)(lg + k); lbv[j] = *(const GAS f32x4*)(lb + k); v[j] = x[j] * DN_ALPHA + *(const GAS f32x4*)(g2 + k) * f[j]; s += (v[j].x + v[j].y) + (v[j].z + v[j].w); }
    const float mean = wave_sum(s) * (1.f / 1024.f); float q = 0.f;
#pragma unroll
    for (int j = 0; j < 4; ++j) { v[j] = v[j] - mean; q += (v[j].x * v[j].x + v[j].y * v[j].y) + (v[j].z * v[j].z + v[j].w * v[j].w); }
    const float rstd = 1.f / sqrtf(wave_sum(q) * (1.f / 1024.f) + LN_EPS);
#pragma unroll
    for (int j = 0; j < 4; ++j) { const int k = 4 * lane + 256 * j; v[j] = v[j] * rstd * lgv[j] + lbv[j]; if (l == 0) { v2u wo; wo.x = pk2(v[j].x, v[j].y); wo.y = pk2(v[j].z, v[j].w); *(GAS v2u*)(xso + (size_t)row * 1024 + k) = wo; } }
    if (l == 1) {
#pragma unroll
        for (int j = 0; j < 4; ++j) *(GAS f32x4*)((GAS float*)a.out + (size_t)row * 1024 + 4 * lane + 256 * j) = v[j];
    }
}
__device__ __forceinline__ void combine_row(const Fr& F, const Args& a, unsigned char* ws, int l, int row, GAS bf16* xso) { f32x4 f[4], x[4]; combine_load(ws, row, f, x, F.lane); combine_fin(F, a, ws, l, row, xso, f, x); }

constexpr int NPH_PRO = 3, NPH_LAYER = 12, NPH = NPH_PRO + 2 * NPH_LAYER;
constexpr float QSCALE = 0.10206207261596575f * 1.4426950408889634f;

__global__ void __launch_bounds__(512, 2) fwd(Args args) {
    extern __shared__ __attribute__((aligned(16))) unsigned char lds[];
    Fr F; F.L = (LAS unsigned char*)lds; F.tid = threadIdx.x; F.lane = F.tid & 63; F.wave = __builtin_amdgcn_readfirstlane(F.tid >> 6); F.G = gridDim.x; F.bid = blockIdx.x;
    volatile LAS unsigned* MISC = (volatile LAS unsigned*)(F.L + LDS_MISC);
    unsigned char* wsraw = args.ws; unsigned char* ws = (unsigned char*)(GAS unsigned char*)wsraw;
#define ctl ((unsigned*)(ws + WS_CTL))
    for (int u = F.tid; u < (LDS_BYTES - LDS_MISC) / 4; u += 512) ((LAS unsigned*)(F.L + LDS_MISC))[u] = 0u;
    __syncthreads();
#if !MK_PER_PHASE
    XcdBarrier bar = xcd_barrier_post(ctl + CW_BAR, MISC + 8);
#define SEAM() xcd_barrier(bar)
#else
#define SEAM() do {} while (0)
#endif
#define HYF(l_, Ln_, blk_, FILT_, HP_) hy_filter_item(F.L, F.tid, INP(args, I_HW1) + (size_t)(l_) * 33 * 64, INP(args, I_HB1) + (l_) * 64, INP(args, I_HW2) + (size_t)(l_) * 64 * 64, INP(args, I_HB2) + (l_) * 64, INP(args, I_HFREQ) + (l_) * 64, INP(args, I_HW3) + (size_t)(l_) * 64 * 2048, Ln_, blk_, FILT_, HP_)
#define PHASE_BEGIN() do { asm volatile("" : "+v"(F.tid)); F.lane = F.tid & 63; asm volatile("" : "+s"(wsraw)); ws = (unsigned char*)(GAS unsigned char*)wsraw; gw = F.bid * 8 + F.wave; gt = F.bid * 512 + F.tid; } while (0)
    const int lo = args.ph_lo, hi = args.ph_hi;
#ifndef MK_ATTVAR
#define MK_ATTVAR 0
#endif
#ifndef MK_DUP
#define MK_DUP 0
#endif
#ifndef MK_DUPN
#define MK_DUPN 1
#endif
#define TIMES(k) (1 + ((MK_DUP >> (k)) & 1) * MK_DUPN)
#ifndef MK_SUB
#define MK_SUB 0xffff
#endif
#define SUB(k) ((MK_SUB >> (k)) & 1)
#ifndef MK_MASK
#define MK_MASK 0x7fff
#endif
#define IN(k) (((MK_MASK >> (k)) & 1) && lo <= (k) && (k) < hi)
#define INL(j) (((MK_MASK >> (3 + (j))) & 1) && lo <= (pb + (j)) && (pb + (j)) < hi)
    int gw = F.bid * 8 + F.wave, gt = F.bid * 512 + F.tid; const int NGW = F.G * 8, NGT = F.G * 512;

    if (IN(0)) for (int r_ = 0; r_ < 1 + (args.dupk == 0); ++r_) {
        PHASE_BEGIN();
        for (int rep_ = 0; rep_ < TIMES(0); ++rep_) {
        __syncthreads();
        for (int step_ = 0; step_ < 2; ++step_) { const bool do_filt = (step_ == 0) == ((F.bid & 1) != 0); __syncthreads();
        if (!do_filt) {
        { LAS float* scr = (LAS float*)(F.L + F.wave * 8448);
          constexpr int I_IN = 16 * 214, I_UQ = 6 * 24, I_UKV = 4 * 32, I_BR = 8 * 32, I_OUT = 16 * 32, I_M1 = 32 * 16 * 64, I_M2 = 32 * 16 * 32, PER_LAYER = I_IN + I_UQ + I_UKV + 3 * I_BR + I_OUT + I_M1 + I_M2;
          for (int it = gw; it < 2 * PER_LAYER; it += NGW) {
              const int l = it / PER_LAYER; int r = it - l * PER_LAYER; unsigned char* wbl = ws + WS_W + (size_t)l * WB_LAYER;
              if (r < I_IN) { tr_item(INP(args, I_WIN) + (size_t)l * 1024 * INTOT, 1024, INTOT, (bf16*)(wbl + WB_IN), 0, nullptr, 1.f, scr, r, F.lane); continue; } r -= I_IN;
              if (r < I_UQ) { tr_item(INP(args, I_WUQ) + (size_t)l * 384 * 768, 384, 768, (bf16*)(wbl + WB_UQ), 0, INP(args, I_QNORM) + l * 384, QSCALE, scr, r, F.lane); continue; } r -= I_UQ;
              if (r < I_UKV) { tr_item(INP(args, I_WUKV) + (size_t)l * 256 * 1024, 256, 1024, (bf16*)(wbl + WB_UKV), 0, INP(args, I_KVNORM) + l * 256, 1.f, scr, r, F.lane); continue; } r -= I_UKV;
              if (r < 3 * I_BR) { const int br = r / I_BR; tr_item(INP(args, I_WBG + br) + (size_t)l * 512 * 1024, 512, 1024, (bf16*)(wbl + WB_BR) + (size_t)br * 1024 * 512, 0, nullptr, 1.f, scr, r - br * I_BR, F.lane); continue; } r -= 3 * I_BR;
              if (r < I_OUT) { tr_item(INP(args, I_WOUT) + (size_t)l * 1024 * 1024, 1024, 1024, (bf16*)(wbl + WB_OUT), 0, nullptr, 1.f, scr, r, F.lane); continue; } r -= I_OUT;
              if (r < I_M1) { const int e = r >> 10; tr_item(INP(args, I_MW1) + ((size_t)l * 32 + e) * 1024 * 2048, 1024, 2048, (bf16*)(wbl + WB_M1) + (size_t)e * 2048 * 1024, 1, nullptr, 1.f, scr, r & 1023, F.lane); continue; } r -= I_M1;
              { const int e = r >> 9; tr_item(INP(args, I_MW2) + ((size_t)l * 32 + e) * 1024 * 1024, 1024, 1024, (bf16*)(wbl + WB_M2) + (size_t)e * 1024 * 1024, 0, nullptr, 1.f, scr, r & 511, F.lane); }
          }
          for (int i = gt; i < 2 * 64 * 1024 / 8; i += NGT) { const int l = i >> 13, j = i & 8191; *(v4u*)((bf16*)(ws + WS_W + (size_t)l * WB_LAYER + WB_IN) + (size_t)INTOT * 1024 + (size_t)j * 8) = (v4u){0u, 0u, 0u, 0u}; }
        }
        if (F.bid < 192) { LAS float* act = (LAS float*)(F.L + 98304);
            __syncthreads();
            for (int i = F.tid; i < 3072; i += 512) { const float x = i < 2048 ? INP(args, I_C)[i] : INP(args, I_CCTX)[i - 2048]; act[i] = silu_(x); }
            __syncthreads();
            for (int it = F.bid; it < 192; it += F.G) { const int l = it / 96, r = it - l * 96, kb = r / 12, nb = r - kb * 12, n = nb * 512 + F.tid;
                const float* W = INP(args, I_ADAW) + (size_t)l * 1024 * 6144; float a0 = 0.f, a1 = 0.f, a2 = 0.f;
#pragma unroll 8
                for (int k = kb * 128; k < kb * 128 + 128; ++k) { const float w = W[(size_t)k * 6144 + n]; a0 += act[k] * w; a1 += act[1024 + k] * w; a2 += act[2048 + k] * w; }
                float* mp = (float*)(ws + WS_MODP) + (((size_t)kb * 2 + l) * 3) * 6144 + n; mp[0] = a0; mp[6144] = a1; mp[2 * 6144] = a2; } }
        for (int i = gt; i < 8192 * 16; i += NGT) { const int t = i >> 4, j = i & 15; const float pos = (float)((j < 8) ? (t >> 6) : (t & 63)); const float inv = powf(10000.f, -(float)(j & 7) / 8.f); const float ang = pos * inv;
            float* rp = (float*)(ws + WS_ROPE) + (size_t)i * 2; rp[0] = cosf(ang); rp[1] = sinf(ang); }
        for (int i = gt; i < FFTN; i += NGT) { float sn, cs; sincospif((float)i / 8192.f, &sn, &cs); f32x2 w; w.x = cs; w.y = -sn; ((f32x2*)(ws + WS_TW))[i] = w; }
        } else {
        __syncthreads();
        for (int it = F.bid; it < 264; it += F.G) { int it2 = it; if (F.G == 256 && it >= 256) continue; if (it2 < 256) HYF(0, 8192, it2, (bf16*)(ws + WS_FILT), (float*)(ws + WS_HPART)); else HYF(0, 256, it2 - 256, (bf16*)(ws + WS_FILTC), (float*)(ws + WS_HPARTC)); }
        if (F.G == 256 && F.bid >= 248) HYF(0, 256, F.bid - 248, (bf16*)(ws + WS_FILTC), (float*)(ws + WS_HPARTC));
        } }
        }
        SEAM();
    }
#ifdef MK_XBAR
    for (int k_ = 0; k_ < MK_XBAR; ++k_) SEAM();
#endif
    if (IN(1)) {
        PHASE_BEGIN();
        for (int i = gt; i < 2 * 3 * 6144; i += NGT) { const int l = i / 18432, n = i % 6144; float s = INP(args, I_ADAB)[l * 6144 + n];
#pragma unroll
            for (int kb = 0; kb < 8; ++kb) s += ((const float*)(ws + WS_MODP))[(size_t)kb * 2 * 18432 + i];
            ((float*)(ws + WS_MOD))[i] = s; }
        SEAM();
    }
    if (IN(2)) for (int r_ = 0; r_ < 1 + (args.dupk == 2); ++r_) {
        PHASE_BEGIN();
        for (int row = gw; row < MALL; row += 2 * NGW) {
            const int row2 = row + NGW; const bool two = row2 < MALL; f32x4 va[4], vb[4];
            ln_mod_load((const GAS float*)(row < NLAT ? INP(args, I_X) + (size_t)row * 1024 : INP(args, I_CTX) + (size_t)(row - NLAT) * 1024), va, F.lane);
            if (two) ln_mod_load((const GAS float*)(row2 < NLAT ? INP(args, I_X) + (size_t)row2 * 1024 : INP(args, I_CTX) + (size_t)(row2 - NLAT) * 1024), vb, F.lane);
            { const int mi = row < NLAT ? (row >> 13) : 2; const GAS float* mod = (const GAS float*)(ws + WS_MOD) + (size_t)mi * 6144; ln_mod_fin(va, mod, mod + 1024, (GAS bf16*)(ws + WS_HBF) + (size_t)row * 1024, F.lane); }
            if (two) { const int mi = row2 < NLAT ? (row2 >> 13) : 2; const GAS float* mod = (const GAS float*)(ws + WS_MOD) + (size_t)mi * 6144; ln_mod_fin(vb, mod, mod + 1024, (GAS bf16*)(ws + WS_HBF) + (size_t)row2 * 1024, F.lane); } }
        SEAM();
    }

    for (int l = 0; l < 2; ++l) {
        const int pb = NPH_PRO + l * NPH_LAYER;
#define wb (ws + WS_W + (size_t)l * WB_LAYER)
        const int nrows = l == 1 ? NLAT : MALL, nPM = nrows / 256;
        if (INL(0)) for (int r_ = 0; r_ < 1 + (args.dupk == 3); ++r_) {
            PHASE_BEGIN();
            if (SUB(0)) { pg8::Gemm g{(const bf16*)(ws + WS_HBF), (const bf16*)(wb + WB_IN), MALL, INPAD, 1024}; pg8::StaticOrder S; S.init(MALL, INPAD, F.G, F.bid);
              pg8::EpiP E{(GAS bf16*)(ws + WS_P), INPAD};
              pg8::gemm_phase<pg8::EpiP, pg8::StaticOrder, true, true>(F.L, g, S, E, F.tid); }
            if (TIMES(2) > 1) { PHASE_BEGIN(); pg8::Gemm g{(const bf16*)(ws + WS_HBF), (const bf16*)(wb + WB_IN), MALL, INPAD, 1024}; pg8::StaticOrder S; S.init(MALL, INPAD, F.G, F.bid);
#ifdef MK_NULLEPI
              pg8::EpiNull E{}; pg8::gemm_phase<pg8::EpiNull, pg8::StaticOrder, true, true>(F.L, g, S, E, F.tid);
#else
              pg8::EpiP E{(GAS bf16*)(ws + WS_P), INPAD}; pg8::gemm_phase<pg8::EpiP, pg8::StaticOrder, true, true>(F.L, g, S, E, F.tid);
#endif
            }
            PHASE_BEGIN();
            for (int rep_ = 0; rep_ < TIMES(3); ++rep_) if (SUB(1)) for (int c = F.bid; c < 512; c += F.G) kspec_item(F, ws, c);
            SEAM();
        }
        if (INL(1)) for (int r_ = 0; r_ < 1 + (args.dupk == 4); ++r_) {
            PHASE_BEGIN();
            for (int rep_ = 0; rep_ < TIMES(4); ++rep_) {
            __syncthreads();
            const int nconv = 2 * 64 * 6 + (l == 0 ? 2 * 2 * 6 : 0);
            for (int it = F.bid; it < nconv; it += F.G) {
                if (it < 2 * 64 * 6) { const int cb = it % 6, tb = (it / 6) & 63, b = it / (6 * 64);
                    conv3_item(F, args, (const GAS bf16*)(ws + WS_P) + (size_t)b * SEQ * INPAD, SEQ, (GAS bf16*)(ws + WS_HYT) + (size_t)b * SEQ, l, tb * 128, cb * 256); }
                else { const int i2 = it - 2 * 64 * 6; const int cb = i2 % 6, tb = (i2 / 6) & 1, b = i2 / (6 * 2);
                    conv3_item(F, args, (const GAS bf16*)(ws + WS_P) + (size_t)(NLAT + b * CTXL) * INPAD, CTXL, (GAS bf16*)(ws + WS_HYTC) + (size_t)b * CTXL, l, tb * 128, cb * 256); }
            }
            LAS float* wa = (LAS float*)(F.L + 65536);
            for (int i = F.tid; i < 8192; i += 512) wa[i] = i < 4096 ? INP(args, I_WA2F)[(size_t)l * 4096 + i] : INP(args, I_WA2B)[(size_t)l * 4096 + i - 4096];
            __syncthreads();
            for (int row = gw; row < MALL; row += NGW) post_row(F, args, ws, l, row, wa);
            }
            SEAM();
        }
        if (INL(2)) for (int r_ = 0; r_ < 1 + (args.dupk == 5); ++r_) {
            PHASE_BEGIN();
            for (int rep_ = 0; rep_ < TIMES(5); ++rep_) if (SUB(2)) { pg8::Gemm g{(const bf16*)(ws + WS_NQ), (const bf16*)(wb + WB_UQ), nrows, 768, 384}; pg8::StaticOrder S; S.init(nrows, 768, F.G, F.bid);
              pg8::EpiP E{(GAS bf16*)(ws + WS_QB), 768};
              pg8::gemm_phase<pg8::EpiP, pg8::StaticOrder, true, true>(F.L, g, S, E, F.tid); }
            PHASE_BEGIN();
            for (int rep_ = 0; rep_ < TIMES(5); ++rep_) if (SUB(3)) { pg8::Gemm g{(const bf16*)(ws + WS_NKV), (const bf16*)(wb + WB_UKV), MALL, 1024, 256}; pg8::StaticOrder S; S.init(MALL, 1024, F.G, (F.bid + F.G - 230 % F.G) % F.G);
              pg8::EpiKV E{(GAS bf16*)(ws + WS_KB), (GAS bf16*)(ws + WS_VT), NLAT, KEYS, CTXL};
              pg8::gemm_phase<pg8::EpiKV, pg8::StaticOrder, true, true>(F.L, g, S, E, F.tid); }
            PHASE_BEGIN();
            for (int rep_ = 0; rep_ < TIMES(7); ++rep_) for (int it = (F.bid + F.G - 198 % F.G) % F.G; it < 1056; it += F.G) gla_a_item(F, ws, it);
            PHASE_BEGIN();
            for (int rep_ = 0; rep_ < TIMES(6); ++rep_) if (SUB(4)) for (int c = F.bid; c < 512; c += F.G) hyconv_item(F, args, ws, l, c);
            PHASE_BEGIN();
            for (int rep_ = 0; rep_ < TIMES(15); ++rep_) if (SUB(5) && l == 0) for (int c = F.bid; c < 512; c += F.G) hyctx_item(F, args, ws, l, c);
            SEAM();
        }
        if (INL(3)) {
            PHASE_BEGIN();
            const int nunits = 512 + (l == 0 ? 16 : 0);
            for (int it = F.bid; it < 256; it += F.G) gla_scan_q(F, ws, it);
            for (int rep_ = 0; rep_ < TIMES(8); ++rep_) { unsigned* qh = ctl + CW_QCTR + (l * 4 + rep_) * 64;
            for (;;) {
                if (F.tid == 0) MISC[0] = __hip_atomic_fetch_add(qh, 1u, __ATOMIC_RELAXED, __HIP_MEMORY_SCOPE_AGENT);
                __syncthreads();
                int u = __builtin_amdgcn_readfirstlane((int)MISC[0]);
                __syncthreads();
                if (u >= nunits) break;
                int bh, qrow0, nt;
                if (u < 512) { bh = u >> 5; qrow0 = (bh >> 3) * SEQ + (u & 31) * 256; nt = KEYS / 64; } else { bh = u - 512; qrow0 = NLAT + (bh >> 3) * CTXL; nt = CTXL / 64; }
                attn_unit(rep_ == 0 ? 0 : MK_ATTVAR, F, (const GAS bf16*)(ws + WS_QB), (const GAS bf16*)(ws + WS_KB) + (size_t)bh * KEYS * 96, (const GAS bf16*)(ws + WS_VT) + (size_t)bh * 64 * KEYS, rep_ == 0 ? (GAS bf16*)(ws + WS_OBR) + (size_t)MALL * 512 : (GAS bf16*)(ws + WS_XPRE), qrow0, bh & 7, nt, (const GAS float*)(ws + WS_ROPE));
            }
            }
            SEAM();
        }
        if (INL(4)) for (int r_ = 0; r_ < 1 + (args.dupk == 7); ++r_) {
            PHASE_BEGIN();
            for (int rep_ = 0; rep_ < TIMES(9); ++rep_) {
            for (int it = F.bid; it < 1056; it += F.G) { if (l == 1 && (it % 132) < 4) continue; gla_c_item(F, args, ws, l, it); }
            for (int it = F.bid; it < 256; it += F.G) hy_tr_item(F, ws, it);
            }
            SEAM();
        }
        if (INL(5)) for (int r_ = 0; r_ < 1 + (args.dupk == 8); ++r_) {
            PHASE_BEGIN();
            pg8::Gemm g{(const bf16*)(ws + WS_OBR), (const bf16*)(wb + WB_BR), MALL, 1024, 512}; pg8::MergeOrder S{nPM, MALL / 256, F.G, F.bid};
            pg8::EpiU E{(GAS bf16*)(ws + WS_U), MALL / 256};
            pg8::gemm_phase<pg8::EpiU, pg8::MergeOrder, true, true>(F.L, g, S, E, F.tid);
            if (TIMES(10) > 1) { PHASE_BEGIN(); pg8::gemm_phase<pg8::EpiU, pg8::MergeOrder, true, true>(F.L, g, S, E, F.tid); }
            SEAM();
            PHASE_BEGIN();
            for (int rep_ = 0; rep_ < TIMES(17); ++rep_) for (int row = gw; row < nrows; row += NGW) gate_row(F, ws, row);
            SEAM();
        }
        if (INL(6)) for (int r_ = 0; r_ < 1 + (args.dupk == 9); ++r_) {
            PHASE_BEGIN();
            pg8::Gemm g{(const bf16*)(ws + WS_YMB), (const bf16*)(wb + WB_OUT), nrows, 1024, 1024}; pg8::StaticOrder S; S.init(nrows, 1024, F.G, F.bid);
            pg8::EpiOut E{l == 0 ? (const GAS float*)INP(args, I_X) : (const GAS float*)(ws + WS_XS), l == 0 ? (const GAS float*)INP(args, I_CTX) - (size_t)NLAT * 1024 : (const GAS float*)(ws + WS_XS), (GAS bf16*)(ws + WS_XPRE), (const GAS float*)(ws + WS_MOD) + (size_t)l * 18432, NLAT, DN_ALPHA, l};
            pg8::gemm_phase<pg8::EpiOut, pg8::StaticOrder, true, true>(F.L, g, S, E, F.tid);
            if (TIMES(11) > 1) { PHASE_BEGIN(); pg8::gemm_phase<pg8::EpiOut, pg8::StaticOrder, true, true>(F.L, g, S, E, F.tid); }
            SEAM();
        }
        if (INL(7)) {
            PHASE_BEGIN();
            LAS float* wT = (LAS float*)F.L; const float* rw = INP(args, I_RW) + (size_t)l * 1024 * 32;
            LAS unsigned* lcnt = (LAS unsigned*)(F.L + LDS_TAB + 512); LAS unsigned* lbase = lcnt + 32;
#pragma unroll 8
            for (int i = F.tid; i < 32768; i += 512) wT[(i & 31) * RW_STRIDE + (i >> 5)] = rw[i];
            if (F.tid < 32) lcnt[F.tid] = 0u;
            __syncthreads();
            for (int rep_ = TIMES(1) - 1; rep_ >= 0; --rep_) for (int rp = gw; rp < nrows / 2; rp += NGW) ln1_router_row2(F, args, ws, l, 2 * rp, wT, rep_ > 0, lcnt);
            __syncthreads();
            if (F.tid < 32) lbase[F.tid] = __hip_atomic_fetch_add(ctl + CW_CNT + (l * 32 + F.tid) * 64, lcnt[F.tid], __ATOMIC_RELAXED, __HIP_MEMORY_SCOPE_AGENT);
            __syncthreads();
            if (F.lane < 8) { const int* tope = (const int*)(ws + WS_TOPE); const int* spos = (const int*)(ws + WS_SPOS); int* elist = (int*)(ws + WS_ELIST);
                for (int rp = gw; rp < nrows / 2; rp += NGW) { const int s_ = rp * 8 + F.lane; const int e_ = tope[s_]; elist[e_ * ECAP + (int)lbase[e_] + spos[s_]] = s_; } }
            SEAM();
        }
        LAS int* pst = (LAS int*)(F.L + LDS_TAB); LAS int* cntl = pst + 64; LAS int* ptab = pst + 128;
        if (INL(9)) for (int r_ = 0; r_ < 1 + (args.dupk == 12); ++r_) {
            PHASE_BEGIN();
            const int npanel = moe_table(F, ws, l, pst, cntl, ptab);
            pg8::Gemm g{(const bf16*)(ws + WS_HBF), (const bf16*)(wb + WB_M1), XG_ROWS, 2048, 1024}; pg8::MoeOrder<8> S{(const LAS int*)ptab, npanel, F.G, F.bid, (const LAS int*)pst, (const LAS int*)cntl};
            pg8::EpiMoe1 E{(GAS bf16*)(ws + WS_ACT), (const GAS float*)INP(args, I_MB1) + (size_t)l * 32 * 2048};
            pg8::gemm_phase_g<pg8::EpiMoe1, pg8::MoeOrder<8>, true, true>(F.L, g, S, E, F.tid, (const GAS int*)(ws + WS_ELIST));
            if (TIMES(13) > 1) { PHASE_BEGIN(); pg8::gemm_phase_g<pg8::EpiMoe1, pg8::MoeOrder<8>, true, true>(F.L, g, S, E, F.tid, (const GAS int*)(ws + WS_ELIST)); }
            SEAM();
        }
        if (INL(10)) for (int r_ = 0; r_ < 1 + (args.dupk == 13); ++r_) {
            PHASE_BEGIN();
            const int npanel = moe_table(F, ws, l, pst, cntl, ptab);
            pg8::Gemm g{(const bf16*)(ws + WS_ACT), (const bf16*)(wb + WB_M2), XG_ROWS, 1024, 1024}; pg8::MoeOrder<4> S{(const LAS int*)ptab, npanel, F.G, F.bid, (const LAS int*)pst, (const LAS int*)cntl};
            pg8::EpiMoe2 E{(GAS bf16*)(ws + WS_YSLOT), (const GAS float*)INP(args, I_MB2) + (size_t)l * 32 * 1024, (const GAS int*)(ws + WS_ELIST), (const GAS float*)(ws + WS_TOPG), (const LAS int*)pst, (const LAS int*)cntl};
            pg8::gemm_phase<pg8::EpiMoe2, pg8::MoeOrder<4>, true, true>(F.L, g, S, E, F.tid);
            if (TIMES(14) > 1) { PHASE_BEGIN(); pg8::gemm_phase<pg8::EpiMoe2, pg8::MoeOrder<4>, true, true>(F.L, g, S, E, F.tid); }
            if (l == 0) { PHASE_BEGIN(); __syncthreads();
                for (int it = (F.G - 1 - F.bid); it < 256; it += F.G) HYF(1, 8192, it, (bf16*)(ws + WS_FILT), (float*)(ws + WS_HPART)); }
            SEAM();
        }
        if (INL(11)) {
            PHASE_BEGIN();
            for (int rep_ = TIMES(16) - 1; rep_ >= 0; --rep_) for (int row = gw; row < nrows; row += NGW) { combine_row(F, args, ws, l, row, rep_ > 0 ? (GAS bf16*)(ws + WS_XPRE) : (GAS bf16*)(ws + WS_XS));
                if (l == 0) { const int mi = row < NLAT ? (row >> 13) : 2; const float* mod = (const float*)(ws + WS_MOD) + (size_t)(3 + mi) * 6144;
                    ln_mod_row_b((const GAS bf16*)(ws + WS_XS) + (size_t)row * 1024, mod, mod + 1024, (bf16*)(ws + WS_HBF) + (size_t)row * 1024, F.lane); } }
            if (l == 0) SEAM();
        }
    }
#undef wb
#undef ctl
#undef IN
#undef INL
}

extern "C" void kernel_launch(void* const* d_in, const int* in_sizes, int n_in, void* d_out, int out_size, void* d_ws, size_t ws_size, hipStream_t stream) {
    static int grid = 0;
    if (grid == 0) {
        if (n_in != 39 || out_size != NLAT * D || ws_size < WS_END) { fprintf(stderr, "kernel_launch: expected 39 inputs, %d outputs, >= %zu B workspace; got %d, %d, %zu\n", NLAT * D, (size_t)WS_END, n_in, out_size, ws_size); grid = -1; return; }
        int dev = 0, cus = 0, per_cu = 0;
        if (hipGetDevice(&dev) != hipSuccess || hipDeviceGetAttribute(&cus, hipDeviceAttributeMultiprocessorCount, dev) != hipSuccess) { grid = -1; return; }
        if (hipFuncSetAttribute((const void*)fwd, hipFuncAttributeMaxDynamicSharedMemorySize, LDS_BYTES) != hipSuccess) { fprintf(stderr, "kernel_launch: hipFuncSetAttribute failed\n"); grid = -1; return; }
        if (hipOccupancyMaxActiveBlocksPerMultiprocessor(&per_cu, (const void*)fwd, 512, LDS_BYTES) != hipSuccess || per_cu < 1) fprintf(stderr, "kernel_launch: occupancy query says %d\n", per_cu);
        (void)hipGetLastError();
        grid = cus;
    }
    if (grid < 0) return;
    (void)hipMemsetAsync((char*)d_ws + WS_CTL, 0, (size_t)CW_DBG * 4, stream);
    Args a{};
    for (int i = 0; i < 39; ++i) a.in[i] = (const float*)d_in[i];
    a.out = (float*)d_out; a.ws = (unsigned char*)d_ws;
#ifdef MK_DUPPH
    a.dupk = MK_DUPPH;
#else
    a.dupk = -1;
#endif
#if MK_PER_PHASE
    for (int ph = 0; ph < NPH; ++ph) { a.ph_lo = ph; a.ph_hi = ph + 1; hipLaunchKernelGGL(fwd, dim3(grid), dim3(512), LDS_BYTES, stream, a); }
#else
    a.ph_lo = 0; a.ph_hi = NPH;
    hipLaunchKernelGGL(fwd, dim3(grid), dim3(512), LDS_BYTES, stream, a);
#endif
}
```
